# Optimizing an MI355X kernel written in HIP

```python
import math
import jax, jax.numpy as jnp
from jax import lax
import numpy as np

D_MODEL = 1024
BATCH = 8
SEQ = 4096
DEPTH = 2

GRID_W = 64
CTX_LEN = 256

BRANCH_W = 512
N_BRANCH = 3

ATT_HEADS = 4
ATT_DH = 64
ATT_DV = 2 * ATT_DH
ATT_QK = ATT_HEADS * 2 * ATT_DH
Q_BLOCK = 128
ROPE_BASE = 10000.0

LRU_BLOCKS = 8
LRU_BS = BRANCH_W // LRU_BLOCKS
LRU_C = 8.0
CONV_W = 4

SSD_HEADDIM = 64
SSD_HEADS = BRANCH_W // SSD_HEADDIM
SSD_GROUPS = 2
SSD_HPG = SSD_HEADS // SSD_GROUPS
SSD_STATE = 128
SSD_CHUNK = 128
SSD_XBC = BRANCH_W + 2 * SSD_GROUPS * SSD_STATE
N_DIR = 2

N_EXPERTS = 64
TOP_K = 8
N_GROUPS = 8
TOPK_GROUPS = 4
EXPERT_F = 256
SHARED_F = 256
ROUTED_SCALE = 2.5
MOE_BLOCK = 128

DN_ALPHA = (2 * DEPTH) ** 0.25
DN_BETA = (8 * DEPTH) ** -0.25
LN_EPS = 1e-5
RMS_EPS = 1e-6

IN_WIDTHS = (ATT_QK, ATT_QK, ATT_HEADS * ATT_DV,
             BRANCH_W, BRANCH_W,
             BRANCH_W, SSD_XBC, N_DIR * SSD_HEADS,
             N_BRANCH * D_MODEL)
IN_SPLITS = tuple(int(s) for s in np.cumsum(IN_WIDTHS)[:-1])
IN_TOTAL = int(sum(IN_WIDTHS))

kernel_name = 'hybrid_dit_diffattn_rglru_ssd_moe'


def layer_norm(x, g, b):
    xf = x.astype(jnp.float32)
    mu = jnp.mean(xf, axis=-1, keepdims=True)
    var = jnp.mean(jnp.square(xf - mu), axis=-1, keepdims=True)
    return ((xf - mu) * lax.rsqrt(var + LN_EPS)).astype(x.dtype) * g + b


def rms_norm(x, g):
    xf = x.astype(jnp.float32)
    return (xf * lax.rsqrt(jnp.mean(xf * xf, axis=-1, keepdims=True) + RMS_EPS)).astype(x.dtype) * g


def axial_rope(n_tokens):
    rows = n_tokens // GRID_W
    row = jnp.repeat(jnp.arange(rows, dtype=jnp.float32), GRID_W)
    col = (jnp.arange(n_tokens) % GRID_W).astype(jnp.float32)
    n_freq = ATT_DH // 4
    inv = ROPE_BASE ** (-jnp.arange(n_freq, dtype=jnp.float32) / n_freq)
    ang = jnp.concatenate([row[:, None] * inv, col[:, None] * inv], axis=-1)
    return jnp.cos(ang), jnp.sin(ang)


def apply_rope(x, cos, sin):
    x1, x2 = jnp.split(x, 2, axis=-1)
    c = cos[:, None, None, :].astype(x.dtype)
    s = sin[:, None, None, :].astype(x.dtype)
    return jnp.concatenate([x1 * c - x2 * s, x2 * c + x1 * s], axis=-1)


def diff_attn_block(q, k, v, lam):
    s = jnp.einsum('bqhmd,bkhmd->bhmqk', q, k).astype(jnp.float32) * (ATT_DH ** -0.5)
    p = jax.nn.softmax(s, axis=-1)
    p = p[:, :, 0] - lam * p[:, :, 1]
    return jnp.einsum('bhqk,bkhe->bqhe', p.astype(v.dtype), v)


def diff_attn_sweep(q, k, v, lam):
    B, L = q.shape[:2]
    qb = q.reshape(B, L // Q_BLOCK, Q_BLOCK, *q.shape[2:]).swapaxes(0, 1)
    ob = lax.map(lambda qi: diff_attn_block(qi, k, v, lam), qb)
    return ob.swapaxes(0, 1).reshape(B, L, *ob.shape[3:])


def diff_attn_head_norm(o, g, lam_init):
    B, L = o.shape[:2]
    return (rms_norm(o, g) * (1.0 - lam_init)).reshape(B, L, -1)


def dwconv_centred(x, w, bias):
    L = x.shape[1]
    left = CONV_W // 2
    xp = jnp.pad(x, ((0, 0), (left, CONV_W - 1 - left), (0, 0)))
    y = xp[:, 0:L] * w[0]
    for j in range(1, CONV_W):
        y = y + xp[:, j:j + L] * w[j]
    return y + bias


def _lin_combine(e1, e2):
    a1, b1 = e1
    a2, b2 = e2
    return a1 * a2, a2 * b1 + b2


def linear_scan(a, b, h0, reverse):
    if reverse:
        b = b.at[:, -1].add(a[:, -1] * h0)
    else:
        b = b.at[:, 0].add(a[:, 0] * h0)
    _, h = lax.associative_scan(_lin_combine, (a, b), reverse=reverse, axis=1)
    return h


def rglru_coeffs(u, w_a, b_a, w_i, b_i, lam):
    B, L, W = u.shape
    ub = u.reshape(B, L, LRU_BLOCKS, LRU_BS)
    r = jax.nn.sigmoid(jnp.einsum('blnk,nkj->blnj', ub, w_a).reshape(B, L, W) + b_a)
    i = jax.nn.sigmoid(jnp.einsum('blnk,nkj->blnj', ub, w_i).reshape(B, L, W) + b_i)
    log_a = -LRU_C * r * jax.nn.softplus(-lam)
    return jnp.exp(log_a), jnp.sqrt(1.0 - jnp.exp(2.0 * log_a)) * (i * u)


def rglru_bidir(u, uc, w_a, b_a, w_i, b_i, lam):
    u = u.astype(jnp.float32)
    uc = uc.astype(jnp.float32)
    y = jnp.zeros_like(u)
    yc = jnp.zeros_like(uc)
    for d in range(N_DIR):
        rev = d == 1
        a_c, b_c = rglru_coeffs(uc, w_a[d], b_a[d], w_i[d], b_i[d], lam[d])
        h_c = linear_scan(a_c, b_c, jnp.zeros_like(b_c[:, 0]), rev)
        h_end = h_c[:, 0] if rev else h_c[:, -1]
        a_l, b_l = rglru_coeffs(u, w_a[d], b_a[d], w_i[d], b_i[d], lam[d])
        y = y + linear_scan(a_l, b_l, h_end, rev)
        yc = yc + h_c
    return y, yc


def segsum(x):
    T = x.shape[-1]
    xe = jnp.broadcast_to(x[..., :, None], x.shape + (T,))
    strict = jnp.tril(jnp.ones((T, T), dtype=bool), -1)
    cs = jnp.cumsum(jnp.where(strict, xe, 0.0), axis=-2)
    return jnp.where(jnp.tril(jnp.ones((T, T), dtype=bool)), cs, -jnp.inf)


def ssd_chunked(xdt, a, bm, cm, h0):
    B, T, G, R, P = xdt.shape
    nc = T // SSD_CHUNK
    xdt = xdt.reshape(B, nc, SSD_CHUNK, G, R, P)
    bm = bm.reshape(B, nc, SSD_CHUNK, G, -1)
    cm = cm.reshape(B, nc, SSD_CHUNK, G, -1)
    a = a.reshape(B, nc, SSD_CHUNK, G, R).transpose(0, 3, 4, 1, 2)
    a_cs = jnp.cumsum(a, axis=-1)
    decay_in = jnp.exp(segsum(a))
    cb = jnp.einsum('bclgn,bcsgn->bcgls', cm, bm)
    y_diag = jnp.einsum('bcgls,bgrcls,bcsgrp->bclgrp', cb, decay_in, xdt)
    decay_to_end = jnp.exp(a_cs[..., -1:] - a_cs)
    states = jnp.einsum('bcsgn,bgrcs,bcsgrp->bcgrpn', bm, decay_to_end, xdt)
    states = jnp.concatenate([h0[:, None], states], axis=1)
    chunk_a = jnp.pad(a_cs[..., -1], ((0, 0), (0, 0), (0, 0), (1, 0)))
    states = jnp.einsum('bgrzc,bcgrpn->bzgrpn', jnp.exp(segsum(chunk_a)), states)
    y_off = jnp.einsum('bclgn,bcgrpn,bgrcl->bclgrp', cm, states[:, :-1], jnp.exp(a_cs))
    return (y_diag + y_off).reshape(B, T, G, R, P), states[:, -1]


def ssd_direction(xs, bm, cm, dt, A, h0, reverse):
    if reverse:
        xs, bm, cm, dt = xs[:, ::-1], bm[:, ::-1], cm[:, ::-1], dt[:, ::-1]
    y, h_last = ssd_chunked(xs * dt[..., None], dt * A, bm, cm, h0)
    return (y[:, ::-1] if reverse else y), h_last


def ssd_prep(xbc, dt_raw, conv_w, conv_b):
    u = jax.nn.silu(dwconv_centred(xbc, conv_w, conv_b)).astype(jnp.float32)
    B, L = u.shape[:2]
    xs, bm, cm = jnp.split(u, [BRANCH_W, BRANCH_W + SSD_GROUPS * SSD_STATE], axis=-1)
    return (xs.reshape(B, L, SSD_GROUPS, SSD_HPG, SSD_HEADDIM),
            bm.reshape(B, L, SSD_GROUPS, SSD_STATE),
            cm.reshape(B, L, SSD_GROUPS, SSD_STATE),
            dt_raw.astype(jnp.float32).reshape(B, L, N_DIR, SSD_GROUPS, SSD_HPG))


def ssd_bidir(xbc, dt_raw, xbcc, dtc_raw, conv_w, conv_b, dt_bias, a_log, d_skip):
    xs, bm, cm, dt = ssd_prep(xbc, dt_raw, conv_w, conv_b)
    xsc, bmc, cmc, dtc = ssd_prep(xbcc, dtc_raw, conv_w, conv_b)
    B, L = xs.shape[:2]
    Lc = xsc.shape[1]
    dtb = dt_bias.astype(jnp.float32).reshape(N_DIR, SSD_GROUPS, SSD_HPG)
    A = -jnp.exp(a_log.astype(jnp.float32)).reshape(N_DIR, SSD_GROUPS, SSD_HPG)
    skip = d_skip.astype(jnp.float32).reshape(SSD_GROUPS, SSD_HPG, 1)
    y = skip * xs
    yc = skip * xsc
    h0 = jnp.zeros((B, SSD_GROUPS, SSD_HPG, SSD_HEADDIM, SSD_STATE), jnp.float32)
    for d in range(N_DIR):
        rev = d == 1
        dt_c = jax.nn.softplus(dtc[:, :, d] + dtb[d])
        dt_l = jax.nn.softplus(dt[:, :, d] + dtb[d])
        y_c, h_ctx = ssd_direction(xsc, bmc, cmc, dt_c, A[d], h0, rev)
        y_l, _ = ssd_direction(xs, bm, cm, dt_l, A[d], h_ctx, rev)
        y = y + y_l
        yc = yc + y_c
    return y.reshape(B, L, BRANCH_W), yc.reshape(B, Lc, BRANCH_W)


def gated_group_rmsnorm(y, z, g):
    B, L = y.shape[:2]
    t = (y * jax.nn.silu(z.astype(jnp.float32))).reshape(B, L, SSD_GROUPS, BRANCH_W // SSD_GROUPS)
    t = t * lax.rsqrt(jnp.mean(t * t, axis=-1, keepdims=True) + RMS_EPS)
    return (t.reshape(B, L, BRANCH_W) * g).astype(z.dtype)


def merge_branches(ya, yb, yc, gates, w_branch, w_out):
    ys = jnp.stack([ya, yb, yc], axis=2)
    proj = jnp.einsum('blnk,nkd->blnd', ys, w_branch)
    g = jax.nn.sigmoid(gates.reshape(*gates.shape[:2], N_BRANCH, D_MODEL).astype(jnp.float32))
    return jnp.einsum('blnd,de->ble', g.astype(proj.dtype) * proj, w_out)


def token_mixers(h, hc, cos, sin, w_in, lam_q, lam_k, lam_init, attn_g,
                 lru_cw, lru_cb, lru_wa, lru_ba, lru_wi, lru_bi, lru_lam,
                 ssd_cw, ssd_cb, ssd_dtb, ssd_alog, ssd_d, ssd_g,
                 w_branch, w_out, need_ctx):
    B, L, _ = h.shape
    Lc = hc.shape[1]
    q, k, v, lx, lg, z, xbc, dt, gates = jnp.split(h @ w_in, IN_SPLITS, axis=-1)
    qc, kc, vc, lxc, lgc, zc, xbcc, dtc, gatesc = jnp.split(hc @ w_in, IN_SPLITS, axis=-1)

    lam = (jnp.exp(jnp.sum(lam_q[0] * lam_k[0])) - jnp.exp(jnp.sum(lam_q[1] * lam_k[1]))).astype(jnp.float32) + lam_init
    q = apply_rope(q.reshape(B, L, ATT_HEADS, 2, ATT_DH), cos, sin)
    k = apply_rope(k.reshape(B, L, ATT_HEADS, 2, ATT_DH), cos, sin)
    kc = kc.reshape(B, Lc, ATT_HEADS, 2, ATT_DH)
    vc = vc.reshape(B, Lc, ATT_HEADS, ATT_DV)
    k_all = jnp.concatenate([k, kc], axis=1)
    v_all = jnp.concatenate([v.reshape(B, L, ATT_HEADS, ATT_DV), vc], axis=1)
    ya = diff_attn_head_norm(diff_attn_sweep(q, k_all, v_all, lam), attn_g, lam_init)

    yb, ybc = rglru_bidir(dwconv_centred(lx, lru_cw, lru_cb), dwconv_centred(lxc, lru_cw, lru_cb),
                          lru_wa, lru_ba, lru_wi, lru_bi, lru_lam)
    yb = yb.astype(h.dtype) * jax.nn.gelu(lg)

    yc, ycc = ssd_bidir(xbc, dt, xbcc, dtc, ssd_cw, ssd_cb, ssd_dtb, ssd_alog, ssd_d)
    yc = gated_group_rmsnorm(yc, z, ssd_g)

    out = merge_branches(ya, yb, yc, gates, w_branch, w_out)
    if not need_ctx:
        return out, None
    qc = qc.reshape(B, Lc, ATT_HEADS, 2, ATT_DH)
    yac = diff_attn_head_norm(diff_attn_block(qc, kc, vc, lam), attn_g, lam_init)
    ybc = ybc.astype(hc.dtype) * jax.nn.gelu(lgc)
    ycc = gated_group_rmsnorm(ycc, zc, ssd_g)
    return out, merge_branches(yac, ybc, ycc, gatesc, w_branch, w_out)


def swiglu(h, w_up, w_down):
    g, u = jnp.split(h @ w_up, 2, axis=-1)
    return (jax.nn.silu(g) * u) @ w_down


def routed_experts(h, eidx, w, w_up, w_down):
    N, D = h.shape
    NK = N * TOP_K
    nb = (NK + N_EXPERTS * (MOE_BLOCK - 1) + MOE_BLOCK - 1) // MOE_BLOCK
    P = nb * MOE_BLOCK
    e_flat = eidx.reshape(-1)
    tok_flat = jnp.repeat(jnp.arange(N, dtype=jnp.int32), TOP_K)
    w_flat = w.reshape(-1)
    counts = jnp.zeros((N_EXPERTS,), jnp.int32).at[e_flat].add(1)
    padded = (counts + MOE_BLOCK - 1) // MOE_BLOCK * MOE_BLOCK
    pend = jnp.cumsum(padded)
    pstart = pend - padded
    start = jnp.cumsum(counts) - counts
    order = jnp.argsort(e_flat)
    se = e_flat[order]
    dest = pstart[se] + jnp.arange(NK, dtype=jnp.int32) - start[se]
    row_tok = jnp.full((P,), N, jnp.int32).at[dest].set(tok_flat[order])
    row_w = jnp.zeros((P,), w.dtype).at[dest].set(w_flat[order])
    blk_e = jnp.minimum(jnp.searchsorted(pend, jnp.arange(nb, dtype=jnp.int32) * MOE_BLOCK, side='right'),
                        N_EXPERTS - 1)
    h_pad = jnp.concatenate([h, jnp.zeros((1, D), h.dtype)], axis=0)

    def expert_block(args):
        e, toks, ws = args
        return swiglu(h_pad[toks], w_up[e], w_down[e]) * ws[:, None].astype(h.dtype)

    ys = lax.map(expert_block, (blk_e, row_tok.reshape(nb, MOE_BLOCK), row_w.reshape(nb, MOE_BLOCK)))
    return jax.ops.segment_sum(ys.reshape(P, D), row_tok, num_segments=N + 1)[:N]


def moe_ffn(h, w_router, router_bias, w_up, w_down, ws_up, ws_down):
    N = h.shape[0]
    scores = jax.nn.sigmoid((h @ w_router).astype(jnp.float32))
    sel = scores + router_bias
    grp_score = lax.top_k(sel.reshape(N, N_GROUPS, N_EXPERTS // N_GROUPS), 2)[0].sum(-1)
    _, gidx = lax.top_k(grp_score, TOPK_GROUPS)
    gmask = jax.nn.one_hot(gidx, N_GROUPS).sum(-2) > 0
    sel = jnp.where(jnp.repeat(gmask, N_EXPERTS // N_GROUPS, axis=-1), sel, -jnp.inf)
    _, eidx = lax.top_k(sel, TOP_K)
    w = jnp.take_along_axis(scores, eidx, axis=-1)
    w = w / jnp.sum(w, axis=-1, keepdims=True) * ROUTED_SCALE
    return swiglu(h, ws_up, ws_down) + routed_experts(h, eidx, w, w_up, w_down)


def setup_inputs(seed: int = 0) -> dict:
    key = jax.random.key(seed)
    kit = iter(jax.random.split(key, 64))

    def nrm(shape, scale):
        return jax.random.normal(next(kit), shape, jnp.float32) * scale

    L, D = DEPTH, D_MODEL
    v0 = 2 * ATT_QK
    col_scale = np.ones((IN_TOTAL,), np.float32)
    col_scale[v0:v0 + ATT_HEADS * ATT_DV] = DN_BETA
    s_lru = jax.random.uniform(next(kit), (L, N_DIR, BRANCH_W), jnp.float32,
                               minval=0.9, maxval=0.999) ** (1.0 / LRU_C)
    dt0 = jnp.exp(jax.random.uniform(next(kit), (L, N_DIR, SSD_HEADS), jnp.float32,
                                     minval=math.log(1e-3), maxval=math.log(1e-1)))
    a0 = jax.random.uniform(next(kit), (L, N_DIR, SSD_HEADS), jnp.float32, minval=1.0, maxval=16.0)
    return {
        'x': nrm((BATCH, SEQ, D), 1.0),
        'c': nrm((BATCH, D), 1.0),
        'ctx': nrm((BATCH, CTX_LEN, D), 1.0),
        'c_ctx': nrm((D,), 1.0),
        'w_mod': nrm((L, D, 6 * D), 0.5 * D ** -0.5),
        'b_mod': nrm((L, 6 * D), 0.01),
        'w_in': nrm((L, D, IN_TOTAL), D ** -0.5) * jnp.asarray(col_scale),
        'lam_q': nrm((L, 2, ATT_DH), 0.1),
        'lam_k': nrm((L, 2, ATT_DH), 0.1),
        'attn_norm_g': 1.0 + nrm((L, ATT_HEADS, ATT_DV), 0.02),
        'lru_conv_w': nrm((L, CONV_W, BRANCH_W), CONV_W ** -0.5),
        'lru_conv_b': nrm((L, BRANCH_W), 0.01),
        'lru_wa': nrm((L, N_DIR, LRU_BLOCKS, LRU_BS, LRU_BS), LRU_BS ** -0.5),
        'lru_ba': nrm((L, N_DIR, BRANCH_W), 0.01),
        'lru_wi': nrm((L, N_DIR, LRU_BLOCKS, LRU_BS, LRU_BS), LRU_BS ** -0.5),
        'lru_bi': nrm((L, N_DIR, BRANCH_W), 0.01),
        'lru_lambda': jnp.log(s_lru) - jnp.log1p(-s_lru),
        'ssd_conv_w': nrm((L, CONV_W, SSD_XBC), CONV_W ** -0.5),
        'ssd_conv_b': nrm((L, SSD_XBC), 0.01),
        'ssd_dt_bias': dt0 + jnp.log(-jnp.expm1(-dt0)),
        'ssd_a_log': jnp.log(a0),
        'ssd_d': 1.0 + nrm((L, SSD_HEADS), 0.02),
        'ssd_norm_g': 1.0 + nrm((L, BRANCH_W), 0.02),
        'w_branch': nrm((L, N_BRANCH, BRANCH_W, D), BRANCH_W ** -0.5 * DN_BETA),
        'w_out': nrm((L, D, D), D ** -0.5 * DN_BETA),
        'ln1_g': 1.0 + nrm((L, D), 0.02),
        'ln1_b': nrm((L, D), 0.01),
        'w_router': nrm((L, D, N_EXPERTS), D ** -0.5),
        'router_bias': nrm((L, N_EXPERTS), 0.01),
        'w_up': nrm((L, N_EXPERTS, D, 2 * EXPERT_F), D ** -0.5),
        'w_down': nrm((L, N_EXPERTS, EXPERT_F, D), EXPERT_F ** -0.5 * DN_BETA),
        'ws_up': nrm((L, D, 2 * SHARED_F), D ** -0.5),
        'ws_down': nrm((L, SHARED_F, D), SHARED_F ** -0.5 * DN_BETA),
        'ln2_g': 1.0 + nrm((L, D), 0.02),
        'ln2_b': nrm((L, D), 0.01),
    }


def reference(x, c, ctx, c_ctx, w_mod, b_mod, w_in, lam_q, lam_k, attn_norm_g,
              lru_conv_w, lru_conv_b, lru_wa, lru_ba, lru_wi, lru_bi, lru_lambda,
              ssd_conv_w, ssd_conv_b, ssd_dt_bias, ssd_a_log, ssd_d, ssd_norm_g,
              w_branch, w_out, ln1_g, ln1_b, w_router, router_bias, w_up, w_down,
              ws_up, ws_down, ln2_g, ln2_b):
    B, L, D = x.shape
    Lc = ctx.shape[1]
    cos, sin = axial_rope(L)
    s_c = jax.nn.silu(c)
    s_cc = jax.nn.silu(c_ctx)
    for l in range(DEPTH):
        last = l == DEPTH - 1
        lam_init = 0.8 - 0.6 * math.exp(-0.3 * l)
        m = jnp.split((s_c @ w_mod[l] + b_mod[l])[:, None, :], 6, axis=-1)
        mc = jnp.split(s_cc @ w_mod[l] + b_mod[l], 6, axis=-1)
        h = x * (1.0 + m[1]) + m[0]
        hc = ctx * (1.0 + mc[1]) + mc[0]
        mix, mix_c = token_mixers(
            h, hc, cos, sin, w_in[l], lam_q[l], lam_k[l], lam_init, attn_norm_g[l],
            lru_conv_w[l], lru_conv_b[l], lru_wa[l], lru_ba[l], lru_wi[l], lru_bi[l], lru_lambda[l],
            ssd_conv_w[l], ssd_conv_b[l], ssd_dt_bias[l], ssd_a_log[l], ssd_d[l], ssd_norm_g[l],
            w_branch[l], w_out[l], not last)
        x = layer_norm(DN_ALPHA * x + m[2] * mix, ln1_g[l], ln1_b[l])
        h2 = (x * (1.0 + m[4]) + m[3]).reshape(B * L, D)
        if last:
            f = moe_ffn(h2, w_router[l], router_bias[l], w_up[l], w_down[l], ws_up[l], ws_down[l])
        else:
            ctx = layer_norm(DN_ALPHA * ctx + mc[2] * mix_c, ln1_g[l], ln1_b[l])
            hc2 = (ctx * (1.0 + mc[4]) + mc[3]).reshape(B * Lc, D)
            f_all = moe_ffn(jnp.concatenate([h2, hc2], axis=0), w_router[l], router_bias[l],
                            w_up[l], w_down[l], ws_up[l], ws_down[l])
            f = f_all[:B * L]
            ctx = layer_norm(DN_ALPHA * ctx + mc[5] * f_all[B * L:].reshape(B, Lc, D), ln2_g[l], ln2_b[l])
        x = layer_norm(DN_ALPHA * x + m[5] * f.reshape(B, L, D), ln2_g[l], ln2_b[l])
    return x
```

```cpp
#include <hip/hip_runtime.h>
#include <cstdio>
#include <cstdint>

#define GAS __attribute__((address_space(1)))
#define LAS __attribute__((address_space(3)))
typedef unsigned short bf16;
typedef short bf16x8 __attribute__((ext_vector_type(8)));
typedef short s16x4 __attribute__((ext_vector_type(4)));
typedef float f32x2 __attribute__((ext_vector_type(2)));
typedef float f32x4 __attribute__((ext_vector_type(4)));
typedef float f32x16 __attribute__((ext_vector_type(16)));
typedef unsigned u32x2 __attribute__((ext_vector_type(2)));
typedef unsigned u32x4 __attribute__((ext_vector_type(4)));

constexpr int DM = 1024, NBATCH = 8, SEQ = 4096, CTXL = 256, DEPTH = 2;
constexpr int NLAT = NBATCH * SEQ, NCTX = NBATCH * CTXL, MTOK = NLAT + NCTX;
constexpr int IN_TOTAL = 7184, ZLD = 7424;
constexpr int ZC_Q = 0, ZC_K = 512, ZC_V = 1024, ZC_LX = 1536, ZC_LG = 2048, ZC_Z = 2560, ZC_XBC = 3072, ZC_GATE = 4096, ZC_DT = 7168;
constexpr int ZC_MIX = 512;
constexpr int NEXP = 64, TOPK = 8, EXPF = 256;
constexpr int PMAX_TILES = 1152, PMAX = PMAX_TILES * 256;
constexpr float DN_ALPHA = 1.41421356237309515f;
constexpr float LN_EPS = 1e-5f, RMS_EPS = 1e-6f;

constexpr size_t MiB = 1u << 20;
constexpr size_t WS_CTL = 0, CTL_ZERO_BYTES = 1 * MiB;
constexpr size_t WS_MOD = 1 * MiB;
constexpr size_t WS_ROPE = 2 * MiB;
constexpr size_t WS_LOGIT = 4 * MiB;
constexpr size_t WS_ACTS = 13 * MiB;
constexpr size_t WS_SELE = 30 * MiB;
constexpr size_t WS_SELW = 32 * MiB;
constexpr size_t WS_SELR = 34 * MiB;
constexpr size_t WS_TSLOT = 36 * MiB;
constexpr size_t WS_ROWTOK = 38 * MiB;
constexpr size_t WS_ROWW = 40 * MiB;
constexpr size_t WS_WGHIST = 42 * MiB;
constexpr size_t WS_TILEE = 42 * MiB + 65536;
constexpr size_t WS_NTILES = 42 * MiB + 131072;
constexpr size_t WS_W = 44 * MiB;
constexpr size_t W_IN = 0;
constexpr size_t W_BR = W_IN + (size_t)ZLD * 1024 * 2;
constexpr size_t W_OUT = W_BR + (size_t)3072 * 512 * 2;
constexpr size_t W_RT = W_OUT + (size_t)1024 * 3072 * 2;
constexpr size_t W_SU = W_RT + (size_t)256 * 2048 * 2;
constexpr size_t W_SD = W_SU + (size_t)512 * 1024 * 2;
constexpr size_t W_UP = W_SD + (size_t)1024 * 256 * 2;
constexpr size_t W_DN = W_UP + (size_t)64 * 512 * 1024 * 2;
constexpr size_t W_END = W_DN + (size_t)64 * 1024 * 256 * 2;
static_assert(W_END <= 122 * MiB, "weights");
constexpr int ZC_H2 = 4096;
constexpr size_t WS_X = 166 * MiB;
constexpr size_t WS_ACT = 302 * MiB;
constexpr size_t WS_H = 446 * MiB;
constexpr size_t WS_ZZ = 514 * MiB;
constexpr size_t WS_YE = WS_H;
constexpr size_t WS_END = 1022 * MiB;
static_assert(WS_X + (size_t)MTOK * 1024 * 4 <= WS_ACT && WS_ACT + (size_t)PMAX * 256 * 2 <= WS_H && WS_H + (size_t)MTOK * 1024 * 2 <= WS_ZZ, "ws map 1");
static_assert(WS_ZZ + (size_t)MTOK * ZLD * 2 <= WS_END && WS_YE + (size_t)PMAX * 1024 * 2 <= WS_END, "ws map 2");
constexpr size_t SCR_STRIDE = (size_t)MTOK * 512 * 2;
static_assert(4 * SCR_STRIDE <= (size_t)PMAX * 256 * 2, "scan scratch fits the act region");
constexpr int CW_BAR = 4096;
constexpr int CW_QUEUE = 16384;

constexpr int LDS_BYTES = 147456;
constexpr int MISC_OFF = 131072 + 320;

#define LDS_WAIT() asm volatile("s_waitcnt lgkmcnt(0)" ::: "memory")
#define VM_WAIT() asm volatile("s_waitcnt vmcnt(0)" ::: "memory")
__device__ __forceinline__ unsigned f2bf(float f) { unsigned u = __builtin_bit_cast(unsigned, f); return (u + 0x7fffu + ((u >> 16) & 1u)) >> 16; }
__device__ __forceinline__ float bf2f(unsigned h) { return __builtin_bit_cast(float, h << 16); }
__device__ __forceinline__ unsigned cvt_pk_bf16(float lo, float hi) { unsigned r; asm volatile("v_cvt_pk_bf16_f32 %0, %1, %2" : "=v"(r) : "v"(lo), "v"(hi)); return r; }
__device__ __forceinline__ float bflo(unsigned w) { return __builtin_bit_cast(float, w << 16); }
__device__ __forceinline__ float bfhi(unsigned w) { return __builtin_bit_cast(float, w & 0xffff0000u); }
__device__ __forceinline__ float fexp(float x) { return __builtin_amdgcn_exp2f(x * 1.4426950408889634f); }
__device__ __forceinline__ float sigmoidf_(float x) { return __builtin_amdgcn_rcpf(1.0f + fexp(-x)); }
__device__ __forceinline__ float siluf_(float x) { return x * sigmoidf_(x); }
__device__ __forceinline__ float softplusf_(float x) { return x > 20.f ? x : log1pf(__expf(x)); }
__device__ __forceinline__ float gelu_tanh(float x) { const float u = 0.7978845608028654f * (x + 0.044715f * x * x * x); const float e = fexp(2.f * u); const float th = 1.f - 2.f * __builtin_amdgcn_rcpf(e + 1.f); return 0.5f * x * (1.f + th); }
__device__ __forceinline__ float wave_sum(float v) {
#pragma unroll
    for (int o = 1; o < 64; o <<= 1) v += __shfl_xor(v, o);
    return v;
}

template <class T> __device__ __forceinline__ T* uni(T* p) { const unsigned long long v = (unsigned long long)p; const unsigned lo = __builtin_amdgcn_readfirstlane((unsigned)v), hi = __builtin_amdgcn_readfirstlane((unsigned)(v >> 32)); return (T*)(((unsigned long long)hi << 32) | lo); }
__device__ __forceinline__ int uni(int v) { return __builtin_amdgcn_readfirstlane(v); }
__device__ __forceinline__ float uni(float v) { return __builtin_bit_cast(float, __builtin_amdgcn_readfirstlane(__builtin_bit_cast(int, v))); }
extern __shared__ __attribute__((aligned(16))) unsigned char lds_raw[];
__device__ __forceinline__ int otid() { int t = threadIdx.x; asm volatile("" : "+v"(t)); return t; }

#define XB_TMO      128
#define XB_XCNT(j)  (256  + 64 * (j))
#define XB_XSUB(j)  (1280 + 64 * (j))
#define XB_XGEN(j)  (2304 + 64 * (j))
#define XB_TOP      3328
#define XB_TOPGEN   3392
#define XCD_BAR_WORDS 3456
#define XB_SPIN_CAP (1u << 20)
__device__ __forceinline__ unsigned xb_ld(unsigned* p)              { return __hip_atomic_load(p, __ATOMIC_RELAXED, __HIP_MEMORY_SCOPE_AGENT); }
__device__ __forceinline__ unsigned xb_add(unsigned* p, unsigned v) { return __hip_atomic_fetch_add(p, v, __ATOMIC_RELAXED, __HIP_MEMORY_SCOPE_AGENT); }
__device__ __forceinline__ unsigned xb_xcc_id() { return (unsigned)__builtin_amdgcn_s_getreg((3 << 11) | 20) & 0xFu; }
#define XB_SPIN(cond, bar) do { unsigned _sp = 0; while (cond) { __builtin_amdgcn_s_sleep(1); \
    if ((++_sp & 255u) == 0u) { if (xb_ld(&(bar)[XB_TMO])) break; if (_sp > XB_SPIN_CAP) { atomicAdd(&(bar)[XB_TMO], 1u); break; } } } } while (0)
struct XcdBarrier { unsigned* bar; unsigned x; volatile LAS unsigned* st; };
__device__ __forceinline__ XcdBarrier xcd_barrier_post(unsigned* bar, volatile LAS unsigned* st) {
    XcdBarrier b; b.bar = bar; b.x = xb_xcc_id(); b.st = st;
    if (threadIdx.x == 0) (void)xb_add(&bar[XB_XCNT(b.x)], 1u);
    return b;
}
__device__ __forceinline__ void xcd_barrier_complete(unsigned* bar, unsigned x, unsigned& nloc, unsigned& nx) {
    const unsigned G = gridDim.x * gridDim.y * gridDim.z;
    unsigned sum, cnt, mine, sp = 0u;
    for (;;) {
        sum = 0u; cnt = 0u; mine = 0u;
#pragma unroll
        for (unsigned j = 0; j < 16; ++j) { const unsigned c = xb_ld(&bar[XB_XCNT(j)]); sum += c; cnt += (c > 0u) ? 1u : 0u; mine = (j == x) ? c : mine; }
        if (sum == G) break;
        __builtin_amdgcn_s_sleep(1);
        if ((++sp & 255u) == 0u) { if (xb_ld(&bar[XB_TMO])) break; if (sp > XB_SPIN_CAP) { atomicAdd(&bar[XB_TMO], 1u); break; } }
    }
    nloc = mine > 0u ? mine : 1u; nx = cnt > 0u ? cnt : 1u;
}
__device__ __forceinline__ void xcd_barrier(const XcdBarrier& b) {
    asm volatile("s_waitcnt vmcnt(0)" ::: "memory");
    __syncthreads();
    if (threadIdx.x == 0) {
        unsigned* bar = b.bar;
        __builtin_amdgcn_s_waitcnt(0);
        unsigned nloc = b.st[0], nx = b.st[1];
        if (nloc == 0u) { xcd_barrier_complete(bar, b.x, nloc, nx); b.st[0] = nloc; b.st[1] = nx; }
        const unsigned old = xb_add(&bar[XB_XSUB(b.x)], 1u);
        const unsigned gen = old / nloc;
        if (old + 1u == (gen + 1u) * nloc) {
            __builtin_amdgcn_fence(__ATOMIC_RELEASE, "agent");
            asm volatile("s_waitcnt vmcnt(0)" ::: "memory");
            const unsigned og = xb_add(&bar[XB_TOP], 1u);
            const unsigned tg = og / nx;
            if (og + 1u == (tg + 1u) * nx) xb_add(&bar[XB_TOPGEN], 1u);
            else XB_SPIN(xb_ld(&bar[XB_TOPGEN]) == tg, bar);
            __builtin_amdgcn_fence(__ATOMIC_ACQUIRE, "agent");
            xb_add(&bar[XB_XGEN(b.x)], 1u);
            asm volatile("s_waitcnt vmcnt(0)" ::: "memory");
        } else {
            XB_SPIN(xb_ld(&bar[XB_XGEN(b.x)]) == gen, bar);
            __builtin_amdgcn_fence(__ATOMIC_ACQUIRE, "agent");
            asm volatile("s_waitcnt vmcnt(0)" ::: "memory");
        }
    }
    __syncthreads();
}

namespace pg8 {
constexpr int BM = 256, BK = 64, HALF = 128, HTB = HALF * BK * 2, STAGE_BYTES = 8 * HTB, NXCD = 8, WGM = 8;
__host__ __device__ __forceinline__ int lds_byte(int r, int c) { const int st = (r >> 4) * 2 + (c >> 5), rr = r & 15, cc = c & 31, ob = rr * 64 + cc * 2; return st * 1024 + (ob ^ (((ob >> 9) & 1) << 5)); }
__host__ __device__ __forceinline__ void stage_rc(int b, int& R, int& C) { const int st = b / 1024, sb = b % 1024, swz = sb ^ (((sb >> 9) & 1) << 5); R = (st >> 1) * 16 + swz / 64; C = (st & 1) * 32 + (swz % 64) / 2; }
__host__ __device__ __forceinline__ int perm32(int rho) { const int n = rho >> 4, i = rho & 15; return 8 * (i >> 2) + 4 * n + (i & 3); }
struct Unit { int pm, pn; };
struct StaticOrder {
    int nM, nN, nwg, G, c;
    __device__ void init(int nM_, int nN_, int G_, int c_) { nM = nM_; nN = nN_; nwg = nM * nN; G = G_; c = c_; }
    __device__ bool next(int i, Unit& u) const {
        const long L = (long)i * G + c; if (L >= nwg) return false;
        int wgid = (int)L; { const int q = nwg / NXCD, r = nwg % NXCD, xcd = wgid % NXCD, off = wgid / NXCD; wgid = (xcd < r ? xcd * (q + 1) : r * (q + 1) + (xcd - r) * q) + off; }
        const int nig = WGM * nN, gid = wgid / nig, fm = gid * WGM, gsz = (nM - fm) < WGM ? (nM - fm) : WGM;
        u.pm = fm + ((wgid % nig) % gsz); u.pn = (wgid % nig) / gsz; return true;
    }
};
template <class Geo, class Epi, class Sched>
__device__ __forceinline__ void gemm_phase(LAS unsigned char* lds, const Geo& g, const Sched& S, const Epi& E) {
    const int tid = otid(), wid = __builtin_amdgcn_readfirstlane(tid >> 6), lane = tid & 63, wr = wid >> 2, wc = wid & 3, fr = lane & 15, fq = lane >> 4;
    const int K = g.K, nt = K / BK;
    int Rs[2], Cs[2];
    unsigned voffB[2], vC[2][2], vN[2][2];
#pragma unroll
    for (int i = 0; i < 2; ++i) { stage_rc(tid * 16 + i * 8192, Rs[i], Cs[i]); const int Rb = Epi::PERM ? ((Rs[i] & ~31) + perm32(Rs[i] & 31)) : Rs[i];
        voffB[i] = (unsigned)(Rb * g.ldb + Cs[i]) * 2u; }
    const size_t kstep = (size_t)(BK * 2);
    const size_t hstepB = (size_t)HALF * g.ldb * 2;
    const unsigned ldsw = (unsigned)wid * 1024u;
    const int aoff = lds_byte(wr * 64 + fr, fq * 8), boff = lds_byte(wc * 32 + fr, fq * 8);
#define PG8_SA(b, h) (((b) * 2 + (h)) * HTB)
#define PG8_SB(b, h) ((4 + (b) * 2 + (h)) * HTB)
#define PG8_STAGE(bufoff, gbase, voff) do { _Pragma("unroll") for (int _i = 0; _i < 2; ++_i) \
        __builtin_amdgcn_global_load_lds((const unsigned*)((const char*)(gbase) + (voff)[_i]), (LAS unsigned*)(lds + (bufoff) + ldsw + _i * 8192), 16, 0, 0); } while (0)
#define PG8_LDA(dst, b, h) do { _Pragma("unroll") for (int m = 0; m < 4; ++m) _Pragma("unroll") for (int k = 0; k < 2; ++k) dst[m][k] = *(const LAS bf16x8*)(lds + PG8_SA(b, h) + aoff + m * 2048 + k * 1024); } while (0)
#define PG8_LDB(dst, b, h) do { _Pragma("unroll") for (int n = 0; n < 2; ++n) _Pragma("unroll") for (int k = 0; k < 2; ++k) dst[n][k] = *(const LAS bf16x8*)(lds + PG8_SB(b, h) + boff + n * 2048 + k * 1024); } while (0)
#define PG8_MMA(ai, bj, At, Bt) do { __builtin_amdgcn_s_setprio(1); _Pragma("unroll") for (int m = 0; m < 4; ++m) _Pragma("unroll") for (int n = 0; n < 2; ++n) _Pragma("unroll") for (int k = 0; k < 2; ++k) \
        acc[ai][bj][m][n] = __builtin_amdgcn_mfma_f32_16x16x32_bf16(Bt[n][k], At[m][k], acc[ai][bj][m][n], 0, 0, 0); __builtin_amdgcn_s_setprio(0); } while (0)
#define PG8_WAIT_V(n) asm volatile("s_waitcnt vmcnt(" #n ")" ::: "memory")
#define PG8_WAIT_L(n) asm volatile("s_waitcnt lgkmcnt(" #n ")" ::: "memory")
#define PG8_BAR __builtin_amdgcn_s_barrier()
#define PG8_SCHED __builtin_amdgcn_sched_barrier(0)
#define PG8_SETV(v, u) do { _Pragma("unroll") for (int _h = 0; _h < 2; ++_h) _Pragma("unroll") for (int _i = 0; _i < 2; ++_i) { \
        const unsigned _row = Geo::GATHER ? g.a_row((u), _h * HALF + Rs[_i]) : (unsigned)(_h * HALF + Rs[_i]); v[_h][_i] = (_row * (unsigned)g.lda + (unsigned)Cs[_i]) * 2u; } } while (0)
    Unit cur, nxt; int ui = 0;
    if (!S.next(0, cur)) return;
    f32x4 acc[2][2][4][2];
#pragma unroll
    for (int a = 0; a < 2; ++a)
#pragma unroll
        for (int b = 0; b < 2; ++b)
#pragma unroll
            for (int m = 0; m < 4; ++m)
#pragma unroll
                for (int n = 0; n < 2; ++n) acc[a][b][m][n] = (f32x4){0.f, 0.f, 0.f, 0.f};
    bf16x8 At[4][2], B0[2][2], B1[2][2];
    const char* cA = g.a_tile(cur); const char* cB = g.b_tile(cur);
    PG8_SETV(vC, cur);
#pragma unroll
    for (int _h = 0; _h < 2; ++_h)
#pragma unroll
        for (int _i = 0; _i < 2; ++_i) vN[_h][_i] = vC[_h][_i];
    if (Geo::GATHER) { PG8_WAIT_V(0); }
    PG8_STAGE(PG8_SB(0, 0), cB, voffB); PG8_STAGE(PG8_SB(0, 1), cB + hstepB, voffB); PG8_STAGE(PG8_SA(0, 0), cA, vC[0]); PG8_STAGE(PG8_SA(0, 1), cA, vC[1]);
    if (wr == 1) PG8_BAR;
    PG8_WAIT_V(2); PG8_BAR;
    PG8_STAGE(PG8_SB(1, 0), cB + kstep, voffB); PG8_STAGE(PG8_SA(1, 0), cA + kstep, vC[0]); PG8_STAGE(PG8_SB(1, 1), cB + hstepB + kstep, voffB);
    PG8_WAIT_V(6); PG8_BAR;
    for (;;) {
        const bool has_next = S.next(ui + 1, nxt);
        const char* nA = has_next ? g.a_tile(nxt) : cA; const char* nB = has_next ? g.b_tile(nxt) : cB;
        for (int t = 0; t < nt; t += 2) {
            const bool last = (t == nt - 2);
            const char* a1 = cA + (size_t)(t + 1) * kstep;
            const char* a2 = last ? nA : cA + (size_t)(t + 2) * kstep; const char* b2 = last ? nB : cB + (size_t)(t + 2) * kstep;
            const char* a3 = a2 + kstep; const char* b3 = b2 + kstep;
            unsigned u0[2], u1[2];
            if (Geo::GATHER) {
                if (last && has_next) { PG8_SETV(vN, nxt); }
#pragma unroll
                for (int _i = 0; _i < 2; ++_i) { u0[_i] = last ? vN[0][_i] : vC[0][_i]; u1[_i] = last ? vN[1][_i] : vC[1][_i]; }
            } else {
#pragma unroll
                for (int _i = 0; _i < 2; ++_i) { u0[_i] = vC[0][_i]; u1[_i] = vC[1][_i]; }
            }
            PG8_LDB(B0, 0, 0); PG8_LDB(B1, 0, 1); PG8_SCHED; PG8_LDA(At, 0, 0); PG8_STAGE(PG8_SA(1, 1), a1, vC[1]);
            PG8_WAIT_V(8); PG8_WAIT_L(0); PG8_BAR; PG8_MMA(0, 0, At, B0); PG8_MMA(0, 1, At, B1); PG8_BAR; PG8_SCHED;
            PG8_LDA(At, 0, 1); PG8_STAGE(PG8_SB(0, 0), b2, voffB); PG8_STAGE(PG8_SB(0, 1), b2 + hstepB, voffB); PG8_STAGE(PG8_SA(0, 0), a2, u0);
            PG8_WAIT_V(8); PG8_WAIT_L(0); PG8_BAR; PG8_MMA(1, 0, At, B0); PG8_MMA(1, 1, At, B1); PG8_BAR; PG8_SCHED;
            PG8_LDB(B0, 1, 0); PG8_LDB(B1, 1, 1); PG8_SCHED; PG8_LDA(At, 1, 0); PG8_STAGE(PG8_SA(0, 1), a2, u1);
            PG8_WAIT_V(8); PG8_WAIT_L(0); PG8_BAR; PG8_MMA(0, 0, At, B0); PG8_MMA(0, 1, At, B1); PG8_BAR; PG8_SCHED;
            PG8_LDA(At, 1, 1); PG8_STAGE(PG8_SB(1, 0), b3, voffB); PG8_STAGE(PG8_SB(1, 1), b3 + hstepB, voffB); PG8_STAGE(PG8_SA(1, 0), a3, u0);
            PG8_WAIT_V(8); PG8_WAIT_L(0); PG8_BAR; PG8_MMA(1, 0, At, B0); PG8_MMA(1, 1, At, B1); PG8_BAR; PG8_SCHED;
        }
        if (wr == 0) PG8_BAR;
        E(acc, cur, wr, wc, fr, fq);
        if (!has_next) break;
#pragma unroll
        for (int a = 0; a < 2; ++a)
#pragma unroll
            for (int b = 0; b < 2; ++b)
#pragma unroll
                for (int m = 0; m < 4; ++m)
#pragma unroll
                    for (int n = 0; n < 2; ++n) acc[a][b][m][n] = (f32x4){0.f, 0.f, 0.f, 0.f};
        cur = nxt; cA = nA; cB = nB; ++ui;
        if (Geo::GATHER) {
#pragma unroll
            for (int _h = 0; _h < 2; ++_h)
#pragma unroll
                for (int _i = 0; _i < 2; ++_i) vC[_h][_i] = vN[_h][_i];
        }
        if (wr == 1) PG8_BAR;
    }
    PG8_WAIT_V(0);
    PG8_BAR;
#undef PG8_SA
#undef PG8_SB
#undef PG8_STAGE
#undef PG8_LDA
#undef PG8_LDB
#undef PG8_MMA
#undef PG8_WAIT_V
#undef PG8_WAIT_L
#undef PG8_BAR
#undef PG8_SCHED
#undef PG8_SETV
}
}

struct GeoPlain {
    static constexpr bool GATHER = false;
    const bf16* A; const bf16* Bt; int K, lda, ldb;
    __device__ __forceinline__ const char* a_tile(const pg8::Unit& u) const { return (const char*)(A + (size_t)u.pm * 256 * lda); }
    __device__ __forceinline__ const char* b_tile(const pg8::Unit& u) const { return (const char*)(Bt + (size_t)u.pn * 256 * ldb); }
    __device__ __forceinline__ unsigned a_row(const pg8::Unit&, int R) const { return (unsigned)R; }
};
struct GeoMergeA {
    static constexpr bool GATHER = false;
    const bf16* ZZ; const bf16* Bt; int K, lda, ldb;
    __device__ __forceinline__ const char* a_tile(const pg8::Unit& u) const { const int br = u.pn >> 2; const int co = br == 0 ? ZC_Q : (br == 1 ? ZC_LG : ZC_Z); return (const char*)(ZZ + (size_t)u.pm * 256 * ZLD + co); }
    __device__ __forceinline__ const char* b_tile(const pg8::Unit& u) const { return (const char*)(Bt + (size_t)u.pn * 256 * 512); }
    __device__ __forceinline__ unsigned a_row(const pg8::Unit&, int R) const { return (unsigned)R; }
};
struct GeoMoeUp {
    static constexpr bool GATHER = true;
    const bf16* A; const bf16* Bt; const int* row_tok; const int* tile_e; int K, lda, ldb;
    __device__ __forceinline__ const char* a_tile(const pg8::Unit&) const { return (const char*)A; }
    __device__ __forceinline__ const char* b_tile(const pg8::Unit& u) const { const int e = tile_e[u.pm]; return (const char*)(Bt + ((size_t)e * 512 + (size_t)u.pn * 256) * 1024); }
    __device__ __forceinline__ unsigned a_row(const pg8::Unit& u, int R) const { return (unsigned)row_tok[u.pm * 256 + R]; }
};
struct GeoMoeDown {
    static constexpr bool GATHER = false;
    const bf16* A; const bf16* Bt; const int* tile_e; int K, lda, ldb;
    __device__ __forceinline__ const char* a_tile(const pg8::Unit& u) const { return (const char*)(A + (size_t)u.pm * 256 * 256); }
    __device__ __forceinline__ const char* b_tile(const pg8::Unit& u) const { const int e = tile_e[u.pm]; return (const char*)(Bt + ((size_t)e * 1024 + (size_t)u.pn * 256) * 256); }
    __device__ __forceinline__ unsigned a_row(const pg8::Unit&, int R) const { return (unsigned)R; }
};

struct EpiInProj {
    static constexpr bool PERM = true;
    bf16* ZZ; const float* cosT; const float* sinT;
    __device__ __forceinline__ void operator()(const f32x4 (&acc)[2][2][4][2], const pg8::Unit& u, int wr, int wc, int fr, int fq) const {
        const int row0 = u.pm * 256 + wr * 64 + fr, colt = u.pn * 256 + wc * 32 + 8 * fq;
        const int kind = u.pn < 4 ? 0 : ((u.pn >= 16 && u.pn < 28) ? 2 : 1);
#pragma unroll
        for (int ai = 0; ai < 2; ++ai)
#pragma unroll
            for (int m = 0; m < 4; ++m) {
                const int row = row0 + ai * 128 + m * 16;
                bf16* rowp = ZZ + (size_t)row * ZLD + colt;
#pragma unroll
                for (int bj = 0; bj < 2; ++bj) {
                    f32x4 v0 = acc[ai][bj][m][0], v1 = acc[ai][bj][m][1];
                    if (kind == 0) {
                        if (row < NLAT) {
                            const int t = row & 4095, i0 = ((colt + bj * 128) & 63) >> 1;
                            const f32x4 c = *(const f32x4*)(cosT + t * 32 + i0), s = *(const f32x4*)(sinT + t * 32 + i0);
                            f32x4 a, b;
                            a[0] = v0[0] * c[0] - v0[1] * s[0]; a[1] = v0[1] * c[0] + v0[0] * s[0];
                            a[2] = v0[2] * c[1] - v0[3] * s[1]; a[3] = v0[3] * c[1] + v0[2] * s[1];
                            b[0] = v1[0] * c[2] - v1[1] * s[2]; b[1] = v1[1] * c[2] + v1[0] * s[2];
                            b[2] = v1[2] * c[3] - v1[3] * s[3]; b[3] = v1[3] * c[3] + v1[2] * s[3];
                            v0 = a; v1 = b;
                        }
                    } else if (kind == 2) {
#pragma unroll
                        for (int j = 0; j < 4; ++j) { v0[j] = sigmoidf_(v0[j]); v1[j] = sigmoidf_(v1[j]); }
                    }
                    u32x4 w; w.x = cvt_pk_bf16(v0[0], v0[1]); w.y = cvt_pk_bf16(v0[2], v0[3]); w.z = cvt_pk_bf16(v1[0], v1[1]); w.w = cvt_pk_bf16(v1[2], v1[3]);
                    *(u32x4*)(rowp + bj * 128) = w;
                }
            }
    }
};
struct EpiMergeA {
    static constexpr bool PERM = true;
    bf16* ZZ;
    __device__ __forceinline__ void operator()(const f32x4 (&acc)[2][2][4][2], const pg8::Unit& u, int wr, int wc, int fr, int fq) const {
        const int row0 = u.pm * 256 + wr * 64 + fr, colt = ZC_GATE + u.pn * 256 + wc * 32 + 8 * fq;
#pragma unroll
        for (int ai = 0; ai < 2; ++ai)
#pragma unroll
            for (int m = 0; m < 4; ++m) {
                bf16* rowp = ZZ + (size_t)(row0 + ai * 128 + m * 16) * ZLD + colt;
#pragma unroll
                for (int bj = 0; bj < 2; ++bj) {
                    const u32x4 gq = *(const u32x4*)(rowp + bj * 128);
                    const f32x4 v0 = acc[ai][bj][m][0], v1 = acc[ai][bj][m][1];
                    u32x4 w;
                    w.x = cvt_pk_bf16(v0[0] * bflo(gq.x), v0[1] * bfhi(gq.x)); w.y = cvt_pk_bf16(v0[2] * bflo(gq.y), v0[3] * bfhi(gq.y));
                    w.z = cvt_pk_bf16(v1[0] * bflo(gq.z), v1[1] * bfhi(gq.z)); w.w = cvt_pk_bf16(v1[2] * bflo(gq.w), v1[3] * bfhi(gq.w));
                    *(u32x4*)(rowp + bj * 128) = w;
                }
            }
    }
};
struct EpiBf16Plain {
    static constexpr bool PERM = true;
    bf16* O; int ldc;
    __device__ __forceinline__ void operator()(const f32x4 (&acc)[2][2][4][2], const pg8::Unit& u, int wr, int wc, int fr, int fq) const {
        const int row0 = u.pm * 256 + wr * 64 + fr, colt = u.pn * 256 + wc * 32 + 8 * fq;
#pragma unroll
        for (int ai = 0; ai < 2; ++ai)
#pragma unroll
            for (int m = 0; m < 4; ++m) {
                bf16* rowp = O + (size_t)(row0 + ai * 128 + m * 16) * ldc + colt;
#pragma unroll
                for (int bj = 0; bj < 2; ++bj) {
                    const f32x4 v0 = acc[ai][bj][m][0], v1 = acc[ai][bj][m][1];
                    u32x4 w; w.x = cvt_pk_bf16(v0[0], v0[1]); w.y = cvt_pk_bf16(v0[2], v0[3]); w.z = cvt_pk_bf16(v1[0], v1[1]); w.w = cvt_pk_bf16(v1[2], v1[3]);
                    *(u32x4*)(rowp + bj * 128) = w;
                }
            }
    }
};
template <bool ROUTED> struct EpiSwiGLU {
    static constexpr bool PERM = true;
    bf16* O; const float* roww;
    __device__ __forceinline__ void operator()(const f32x4 (&acc)[2][2][4][2], const pg8::Unit& u, int wr, int wc, int fr, int fq) const {
        const int row0 = u.pm * 256 + wr * 64 + fr, colt = u.pn * 128 + wc * 32 + 8 * fq;
#pragma unroll
        for (int ai = 0; ai < 2; ++ai)
#pragma unroll
            for (int m = 0; m < 4; ++m) {
                const int row = row0 + ai * 128 + m * 16;
                const float rw = ROUTED ? roww[row] : 1.0f;
                const f32x4 g0 = acc[ai][0][m][0], g1 = acc[ai][0][m][1], u0 = acc[ai][1][m][0], u1 = acc[ai][1][m][1];
                f32x4 a, b;
#pragma unroll
                for (int j = 0; j < 4; ++j) { a[j] = siluf_(g0[j]) * u0[j] * rw; b[j] = siluf_(g1[j]) * u1[j] * rw; }
                u32x4 w; w.x = cvt_pk_bf16(a[0], a[1]); w.y = cvt_pk_bf16(a[2], a[3]); w.z = cvt_pk_bf16(b[0], b[1]); w.w = cvt_pk_bf16(b[2], b[3]);
                *(u32x4*)(O + (size_t)row * 256 + colt) = w;
            }
    }
};
struct EpiRouter {
    static constexpr bool PERM = false;
    float* L;
    __device__ __forceinline__ void operator()(const f32x4 (&acc)[2][2][4][2], const pg8::Unit& u, int wr, int wc, int fr, int fq) const {
        if (wc >= 2) return;
        const int row0 = u.pm * 256 + wr * 64 + fr, col0 = wc * 32 + 4 * fq;
#pragma unroll
        for (int ai = 0; ai < 2; ++ai)
#pragma unroll
            for (int m = 0; m < 4; ++m) {
                float* rowp = L + (size_t)(row0 + ai * 128 + m * 16) * 64 + col0;
#pragma unroll
                for (int n = 0; n < 2; ++n) *(f32x4*)(rowp + n * 16) = acc[ai][0][m][n] + acc[ai][1][m][n];
            }
    }
};
struct EpiSharedDown {
    static constexpr bool PERM = false;
    float* X; const float* modl;
    __device__ __forceinline__ void operator()(const f32x4 (&acc)[2][2][4][2], const pg8::Unit& u, int wr, int wc, int fr, int fq) const {
        const int row0 = u.pm * 256 + wr * 64 + fr, col0 = u.pn * 256 + wc * 32 + 4 * fq;
#pragma unroll
        for (int ai = 0; ai < 2; ++ai)
#pragma unroll
            for (int m = 0; m < 4; ++m) {
                const int row = row0 + ai * 128 + m * 16;
                const int mr = row < NLAT ? (row >> 12) : 8;
                float* rowp = X + (size_t)row * 1024 + col0;
                const float* m5 = modl + (size_t)mr * 6144 + 5 * 1024 + col0;
#pragma unroll
                for (int bj = 0; bj < 2; ++bj)
#pragma unroll
                    for (int n = 0; n < 2; ++n) {
                        const f32x4 xv = *(const f32x4*)(rowp + bj * 128 + n * 16), gv = *(const f32x4*)(m5 + bj * 128 + n * 16);
                        *(f32x4*)(rowp + bj * 128 + n * 16) = xv * DN_ALPHA + gv * acc[ai][bj][m][n];
                    }
            }
    }
};

namespace att {
constexpr int KVBLK = 64;
constexpr float SCALE = 0.125f, THR = 8.f;
constexpr size_t SHM_V = KVBLK * 128 * 2, SHM_K = KVBLK * 128 * 2;
constexpr size_t SHM_ATTN = 2 * SHM_V + 2 * SHM_K + 8 * 64 * 4;
#define KSWZ(row, colB) ((row) * 256 + ((colB) ^ (((row) & 7) << 4)))
#define SBAR() __builtin_amdgcn_sched_barrier(0)
__device__ __forceinline__ int crow(int r, int hi) { return (r & 3) + 8 * (r >> 2) + 4 * hi; }
__device__ __forceinline__ void partialSM(f32x16& p0, f32x16& p1, float& m_reg, float& mn, float& alpha) {
  constexpr float C = SCALE * 1.4426950408889634f;
  float pmax = p0[0];
#pragma unroll
  for (int r = 1; r < 16; ++r) pmax = fmaxf(pmax, p0[r]);
#pragma unroll
  for (int r = 0; r < 16; ++r) pmax = fmaxf(pmax, p1[r]);
  { auto rr = __builtin_amdgcn_permlane32_swap(__float_as_uint(pmax), __float_as_uint(pmax), false, false);
    pmax = fmaxf(__uint_as_float(rr[0]), __uint_as_float(rr[1])); }
  if (__builtin_expect(__all(pmax - m_reg <= THR / SCALE), 1)) { mn = m_reg; alpha = 1.f; }
  else { mn = fmaxf(m_reg, pmax); alpha = __builtin_amdgcn_exp2f((m_reg - mn) * C); m_reg = mn; }
  float mnC = -mn * C;
#pragma unroll
  for (int r = 0; r < 16; ++r) p0[r] = fmaf(p0[r], C, mnC);
#pragma unroll
  for (int r = 0; r < 16; ++r) p1[r] = fmaf(p1[r], C, mnC);
#pragma unroll
  for (int r = 0; r < 16; ++r) p0[r] = __builtin_amdgcn_exp2f(p0[r]);
}
__device__ __forceinline__ void finishSM(f32x16& p0, f32x16& p1, float alpha, float& l_reg, bf16x8& pa0, bf16x8& pa1, bf16x8& pa2, bf16x8& pa3) {
#pragma unroll
  for (int r = 0; r < 16; ++r) p1[r] = __builtin_amdgcn_exp2f(p1[r]);
  float ps = 0;
#pragma unroll
  for (int r = 0; r < 16; ++r) ps += p0[r];
#pragma unroll
  for (int r = 0; r < 16; ++r) ps += p1[r];
  { auto rr = __builtin_amdgcn_permlane32_swap(__float_as_uint(ps), __float_as_uint(ps), false, false);
    ps = __uint_as_float(rr[0]) + __uint_as_float(rr[1]); }
  l_reg = l_reg * alpha + ps;
#define PK4(P, BASE, OUT) do { unsigned a0 = cvt_pk_bf16(P[BASE + 0], P[BASE + 1]), a1 = cvt_pk_bf16(P[BASE + 2], P[BASE + 3]);   \
    unsigned b0 = cvt_pk_bf16(P[BASE + 4], P[BASE + 5]), b1 = cvt_pk_bf16(P[BASE + 6], P[BASE + 7]);                              \
    auto r0 = __builtin_amdgcn_permlane32_swap(a0, b0, false, false); auto r1 = __builtin_amdgcn_permlane32_swap(a1, b1, false, false); \
    u32x4 w = {r0[0], r1[0], r0[1], r1[1]}; OUT = *reinterpret_cast<bf16x8*>(&w); } while (0)
  PK4(p0, 0, pa0); PK4(p0, 8, pa1); PK4(p1, 0, pa2); PK4(p1, 8, pa3);
#undef PK4
}
__device__ __forceinline__ void qkt(f32x16& p0, f32x16& p1, const char* Ks, const bf16x8 (&qr)[4], int r32, int hi, int mcol) {
  p0 = f32x16{}; p1 = f32x16{};
#pragma unroll
  for (int d0 = 0; d0 < 4; ++d0) { int cb = (mcol + d0 * 16 + hi * 8) * 2;
    bf16x8 b0 = *reinterpret_cast<const bf16x8*>(Ks + KSWZ(r32, cb));
    bf16x8 b1 = *reinterpret_cast<const bf16x8*>(Ks + KSWZ(32 + r32, cb));
    p0 = __builtin_amdgcn_mfma_f32_32x32x16_bf16(b0, qr[d0], p0, 0, 0, 0);
    p1 = __builtin_amdgcn_mfma_f32_32x32x16_bf16(b1, qr[d0], p1, 0, 0, 0); }
}
__device__ __forceinline__ int v_st(int k, int c) { const int kk = (k & ~0xC) | ((k & 4) << 1) | ((k & 8) >> 1); return ((kk >> 3) * 4 + (c >> 5)) * 512 + ((kk & 7) * 32 + (c & 31)) * 2; }
__device__ __forceinline__ int v_rd_base(int lane) { return ((lane & 3) << 3) | (((lane >> 2) & 3) << 6) | (((lane >> 4) & 1) << 5) | (((lane >> 5) & 1) << 8); }
constexpr int v_rd_off(int d0, int ks, int half) { return d0 * 512 + ks * 4096 + half * 2048; }
template <int OFF> __device__ __forceinline__ s16x4 tr_read(int vb) {
  s16x4 r; asm volatile("ds_read_b64_tr_b16 %0, %1 offset:%2" : "=&v"(r) : "v"(vb), "i"(OFF) : "memory"); return r;
}
template <int D0> __device__ __forceinline__ void pv_one(f32x16& od, int vb, bf16x8 pa0, bf16x8 pa1, bf16x8 pa2, bf16x8 pa3) {
  const s16x4 l0 = tr_read<v_rd_off(D0, 0, 0)>(vb), h0 = tr_read<v_rd_off(D0, 0, 1)>(vb), l1 = tr_read<v_rd_off(D0, 1, 0)>(vb), h1 = tr_read<v_rd_off(D0, 1, 1)>(vb);
  const s16x4 l2 = tr_read<v_rd_off(D0, 2, 0)>(vb), h2 = tr_read<v_rd_off(D0, 2, 1)>(vb), l3 = tr_read<v_rd_off(D0, 3, 0)>(vb), h3 = tr_read<v_rd_off(D0, 3, 1)>(vb);
  asm volatile("s_waitcnt lgkmcnt(0)" ::: "memory"); SBAR();
#define PK(L, H) (bf16x8){L[0], L[1], L[2], L[3], H[0], H[1], H[2], H[3]}
  od = __builtin_amdgcn_mfma_f32_32x32x16_bf16(pa0, PK(l0, h0), od, 0, 0, 0);
  od = __builtin_amdgcn_mfma_f32_32x32x16_bf16(pa1, PK(l1, h1), od, 0, 0, 0);
  od = __builtin_amdgcn_mfma_f32_32x32x16_bf16(pa2, PK(l2, h2), od, 0, 0, 0);
  od = __builtin_amdgcn_mfma_f32_32x32x16_bf16(pa3, PK(l3, h3), od, 0, 0, 0);
#undef PK
}
__device__ __forceinline__ void pv_d0(f32x16* o, int vb, bf16x8 pa0, bf16x8 pa1, bf16x8 pa2, bf16x8 pa3) {
  pv_one<0>(o[0], vb, pa0, pa1, pa2, pa3); pv_one<1>(o[1], vb, pa0, pa1, pa2, pa3); pv_one<2>(o[2], vb, pa0, pa1, pa2, pa3); pv_one<3>(o[3], vb, pa0, pa1, pa2, pa3);
}
static __device__ __forceinline__ void attn_unit(bf16* __restrict__ ZZ_, int qrow0_, int h_, int krowA_, int ntA_, int krowB_, int NT_, float lam_, const float* __restrict__ gn_, float oscale_) {
  bf16* __restrict__ ZZ = uni(ZZ_); const int qrow0 = uni(qrow0_), h = uni(h_), krowA = uni(krowA_), ntA = uni(ntA_), krowB = uni(krowB_), NT = uni(NT_); const float lam = uni(lam_), oscale = uni(oscale_); const float* __restrict__ gn = uni(gn_);
  char* lds = (char*)lds_raw;
  const int tid = otid(), wid = tid >> 6, lane = tid & 63, r32 = lane & 31, hi = lane >> 5;
  const int map = wid >> 2, wq = wid & 3, mcol = map * 64;
  char* V_lds = lds; char* K_lds = lds + 2 * SHM_V;
  float* ws = (float*)(lds + 2 * SHM_V + 2 * SHM_K) + wid * 64; float* li_l = ws; float* al_l = ws + 32;
  float m_reg = -1e30f, l_reg = 0; f32x16 o[4] = {}; bf16x8 qr[4];
  const bf16* Qw = ZZ + (size_t)(qrow0 + wq * 32 + r32) * ZLD + ZC_Q + h * 128 + mcol + hi * 8;
#pragma unroll
  for (int d0 = 0; d0 < 4; ++d0) qr[d0] = *reinterpret_cast<const bf16x8*>(Qw + d0 * 16);
  const int sr = tid >> 4, sc = (tid & 15) * 8, vst0 = v_st(sr, sc), vst1 = v_st(32 + sr, sc);
  const int vb0 = (int)(uintptr_t)(LAS char*)V_lds + v_rd_base(lane);
  const bf16* Kcol = ZZ + ZC_K + h * 128 + sc; const bf16* Vcol = ZZ + ZC_V + h * 128 + sc;
  struct { bf16x8 vs0, vs1, ks0, ks1; } sr_[2];
#define KROW(j) ((j) < ntA ? krowA + (j) * KVBLK : krowB + ((j) - ntA) * KVBLK)
#define SLOAD(i, j) do { const size_t _r0 = (size_t)(KROW(j) + sr) * ZLD, _r1 = _r0 + (size_t)32 * ZLD; \
    sr_[i].vs0 = *reinterpret_cast<const bf16x8*>(Vcol + _r0); sr_[i].vs1 = *reinterpret_cast<const bf16x8*>(Vcol + _r1); \
    sr_[i].ks0 = *reinterpret_cast<const bf16x8*>(Kcol + _r0); sr_[i].ks1 = *reinterpret_cast<const bf16x8*>(Kcol + _r1); } while (0)
#define SWRITE(b, i) do { *(bf16x8*)(V_lds + (b) * SHM_V + vst0) = sr_[i].vs0;          \
    *(bf16x8*)(V_lds + (b) * SHM_V + vst1) = sr_[i].vs1; int kc = sc * 2;               \
    *(bf16x8*)(K_lds + (b) * SHM_K + KSWZ(sr, kc)) = sr_[i].ks0;                       \
    *(bf16x8*)(K_lds + (b) * SHM_K + KSWZ(32 + sr, kc)) = sr_[i].ks1; } while (0)
#define SWAIT() asm volatile("s_waitcnt vmcnt(4)" ::: "memory")
#define RESC(a) do { if (__any((a) < 1.f)) { if (hi == 0) al_l[r32] = (a); asm volatile("s_waitcnt lgkmcnt(0)" ::: "memory"); \
    _Pragma("unroll") for (int d = 0; d < 4; ++d) _Pragma("unroll") for (int r = 0; r < 16; ++r) o[d][r] *= al_l[crow(r, hi)]; } } while (0)
  f32x16 pA0, pA1, pB0, pB1; float mnA, mnB, alA, alB; bf16x8 pa0, pa1, pa2, pa3;
  constexpr int SE = 0, SO = 1;
  SLOAD(SE, 0); asm volatile("s_waitcnt vmcnt(0)" ::: "memory"); SWRITE(0, SE); __syncthreads();
  qkt(pA0, pA1, K_lds, qr, r32, hi, mcol); partialSM(pA0, pA1, m_reg, mnA, alA);
  SLOAD(SO, 1); if (2 < NT) SLOAD(SE, 2);
  SWAIT(); SWRITE(1, SO); __syncthreads();
  for (int j = 1; j + 1 < NT; j += 2) {
    SBAR(); qkt(pB0, pB1, K_lds + SHM_K, qr, r32, hi, mcol);
    finishSM(pA0, pA1, alA, l_reg, pa0, pa1, pa2, pa3); SBAR();
    SLOAD(SO, j + 2); SBAR();
    pv_d0(o, vb0, pa0, pa1, pa2, pa3); partialSM(pB0, pB1, m_reg, mnB, alB);
    __syncthreads(); SWAIT(); SWRITE(0, SE);
    RESC(alB); __syncthreads();
    SBAR(); qkt(pA0, pA1, K_lds, qr, r32, hi, mcol);
    finishSM(pB0, pB1, alB, l_reg, pa0, pa1, pa2, pa3); SBAR();
    if (j + 3 < NT) SLOAD(SE, j + 3); SBAR();
    pv_d0(o, vb0 + (int)SHM_V, pa0, pa1, pa2, pa3); partialSM(pA0, pA1, m_reg, mnA, alA);
    __syncthreads(); SWAIT(); SWRITE(1, SO);
    RESC(alA); __syncthreads();
  }
  SBAR(); qkt(pB0, pB1, K_lds + SHM_K, qr, r32, hi, mcol);
  finishSM(pA0, pA1, alA, l_reg, pa0, pa1, pa2, pa3); SBAR();
  pv_d0(o, vb0, pa0, pa1, pa2, pa3); partialSM(pB0, pB1, m_reg, mnB, alB);
  __syncthreads(); RESC(alB);
  finishSM(pB0, pB1, alB, l_reg, pa0, pa1, pa2, pa3); SBAR();
  pv_d0(o, vb0 + (int)SHM_V, pa0, pa1, pa2, pa3);
  if (hi == 0) li_l[r32] = l_reg; asm volatile("s_waitcnt lgkmcnt(0)" ::: "memory");
  float rli[16];
#pragma unroll
  for (int r = 0; r < 16; ++r) rli[r] = __builtin_amdgcn_rcpf(li_l[crow(r, hi)]);
  __syncthreads();
  float* xch = (float*)lds + (size_t)wq * 4096;
  if (map == 1) {
#pragma unroll
    for (int d0 = 0; d0 < 4; ++d0)
#pragma unroll
      for (int r = 0; r < 16; ++r) xch[(d0 * 16 + r) * 64 + lane] = o[d0][r] * rli[r];
  }
  __syncthreads();
  if (map == 0) {
    float ss[16];
#pragma unroll
    for (int r = 0; r < 16; ++r) ss[r] = 0.f;
#pragma unroll
    for (int d0 = 0; d0 < 4; ++d0)
#pragma unroll
      for (int r = 0; r < 16; ++r) { const float v = o[d0][r] * rli[r] - lam * xch[(d0 * 16 + r) * 64 + lane]; o[d0][r] = v; ss[r] += v * v; }
#pragma unroll
    for (int r = 0; r < 16; ++r) {
#pragma unroll
      for (int off = 1; off < 32; off <<= 1) ss[r] += __shfl_xor(ss[r], off);
      ss[r] = __builtin_amdgcn_rsqf(ss[r] * (1.0f / 128.0f) + RMS_EPS) * oscale;
    }
    float gv[4];
#pragma unroll
    for (int d0 = 0; d0 < 4; ++d0) gv[d0] = gn[d0 * 32 + r32];
    bf16* Ow = ZZ + (size_t)(qrow0 + wq * 32) * ZLD + ZC_Q + h * 128 + r32;
#pragma unroll
    for (int r = 0; r < 16; ++r) { const int orow = crow(r, hi);
#pragma unroll
      for (int d0 = 0; d0 < 4; ++d0) Ow[(size_t)orow * ZLD + d0 * 32] = (bf16)f2bf(o[d0][r] * ss[r] * gv[d0]); }
  }
#undef KROW
#undef SLOAD
#undef SWRITE
#undef SWAIT
#undef RESC
}
#undef KSWZ
#undef SBAR
}

__device__ __forceinline__ f32x4 mma_tile(const LAS char* A, int sa, const LAS char* B, int sb, int ksteps, int lane, f32x4 acc) {
    const int r = lane & 15, q = lane >> 4;
    for (int k = 0; k < ksteps; ++k) {
        const bf16x8 a = *(const LAS bf16x8*)(A + r * sa + (k * 32 + q * 8) * 2);
        const bf16x8 b = *(const LAS bf16x8*)(B + r * sb + (k * 32 + q * 8) * 2);
        acc = __builtin_amdgcn_mfma_f32_16x16x32_bf16(a, b, acc, 0, 0, 0);
    }
    return acc;
}

namespace ssd {
constexpr int T = 64, SC = 136 * 2, SS = 72 * 2;
constexpr int O_CM = 0, O_BM = O_CM + 64 * SC, O_BMT = O_BM + 64 * SC, O_XDT = O_BMT + 128 * SS, O_XWT = O_XDT + 64 * SS, O_MM = O_XWT + 64 * SS, O_SB = O_MM + 64 * SS;
constexpr int O_XSK = O_SB + 64 * SC, O_ACS = O_XSK + 64 * 65 * 4, O_CW = O_ACS + 512, O_END = O_CW + 320 * 5 * 4;
static_assert(O_END <= 131072, "ssd lds");
struct Par { const bf16* ZZ; bf16* Y; const float* conv_w; const float* conv_b; float dtb, A, Dskip; int b, h, d; };
static __device__ __forceinline__ void unit(Par P_) {
    Par P; P.ZZ = uni(P_.ZZ); P.Y = uni(P_.Y); P.conv_w = uni(P_.conv_w); P.conv_b = uni(P_.conv_b); P.dtb = uni(P_.dtb); P.A = uni(P_.A); P.Dskip = uni(P_.Dskip); P.b = uni(P_.b); P.h = uni(P_.h); P.d = uni(P_.d);
    LAS char* lds = (LAS char*)lds_raw;
    const int tid = otid(), wid = __builtin_amdgcn_readfirstlane(tid >> 6), lane = tid & 63, fr = lane & 15, fq = lane >> 4;
    const int g = P.h >> 2;
    LAS float* ACS = (LAS float*)(lds + O_ACS); LAS float* DTV = ACS + 64; LAS float* CW = (LAS float*)(lds + O_CW); LAS float* XSK = (LAS float*)(lds + O_XSK);
    for (int i = tid; i < 320 * 5; i += 512) { const int lc = i / 5, j = i % 5; const int c = lc < 64 ? P.h * 64 + lc : (lc < 192 ? 512 + g * 128 + (lc - 64) : 768 + g * 128 + (lc - 192));
        CW[i] = j < 4 ? P.conv_w[j * 1024 + c] : P.conv_b[c]; }
    for (int i = tid; i < 64 * SC / 4; i += 512) ((LAS unsigned*)(lds + O_SB))[i] = 0u;
    f32x4 Sacc[4];
#pragma unroll
    for (int i = 0; i < 4; ++i) Sacc[i] = (f32x4){0.f, 0.f, 0.f, 0.f};
    __syncthreads();
    for (int ch = 0; ch < 68; ++ch) {
        const bool isctx = ch < 4; const int cc = isctx ? ch : ch - 4; const int Ls = isctx ? CTXL : SEQ; const int rseg = isctx ? NLAT + P.b * CTXL : P.b * SEQ;
        if (wid == 0) {
            const int sp = cc * 64 + lane; const int tk = P.d ? Ls - 1 - sp : sp;
            const float raw = bf2f(P.ZZ[(size_t)(rseg + tk) * ZLD + ZC_DT + P.d * 8 + P.h]);
            const float dt = softplusf_(raw + P.dtb); float v = dt * P.A;
#pragma unroll
            for (int off = 1; off < 64; off <<= 1) { const float t = __shfl_up(v, off); if (lane >= off) v += t; }
            ACS[lane] = v; DTV[lane] = dt;
        }
        __syncthreads();
        const float acs_end = ACS[63];
        for (int it = tid; it < 64 * 40; it += 512) {
            const int pos = it / 40, oc = it % 40, lc0 = oc * 8;
            const int sp = cc * 64 + pos; const int tk = P.d ? Ls - 1 - sp : sp;
            const int c0 = lc0 < 64 ? P.h * 64 + lc0 : (lc0 < 192 ? 512 + g * 128 + (lc0 - 64) : 768 + g * 128 + (lc0 - 192));
            float u[8];
#pragma unroll
            for (int e = 0; e < 8; ++e) u[e] = CW[(lc0 + e) * 5 + 4];
#pragma unroll
            for (int j = 0; j < 4; ++j) { const int t2 = tk + j - 2;
                if (t2 >= 0 && t2 < Ls) { const u32x4 xv = *(const u32x4*)(P.ZZ + (size_t)(rseg + t2) * ZLD + ZC_XBC + c0);
                    u[0] += bflo(xv.x) * CW[(lc0 + 0) * 5 + j]; u[1] += bfhi(xv.x) * CW[(lc0 + 1) * 5 + j]; u[2] += bflo(xv.y) * CW[(lc0 + 2) * 5 + j]; u[3] += bfhi(xv.y) * CW[(lc0 + 3) * 5 + j];
                    u[4] += bflo(xv.z) * CW[(lc0 + 4) * 5 + j]; u[5] += bfhi(xv.z) * CW[(lc0 + 5) * 5 + j]; u[6] += bflo(xv.w) * CW[(lc0 + 6) * 5 + j]; u[7] += bfhi(xv.w) * CW[(lc0 + 7) * 5 + j]; } }
#pragma unroll
            for (int e = 0; e < 8; ++e) u[e] = siluf_(u[e]);
            if (lc0 < 64) {
                const float dt = DTV[pos], wgt = fexp(acs_end - ACS[pos]);
#pragma unroll
                for (int e = 0; e < 8; ++e) { const int p = lc0 + e; const float xd = u[e] * dt;
                    *(LAS bf16*)(lds + O_XDT + p * SS + pos * 2) = (bf16)f2bf(xd); *(LAS bf16*)(lds + O_XWT + p * SS + pos * 2) = (bf16)f2bf(xd * wgt);
                    XSK[pos * 65 + p] = P.Dskip * u[e]; }
            } else {
                u32x4 w; w.x = cvt_pk_bf16(u[0], u[1]); w.y = cvt_pk_bf16(u[2], u[3]); w.z = cvt_pk_bf16(u[4], u[5]); w.w = cvt_pk_bf16(u[6], u[7]);
                if (lc0 < 192) { const int n0 = lc0 - 64; *(LAS u32x4*)(lds + O_BM + pos * SC + n0 * 2) = w;
#pragma unroll
                    for (int e = 0; e < 8; ++e) *(LAS bf16*)(lds + O_BMT + (n0 + e) * SS + pos * 2) = (bf16)f2bf(u[e]);
                } else { const int n0 = lc0 - 192; *(LAS u32x4*)(lds + O_CM + pos * SC + n0 * 2) = w; }
            }
        }
        __syncthreads();
        const int lt = wid >> 1, h2 = wid & 1;
        f32x4 yo[2];
#pragma unroll
        for (int i = 0; i < 2; ++i) {
            const int st = h2 * 2 + i;
            f32x4 gacc = (f32x4){0.f, 0.f, 0.f, 0.f};
            if (st <= lt) gacc = mma_tile(lds + O_CM + lt * 16 * SC, SC, lds + O_BM + st * 16 * SC, SC, 4, lane, gacc);
            const int s = st * 16 + fr; const float as = ACS[s];
#pragma unroll
            for (int jj = 0; jj < 4; ++jj) { const int l = lt * 16 + fq * 4 + jj; const float v = (s <= l) ? gacc[jj] * fexp(ACS[l] - as) : 0.f;
                *(LAS bf16*)(lds + O_MM + l * SS + s * 2) = (bf16)f2bf(v); }
            yo[i] = mma_tile(lds + O_CM + lt * 16 * SC, SC, lds + O_SB + st * 16 * SC, SC, 4, lane, (f32x4){0.f, 0.f, 0.f, 0.f});
        }
        __syncthreads();
#pragma unroll
        for (int i = 0; i < 2; ++i) {
            const int pt = h2 * 2 + i;
            const f32x4 yd = mma_tile(lds + O_MM + lt * 16 * SS, SS, lds + O_XDT + pt * 16 * SS, SS, 2, lane, (f32x4){0.f, 0.f, 0.f, 0.f});
            const int p = pt * 16 + fr;
#pragma unroll
            for (int jj = 0; jj < 4; ++jj) { const int l = lt * 16 + fq * 4 + jj; float y = yd[jj] + fexp(ACS[l]) * yo[i][jj]; if (P.d == 0) y += XSK[l * 65 + p];
                const int sp = cc * 64 + l; const int tk = P.d ? Ls - 1 - sp : sp;
                P.Y[(size_t)(rseg + tk) * 512 + P.h * 64 + p] = (bf16)f2bf(y); }
        }
        { const float dec = fexp(acs_end); const int pt = lt;
#pragma unroll
          for (int i = 0; i < 4; ++i) { const int nt = h2 * 4 + i;
              Sacc[i] = mma_tile(lds + O_XWT + pt * 16 * SS, SS, lds + O_BMT + nt * 16 * SS, SS, 2, lane, Sacc[i] * dec);
              const int n = nt * 16 + fr;
#pragma unroll
              for (int jj = 0; jj < 4; ++jj) { const int p = pt * 16 + fq * 4 + jj; *(LAS bf16*)(lds + O_SB + p * SC + n * 2) = (bf16)f2bf(Sacc[i][jj]); } } }
        __syncthreads();
    }
}
}

namespace lru {
constexpr int SS = 72 * 2;
constexpr int O_U = 0, O_WA = O_U + 128 * SS, O_WI = O_WA + 64 * SS, O_HL = O_WI + 64 * SS, O_CP = O_HL + 32768, O_AGG = O_CP + 32768, O_CW = O_AGG + 8 * 2 * 64 * 4, O_END = O_CW + 64 * 5 * 4;
static_assert(O_END <= 131072, "lru lds");
struct Par { const bf16* ZZ; bf16* Hout; const float* conv_w; const float* conv_b; const float* wa; const float* wi; const float* ba; const float* bi; const float* lam; int b, n, d; };
static __device__ __forceinline__ void unit(Par P_) {
    Par P; P.ZZ = uni(P_.ZZ); P.Hout = uni(P_.Hout); P.conv_w = uni(P_.conv_w); P.conv_b = uni(P_.conv_b); P.wa = uni(P_.wa); P.wi = uni(P_.wi); P.ba = uni(P_.ba); P.bi = uni(P_.bi); P.lam = uni(P_.lam); P.b = uni(P_.b); P.n = uni(P_.n); P.d = uni(P_.d);
    LAS char* lds = (LAS char*)lds_raw;
    const int tid = otid(), wid = __builtin_amdgcn_readfirstlane(tid >> 6), lane = tid & 63, fr = lane & 15, fq = lane >> 4;
    LAS float* HL = (LAS float*)(lds + O_HL) + wid * 1024; LAS float* CP = (LAS float*)(lds + O_CP) + wid * 1024;
    LAS float* AGG = (LAS float*)(lds + O_AGG); LAS float* CW = (LAS float*)(lds + O_CW);
    for (int i = tid; i < 64 * 5; i += 512) { const int lc = i / 5, j = i % 5; const int c = P.n * 64 + lc; CW[i] = j < 4 ? P.conv_w[j * 512 + c] : P.conv_b[c]; }
    for (int i = tid; i < 4096; i += 512) { const int k = i >> 6, j = i & 63;
        *(LAS bf16*)(lds + O_WA + j * SS + k * 2) = (bf16)f2bf(P.wa[i]); *(LAS bf16*)(lds + O_WI + j * SS + k * 2) = (bf16)f2bf(P.wi[i]); }
    const int chn = P.n * 64 + lane;
    const float ba = P.ba[chn], bi = P.bi[chn], c8 = -8.0f * softplusf_(-P.lam[chn]);
    float hc = 0.f;
    __syncthreads();
    for (int ch = 0; ch < 34; ++ch) {
        const bool isctx = ch < 2; const int cc = isctx ? ch : ch - 2; const int Ls = isctx ? CTXL : SEQ; const int rseg = isctx ? NLAT + P.b * CTXL : P.b * SEQ;
        for (int it = tid; it < 128 * 8; it += 512) {
            const int pos = it >> 3, lc0 = (it & 7) * 8;
            const int sp = cc * 128 + pos; const int tk = P.d ? Ls - 1 - sp : sp;
            float u[8];
#pragma unroll
            for (int e = 0; e < 8; ++e) u[e] = CW[(lc0 + e) * 5 + 4];
#pragma unroll
            for (int j = 0; j < 4; ++j) { const int t2 = tk + j - 2;
                if (t2 >= 0 && t2 < Ls) { const u32x4 xv = *(const u32x4*)(P.ZZ + (size_t)(rseg + t2) * ZLD + ZC_LX + P.n * 64 + lc0);
                    u[0] += bflo(xv.x) * CW[(lc0 + 0) * 5 + j]; u[1] += bfhi(xv.x) * CW[(lc0 + 1) * 5 + j]; u[2] += bflo(xv.y) * CW[(lc0 + 2) * 5 + j]; u[3] += bfhi(xv.y) * CW[(lc0 + 3) * 5 + j];
                    u[4] += bflo(xv.z) * CW[(lc0 + 4) * 5 + j]; u[5] += bfhi(xv.z) * CW[(lc0 + 5) * 5 + j]; u[6] += bflo(xv.w) * CW[(lc0 + 6) * 5 + j]; u[7] += bfhi(xv.w) * CW[(lc0 + 7) * 5 + j]; } }
            u32x4 w; w.x = cvt_pk_bf16(u[0], u[1]); w.y = cvt_pk_bf16(u[2], u[3]); w.z = cvt_pk_bf16(u[4], u[5]); w.w = cvt_pk_bf16(u[6], u[7]);
            *(LAS u32x4*)(lds + O_U + pos * SS + lc0 * 2) = w;
        }
        __syncthreads();
#pragma unroll
        for (int jt = 0; jt < 4; ++jt) {
            const f32x4 ga = mma_tile(lds + O_U + wid * 16 * SS, SS, lds + O_WA + jt * 16 * SS, SS, 2, lane, (f32x4){0.f, 0.f, 0.f, 0.f});
            const f32x4 gi = mma_tile(lds + O_U + wid * 16 * SS, SS, lds + O_WI + jt * 16 * SS, SS, 2, lane, (f32x4){0.f, 0.f, 0.f, 0.f});
#pragma unroll
            for (int jj = 0; jj < 4; ++jj) { HL[(fq * 4 + jj) * 64 + jt * 16 + fr] = ga[jj]; CP[(fq * 4 + jj) * 64 + jt * 16 + fr] = gi[jj]; }
        }
        LDS_WAIT();
        float h = 0.f, Pp = 1.f;
        for (int i = 0; i < 16; ++i) {
            const float uo = bf2f(*(const LAS bf16*)(lds + O_U + (wid * 16 + i) * SS + lane * 2));
            const float r = sigmoidf_(HL[i * 64 + lane] + ba), ig = sigmoidf_(CP[i * 64 + lane] + bi), la = c8 * r;
            const float a = __expf(la), bb = sqrtf(-expm1f(2.0f * la)) * (ig * uo);
            h = a * h + bb; Pp *= a;
            HL[i * 64 + lane] = h; CP[i * 64 + lane] = Pp;
        }
        AGG[(wid * 2 + 0) * 64 + lane] = Pp; AGG[(wid * 2 + 1) * 64 + lane] = h;
        __syncthreads();
        float cin = hc, call = hc;
#pragma unroll
        for (int w = 0; w < 8; ++w) { const float pw = AGG[(w * 2 + 0) * 64 + lane], hw = AGG[(w * 2 + 1) * 64 + lane]; call = pw * call + hw; if (w < wid) cin = call; }
        hc = call;
        for (int i = 0; i < 16; ++i) {
            const float hf = HL[i * 64 + lane] + CP[i * 64 + lane] * cin;
            const int sp = cc * 128 + wid * 16 + i; const int tk = P.d ? Ls - 1 - sp : sp;
            P.Hout[(size_t)(rseg + tk) * 512 + chn] = (bf16)f2bf(hf);
        }
        __syncthreads();
    }
}
}

struct Args { const float* in[35]; float* out; unsigned char* ws; int ph_lo, ph_hi; };
enum { I_X = 0, I_C, I_CTX, I_CCTX, I_WMOD, I_BMOD, I_WIN, I_LAMQ, I_LAMK, I_ATTNG, I_LCW, I_LCB, I_LWA, I_LBA, I_LWI, I_LBI, I_LLAM, I_SCW, I_SCB, I_SDTB, I_SALOG, I_SD, I_SNG,
       I_WBR, I_WOUT, I_LN1G, I_LN1B, I_WRT, I_RBIAS, I_WUP, I_WDN, I_WSU, I_WSD, I_LN2G, I_LN2B };

__device__ __forceinline__ int map_win(int n) {
    if (n < 1024) { const int o = n & 63; return (n & ~63) + 2 * (o & 31) + (o >> 5); }
    if (n < 4096) return n;
    if (n < 4112) return ZC_DT + (n - 4096);
    return ZC_GATE + (n - 4112);
}
__device__ __forceinline__ int map_up(int n) { const int j = n & 255, isu = n >> 8; return (j >> 7) * 256 + isu * 128 + (j & 127); }
template <int MODE> __device__ __forceinline__ void cvt_tile(const float* __restrict__ src, int lds_, int K, int N, bf16* __restrict__ dst, int ldd, int item, LAS float* scr) {
    const int tid = otid(); const int nblk = (N + 63) >> 6; const int kb = item / nblk, nb = item % nblk, k0 = kb * 64, n0 = nb * 64;
    { const int nn = tid & 63, n = n0 + nn;
#pragma unroll
      for (int i = 0; i < 8; ++i) { const int kk = (tid >> 6) + 8 * i; scr[kk * 65 + nn] = (n < N) ? src[(size_t)(k0 + kk) * lds_ + n] : 0.f; } }
    __syncthreads();
    { const int nn = tid >> 3, kc = (tid & 7) * 8, n = n0 + nn;
      if (n < N) {
          const LAS float* s = scr + kc * 65 + nn;
          u32x4 o; o.x = cvt_pk_bf16(s[0], s[65]); o.y = cvt_pk_bf16(s[2 * 65], s[3 * 65]); o.z = cvt_pk_bf16(s[4 * 65], s[5 * 65]); o.w = cvt_pk_bf16(s[6 * 65], s[7 * 65]);
          const int r = MODE == 1 ? map_win(n) : (MODE == 2 ? map_up(n) : n);
          bf16* d = dst + (size_t)r * ldd + k0 + kc;
          *(u32x4*)d = o;
          if (MODE == 3) { *(u32x4*)(d + 1024) = o; *(u32x4*)(d + 2048) = o; }
      } }
    __syncthreads();
}
__device__ __forceinline__ void convert_layer_weights(const Args& a, int l, LAS float* scr) {
    unsigned char* W = a.ws + WS_W;
    constexpr int N0 = 16 * 113, N1 = 3 * 8 * 16, N2 = 256, N3 = 16, N4 = 128, N5 = 64, N6 = 64 * 128, N7 = 64 * 64;
    constexpr int NIT = N0 + N1 + N2 + N3 + N4 + N5 + N6 + N7;
    for (int it = blockIdx.x; it < NIT; it += gridDim.x) {
        int r = it;
        if (r < N0) { cvt_tile<1>(a.in[I_WIN] + (size_t)l * 1024 * IN_TOTAL, IN_TOTAL, 1024, IN_TOTAL, (bf16*)(W + W_IN), 1024, r, scr); continue; } r -= N0;
        if (r < N1) { const int br = r / 128; cvt_tile<0>(a.in[I_WBR] + (size_t)(l * 3 + br) * 512 * 1024, 1024, 512, 1024, (bf16*)(W + W_BR) + (size_t)br * 1024 * 512, 512, r % 128, scr); continue; } r -= N1;
        if (r < N2) { cvt_tile<3>(a.in[I_WOUT] + (size_t)l * 1024 * 1024, 1024, 1024, 1024, (bf16*)(W + W_OUT), 3072, r, scr); continue; } r -= N2;
        if (r < N3) { const float* wr = a.in[I_WRT] + (size_t)l * 1024 * 64; bf16* o = (bf16*)(W + W_RT);
            for (int i = r * 4096 + otid(); i < (r + 1) * 4096; i += 512) { const int k = i >> 6, n = i & 63; const float v = wr[i]; const unsigned hi = f2bf(v); const unsigned lo = f2bf(v - bf2f(hi));
                o[(size_t)n * 2048 + k] = (bf16)hi; o[(size_t)n * 2048 + 1024 + k] = (bf16)hi; o[(size_t)(128 + n) * 2048 + k] = (bf16)lo; o[(size_t)(128 + n) * 2048 + 1024 + k] = (bf16)0; }
            continue; } r -= N3;
        if (r < N4) { cvt_tile<2>(a.in[I_WSU] + (size_t)l * 1024 * 512, 512, 1024, 512, (bf16*)(W + W_SU), 1024, r, scr); continue; } r -= N4;
        if (r < N5) { cvt_tile<0>(a.in[I_WSD] + (size_t)l * 256 * 1024, 1024, 256, 1024, (bf16*)(W + W_SD), 256, r, scr); continue; } r -= N5;
        if (r < N6) { const int e = r / 128; cvt_tile<2>(a.in[I_WUP] + (size_t)(l * 64 + e) * 1024 * 512, 512, 1024, 512, (bf16*)(W + W_UP) + (size_t)e * 512 * 1024, 1024, r % 128, scr); continue; } r -= N6;
        { const int e = r / 64; cvt_tile<0>(a.in[I_WDN] + (size_t)(l * 64 + e) * 256 * 1024, 1024, 256, 1024, (bf16*)(W + W_DN) + (size_t)e * 1024 * 256, 256, r % 64, scr); }
    }
}

__device__ __forceinline__ void phase_mod_rope(const Args& a, LAS float* lds) {
    const int tid = otid();
    float* mod = (float*)(a.ws + WS_MOD); float* cosT = (float*)(a.ws + WS_ROPE); float* sinT = cosT + 4096 * 32;
    LAS float* S = lds; LAS float* RED = lds + 9 * 1024;
    for (int i = tid; i < 9 * 1024; i += 512) { const float v = i < 8192 ? a.in[I_C][i] : a.in[I_CCTX][i - 8192]; S[i] = siluf_(v); }
    __syncthreads();
    for (int un = blockIdx.x; un < 2 * 96; un += gridDim.x) {
        const int l = un / 96, cb = un % 96, kg = tid >> 6, j = tid & 63, col = cb * 64 + j;
        const float* w = a.in[I_WMOD] + (size_t)l * 1024 * 6144 + col;
        float acc[9];
#pragma unroll
        for (int r = 0; r < 9; ++r) acc[r] = 0.f;
        for (int k = kg * 128; k < kg * 128 + 128; ++k) { const float wv = w[(size_t)k * 6144];
#pragma unroll
            for (int r = 0; r < 9; ++r) acc[r] += S[r * 1024 + k] * wv; }
#pragma unroll
        for (int r = 0; r < 9; ++r) RED[(kg * 9 + r) * 64 + j] = acc[r];
        __syncthreads();
        for (int o = tid; o < 9 * 64; o += 512) { const int r = o >> 6, jj = o & 63; float s = a.in[I_BMOD][l * 6144 + cb * 64 + jj];
#pragma unroll
            for (int g = 0; g < 8; ++g) s += RED[(g * 9 + r) * 64 + jj];
            mod[((size_t)l * 9 + r) * 6144 + cb * 64 + jj] = s; }
        __syncthreads();
    }
    for (int i = blockIdx.x * 512 + tid; i < 4096 * 32; i += gridDim.x * 512) {
        const int t = i >> 5, f = i & 31; const float pos = (float)(f < 16 ? (t >> 6) : (t & 63));
        const float inv = powf(10000.0f, -(float)(f & 15) / 16.0f); const float ang = pos * inv;
        cosT[i] = cosf(ang); sinT[i] = sinf(ang);
    }
}

__device__ __forceinline__ const float* xrow_in(const Args& a, int l, int row) {
    if (l == 0) return row < NLAT ? a.in[I_X] + (size_t)row * 1024 : a.in[I_CTX] + (size_t)(row - NLAT) * 1024;
    return (const float*)(a.ws + WS_X) + (size_t)row * 1024;
}
__device__ __forceinline__ void store_h_row(bf16* hrow, const f32x4 (&v)[4], const float* m0, const float* m1, int lane) {
#pragma unroll
    for (int j = 0; j < 4; ++j) { const int c = 4 * lane + 256 * j; const f32x4 s = *(const f32x4*)(m1 + c), t = *(const f32x4*)(m0 + c);
        u32x2 w; w.x = cvt_pk_bf16(v[j][0] * (1.f + s[0]) + t[0], v[j][1] * (1.f + s[1]) + t[1]); w.y = cvt_pk_bf16(v[j][2] * (1.f + s[2]) + t[2], v[j][3] * (1.f + s[3]) + t[3]);
        *(u32x2*)(hrow + c) = w; }
}
__device__ __forceinline__ void layer_norm_row(f32x4 (&v)[4], const float* g, const float* b, int lane) {
    float s = 0.f;
#pragma unroll
    for (int j = 0; j < 4; ++j) s += (v[j][0] + v[j][1]) + (v[j][2] + v[j][3]);
    const float mean = wave_sum(s) * (1.f / 1024.f); float q = 0.f;
#pragma unroll
    for (int j = 0; j < 4; ++j) { v[j] = v[j] - mean; q += (v[j][0] * v[j][0] + v[j][1] * v[j][1]) + (v[j][2] * v[j][2] + v[j][3] * v[j][3]); }
    const float rstd = __builtin_amdgcn_rsqf(wave_sum(q) * (1.f / 1024.f) + LN_EPS);
#pragma unroll
    for (int j = 0; j < 4; ++j) { const int c = 4 * lane + 256 * j; const f32x4 gg = *(const f32x4*)(g + c), bb = *(const f32x4*)(b + c); v[j] = v[j] * rstd * gg + bb; }
}
__device__ __forceinline__ void phase_modulate0(const Args& a) {
    const int tid_ = otid(); const int lane = tid_ & 63, gw = blockIdx.x * 8 + (tid_ >> 6), NGW = gridDim.x * 8;
    const float* mod = (const float*)(a.ws + WS_MOD); bf16* H = (bf16*)(a.ws + WS_H);
    for (int row = gw; row < MTOK; row += NGW) {
        const float* xr = xrow_in(a, 0, row); const int mr = row < NLAT ? (row >> 12) : 8; const float* mm = mod + (size_t)mr * 6144;
        f32x4 v[4];
#pragma unroll
        for (int j = 0; j < 4; ++j) v[j] = *(const f32x4*)(xr + 4 * lane + 256 * j);
        store_h_row(H + (size_t)row * 1024, v, mm, mm + 1024, lane);
    }
}
__device__ __forceinline__ void phase_mixer_finalize(const Args& a, int l, int nrows) {
    const int tid_ = otid(); const int lane = tid_ & 63, gw = blockIdx.x * 8 + (tid_ >> 6), NGW = gridDim.x * 8;
    bf16* ZZ = (bf16*)(a.ws + WS_ZZ); const bf16* SCR = (const bf16*)(a.ws + WS_ACT); const size_t SS_ = (size_t)MTOK * 512;
    const float* ng = a.in[I_SNG] + l * 512 + 8 * lane;
    const f32x4 g0 = *(const f32x4*)ng, g1 = *(const f32x4*)(ng + 4);
    for (int row = gw; row < nrows; row += NGW) {
        const size_t so = (size_t)row * 512 + 8 * lane;
        const u32x4 h0 = *(const u32x4*)(SCR + so), h1 = *(const u32x4*)(SCR + SS_ + so), y0 = *(const u32x4*)(SCR + 2 * SS_ + so), y1 = *(const u32x4*)(SCR + 3 * SS_ + so);
        bf16* zr = ZZ + (size_t)row * ZLD;
        const u32x4 lg = *(const u32x4*)(zr + ZC_LG + 8 * lane), zz = *(const u32x4*)(zr + ZC_Z + 8 * lane);
        float hb[8], t[8], lgv[8], zv[8];
        hb[0] = bflo(h0.x) + bflo(h1.x); hb[1] = bfhi(h0.x) + bfhi(h1.x); hb[2] = bflo(h0.y) + bflo(h1.y); hb[3] = bfhi(h0.y) + bfhi(h1.y);
        hb[4] = bflo(h0.z) + bflo(h1.z); hb[5] = bfhi(h0.z) + bfhi(h1.z); hb[6] = bflo(h0.w) + bflo(h1.w); hb[7] = bfhi(h0.w) + bfhi(h1.w);
        t[0] = bflo(y0.x) + bflo(y1.x); t[1] = bfhi(y0.x) + bfhi(y1.x); t[2] = bflo(y0.y) + bflo(y1.y); t[3] = bfhi(y0.y) + bfhi(y1.y);
        t[4] = bflo(y0.z) + bflo(y1.z); t[5] = bfhi(y0.z) + bfhi(y1.z); t[6] = bflo(y0.w) + bflo(y1.w); t[7] = bfhi(y0.w) + bfhi(y1.w);
        lgv[0] = bflo(lg.x); lgv[1] = bfhi(lg.x); lgv[2] = bflo(lg.y); lgv[3] = bfhi(lg.y); lgv[4] = bflo(lg.z); lgv[5] = bfhi(lg.z); lgv[6] = bflo(lg.w); lgv[7] = bfhi(lg.w);
        zv[0] = bflo(zz.x); zv[1] = bfhi(zz.x); zv[2] = bflo(zz.y); zv[3] = bfhi(zz.y); zv[4] = bflo(zz.z); zv[5] = bfhi(zz.z); zv[6] = bflo(zz.w); zv[7] = bfhi(zz.w);
        float ss = 0.f;
#pragma unroll
        for (int e = 0; e < 8; ++e) { hb[e] *= gelu_tanh(lgv[e]); t[e] *= siluf_(zv[e]); ss += t[e] * t[e]; }
#pragma unroll
        for (int off = 1; off < 32; off <<= 1) ss += __shfl_xor(ss, off);
        const float ri = __builtin_amdgcn_rsqf(ss * (1.f / 256.f) + RMS_EPS);
        u32x4 wb, wc;
        wb.x = cvt_pk_bf16(hb[0], hb[1]); wb.y = cvt_pk_bf16(hb[2], hb[3]); wb.z = cvt_pk_bf16(hb[4], hb[5]); wb.w = cvt_pk_bf16(hb[6], hb[7]);
        wc.x = cvt_pk_bf16(t[0] * ri * g0[0], t[1] * ri * g0[1]); wc.y = cvt_pk_bf16(t[2] * ri * g0[2], t[3] * ri * g0[3]);
        wc.z = cvt_pk_bf16(t[4] * ri * g1[0], t[5] * ri * g1[1]); wc.w = cvt_pk_bf16(t[6] * ri * g1[2], t[7] * ri * g1[3]);
        *(u32x4*)(zr + ZC_LG + 8 * lane) = wb; *(u32x4*)(zr + ZC_Z + 8 * lane) = wc;
    }
}
__device__ __forceinline__ void phase_ln1(const Args& a, int l, int nrows) {
    const int tid_ = otid(); const int lane = tid_ & 63, gw = blockIdx.x * 8 + (tid_ >> 6), NGW = gridDim.x * 8;
    const float* mod = (const float*)(a.ws + WS_MOD) + (size_t)l * 9 * 6144; bf16* H = (bf16*)(a.ws + WS_H); float* X = (float*)(a.ws + WS_X); const bf16* ZZ = (const bf16*)(a.ws + WS_ZZ);
    const float* g = a.in[I_LN1G] + l * 1024; const float* b = a.in[I_LN1B] + l * 1024;
    for (int row = gw; row < nrows; row += NGW) {
        const float* xr = xrow_in(a, l, row); const int mr = row < NLAT ? (row >> 12) : 8; const float* mm = mod + (size_t)mr * 6144;
        const bf16* mx = ZZ + (size_t)row * ZLD + ZC_MIX;
        f32x4 v[4];
#pragma unroll
        for (int j = 0; j < 4; ++j) { const int c = 4 * lane + 256 * j; const f32x4 xv = *(const f32x4*)(xr + c), gt = *(const f32x4*)(mm + 2 * 1024 + c); const u32x2 mw = *(const u32x2*)(mx + c);
            v[j][0] = DN_ALPHA * xv[0] + gt[0] * bflo(mw.x); v[j][1] = DN_ALPHA * xv[1] + gt[1] * bfhi(mw.x); v[j][2] = DN_ALPHA * xv[2] + gt[2] * bflo(mw.y); v[j][3] = DN_ALPHA * xv[3] + gt[3] * bfhi(mw.y); }
        layer_norm_row(v, g, b, lane);
        float* xo = X + (size_t)row * 1024;
#pragma unroll
        for (int j = 0; j < 4; ++j) *(f32x4*)(xo + 4 * lane + 256 * j) = v[j];
        { bf16* hrow = (bf16*)(a.ws + WS_ZZ) + (size_t)row * ZLD + ZC_H2; const float* m3 = mm + 3 * 1024; const float* m4 = mm + 4 * 1024;
#pragma unroll
          for (int j = 0; j < 4; ++j) { const int c = 4 * lane + 256 * j; const f32x4 sc = *(const f32x4*)(m4 + c), sh = *(const f32x4*)(m3 + c);
              float hv[4]; unsigned hh[4], hl[4];
#pragma unroll
              for (int e = 0; e < 4; ++e) { hv[e] = v[j][e] * (1.f + sc[e]) + sh[e]; hh[e] = f2bf(hv[e]); hl[e] = f2bf(hv[e] - bf2f(hh[e])); }
              u32x2 w; w.x = hh[0] | (hh[1] << 16); w.y = hh[2] | (hh[3] << 16); *(u32x2*)(hrow + c) = w;
              u32x2 wl; wl.x = hl[0] | (hl[1] << 16); wl.y = hl[2] | (hl[3] << 16); *(u32x2*)(hrow + 1024 + c) = wl; } }
    }
}
__device__ __forceinline__ void phase_ln2(const Args& a, int l, int nrows) {
    const int tid_ = otid(); const int lane = tid_ & 63, gw = blockIdx.x * 8 + (tid_ >> 6), NGW = gridDim.x * 8;
    const float* mod = (const float*)(a.ws + WS_MOD) + (size_t)l * 9 * 6144; const float* modn = (const float*)(a.ws + WS_MOD) + (size_t)(l + 1) * 9 * 6144;
    bf16* H = (bf16*)(a.ws + WS_ACT); float* X = (float*)(a.ws + WS_X); const bf16* YE = (const bf16*)(a.ws + WS_YE); const int* tslot = (const int*)(a.ws + WS_TSLOT);
    const float* g = a.in[I_LN2G] + l * 1024; const float* b = a.in[I_LN2B] + l * 1024;
    const bool last = (l == DEPTH - 1);
    for (int row = gw; row < nrows; row += NGW) {
        const int mr = row < NLAT ? (row >> 12) : 8; const float* mm = mod + (size_t)mr * 6144;
        float* xo = X + (size_t)row * 1024;
        f32x4 f[4];
#pragma unroll
        for (int j = 0; j < 4; ++j) f[j] = (f32x4){0.f, 0.f, 0.f, 0.f};
#pragma unroll
        for (int k = 0; k < 8; ++k) { const int slot = tslot[row * 8 + k]; const bf16* yr = YE + (size_t)slot * 1024;
#pragma unroll
            for (int j = 0; j < 4; ++j) { const u32x2 w = *(const u32x2*)(yr + 4 * lane + 256 * j); f[j][0] += bflo(w.x); f[j][1] += bfhi(w.x); f[j][2] += bflo(w.y); f[j][3] += bfhi(w.y); } }
        f32x4 v[4];
#pragma unroll
        for (int j = 0; j < 4; ++j) { const int c = 4 * lane + 256 * j; v[j] = *(const f32x4*)(xo + c) + *(const f32x4*)(mm + 5 * 1024 + c) * f[j]; }
        layer_norm_row(v, g, b, lane);
        if (last) { float* o = a.out + (size_t)row * 1024;
#pragma unroll
            for (int j = 0; j < 4; ++j) *(f32x4*)(o + 4 * lane + 256 * j) = v[j];
        } else {
#pragma unroll
            for (int j = 0; j < 4; ++j) *(f32x4*)(xo + 4 * lane + 256 * j) = v[j];
            const float* mn = modn + (size_t)mr * 6144;
            store_h_row(H + (size_t)row * 1024, v, mn, mn + 1024, lane);
        }
    }
}

__device__ __forceinline__ void phase_route_a(const Args& a, int l, int ntok, LAS unsigned* hist) {
    const int tid = otid(), lane = tid & 63, wid = tid >> 6;
    const float* L = (const float*)(a.ws + WS_LOGIT); int* selE = (int*)(a.ws + WS_SELE); float* selW = (float*)(a.ws + WS_SELW); int* selR = (int*)(a.ws + WS_SELR); int* wgh = (int*)(a.ws + WS_WGHIST);
    if (tid < 64) hist[tid] = 0u;
    __syncthreads();
    const float bias = a.in[I_RBIAS][l * 64 + lane];
    const int tpw = (ntok + gridDim.x - 1) / gridDim.x; const int t0 = blockIdx.x * tpw, t1 = min(ntok, t0 + tpw);
    for (int row = t0 + wid; row < t1; row += 8) {
        const float s = sigmoidf_(L[(size_t)row * 64 + lane]); const float sel = s + bias;
        float m1 = sel;
        m1 = fmaxf(m1, __shfl_xor(m1, 1)); m1 = fmaxf(m1, __shfl_xor(m1, 2)); m1 = fmaxf(m1, __shfl_xor(m1, 4));
        const unsigned long long bm = __ballot(sel == m1); const unsigned gbits = (unsigned)((bm >> (lane & ~7)) & 0xffull);
        const int first = (lane & ~7) + (__ffs(gbits) - 1);
        float m2 = (lane == first) ? -INFINITY : sel;
        m2 = fmaxf(m2, __shfl_xor(m2, 1)); m2 = fmaxf(m2, __shfl_xor(m2, 2)); m2 = fmaxf(m2, __shfl_xor(m2, 4));
        const float gs = m1 + m2; const int myg = lane >> 3;
        int grank = 0;
#pragma unroll
        for (int gq = 0; gq < 8; ++gq) { const float o = __builtin_bit_cast(float, __builtin_amdgcn_readlane(__builtin_bit_cast(int, gs), gq * 8)); grank += (o > gs || (o == gs && gq < myg)) ? 1 : 0; }
        const float sel2 = grank < 4 ? sel : -INFINITY;
        int erank = 0;
#pragma unroll
        for (int e = 0; e < 64; ++e) { const float o = __builtin_bit_cast(float, __builtin_amdgcn_readlane(__builtin_bit_cast(int, sel2), e)); erank += (o > sel2 || (o == sel2 && e < lane)) ? 1 : 0; }
        const bool chosen = (erank < 8) && (grank < 4);
        const unsigned long long cm = __ballot(chosen);
        const float wsum = wave_sum(chosen ? s : 0.f);
        if (chosen) {
            const int kidx = __popcll(cm & ((1ull << lane) - 1ull));
            const unsigned rk = __hip_atomic_fetch_add(&hist[lane], 1u, __ATOMIC_RELAXED, __HIP_MEMORY_SCOPE_WORKGROUP);
            selE[row * 8 + kidx] = lane; selW[row * 8 + kidx] = s / wsum * 2.5f; selR[row * 8 + kidx] = (int)rk;
        }
    }
    __syncthreads();
    if (tid < 64) wgh[blockIdx.x * 64 + tid] = (int)hist[tid];
}
__device__ __forceinline__ void phase_route_b(const Args& a, int ntok, LAS int* sm) {
    const int tid = otid(), lane = tid & 63, wid = tid >> 6;
    const int* selE = (const int*)(a.ws + WS_SELE); const float* selW = (const float*)(a.ws + WS_SELW); const int* selR = (const int*)(a.ws + WS_SELR); const int* wgh = (const int*)(a.ws + WS_WGHIST);
    int* tslot = (int*)(a.ws + WS_TSLOT); int* rowtok = (int*)(a.ws + WS_ROWTOK); float* roww = (float*)(a.ws + WS_ROWW); int* tileE = (int*)(a.ws + WS_TILEE); int* ntiles = (int*)(a.ws + WS_NTILES);
    LAS int* OFF = sm; LAS int* CNT = sm + 64; LAS int* PST = sm + 128; LAS int* PEN = sm + 192;
    if (wid == 0) {
        int cnt = 0, base = 0;
        for (int w = 0; w < (int)gridDim.x; ++w) { const int v = wgh[w * 64 + lane]; cnt += v; if (w < (int)blockIdx.x) base += v; }
        const int padded = (cnt + 255) & ~255; int inc = padded;
#pragma unroll
        for (int off = 1; off < 64; off <<= 1) { const int t = __shfl_up(inc, off); if (lane >= off) inc += t; }
        OFF[lane] = inc - padded + base; CNT[lane] = cnt; PST[lane] = inc - padded; PEN[lane] = inc;
    }
    __syncthreads();
    const int tpw = (ntok + gridDim.x - 1) / gridDim.x; const int t0 = blockIdx.x * tpw, t1 = min(ntok, t0 + tpw);
    for (int i = t0 * 8 + tid; i < t1 * 8; i += 512) { const int e = selE[i]; const int slot = OFF[e] + selR[i]; tslot[i] = slot; rowtok[slot] = i >> 3; roww[slot] = selW[i]; }
    for (int e = blockIdx.x; e < 64; e += gridDim.x) {
        const int ps = PST[e], pe = PEN[e], cn = CNT[e];
        for (int i = ps + cn + tid; i < pe; i += 512) { rowtok[i] = 0; roww[i] = 0.f; }
        for (int t = (ps >> 8) + tid; t < (pe >> 8); t += 512) tileE[t] = e;
    }
    if (blockIdx.x == 0 && tid == 0) *ntiles = PEN[63] >> 8;
}

#ifndef MK_PER_PHASE
#define MK_PER_PHASE 0
#endif
constexpr int NPHASE = 2 + 12 * DEPTH;

__global__ void __launch_bounds__(512, 2) mega_fwd(Args a) {
    LAS unsigned char* lds = (LAS unsigned char*)lds_raw;
    volatile LAS unsigned* MISC = (volatile LAS unsigned*)(lds + MISC_OFF);
    const int tid = otid();
    const int G = gridDim.x;
    unsigned* ctl = (unsigned*)(a.ws + WS_CTL);
    for (int u = tid; u < 32; u += 512) MISC[u] = 0u;
    __syncthreads();
    const int lo = a.ph_lo, hi = a.ph_hi;
    XcdBarrier bar; bar.bar = ctl + CW_BAR; bar.x = 0; bar.st = nullptr;
    if (hi - lo > 1) bar = xcd_barrier_post(ctl + CW_BAR, MISC + 8);
#ifndef MK_ONLY
#define MK_ONLY -1
#endif
#define SELP(k) ((MK_ONLY) < 0 || (MK_ONLY) == (k))
#define IN(k) (lo <= (k) && (k) < hi)
#define SEAM(k) do { if (IN(k) && IN((k) + 1)) xcd_barrier(bar); } while (0)
    unsigned char* ws = a.ws;
    bf16* ZZ = (bf16*)(ws + WS_ZZ); bf16* H = (bf16*)(ws + WS_H); float* X = (float*)(ws + WS_X);
    unsigned char* W = ws + WS_W;

    if (SELP(0) && IN(0)) { phase_mod_rope(a, (LAS float*)lds); }
    SEAM(0);
    if (SELP(1) && IN(1)) { convert_layer_weights(a, 0, (LAS float*)lds); phase_modulate0(a); }
    SEAM(1);

    for (int l = 0; l < DEPTH; ++l) {
        const int pb = 2 + 12 * l;
        const bool last = (l == DEPTH - 1);
        const int nrows = last ? NLAT : MTOK;
        const int ntile = nrows / 256;
        const float* modl = (const float*)(ws + WS_MOD) + (size_t)l * 9 * 6144;

        if (SELP(2) && IN(pb + 0)) {
            const bf16* Hin = (l == 0) ? H : (const bf16*)(ws + WS_ACT);
            GeoPlain g{Hin, (const bf16*)(W + W_IN), 1024, 1024, 1024};
            pg8::StaticOrder S; S.init(MTOK / 256, ZLD / 256, G, (int)blockIdx.x);
            EpiInProj E{ZZ, (const float*)(ws + WS_ROPE), (const float*)(ws + WS_ROPE) + 4096 * 32};
            pg8::gemm_phase(lds, g, S, E);
        }
        SEAM(pb + 0);

        if (SELP(3) && IN(pb + 1)) {
            unsigned* qhead = ctl + CW_QUEUE + 64 * l;
            const int nunits = 256 + 1024 + (last ? 0 : 64);
            const float lam_init = 0.8f - 0.6f * __expf(-0.3f * (float)l);
            bf16* SCR = (bf16*)(ws + WS_ACT);
#ifndef MK_UNIT
#define MK_UNIT 7
#endif
#define NEXT_UNIT() do { __syncthreads(); if (tid == 0) MISC[0] = atomicAdd(qhead, 1u); __syncthreads(); uid = (int)MISC[0]; } while (0)
            int uid; NEXT_UNIT();
            while ((MK_UNIT & 1) && uid < 128) {
                const int b = uid >> 4, h = (uid >> 1) & 7, d = uid & 1;
                ssd::Par P; P.ZZ = ZZ; P.Y = SCR + (size_t)(2 + d) * MTOK * 512; P.conv_w = a.in[I_SCW] + (size_t)l * 4 * 1024; P.conv_b = a.in[I_SCB] + l * 1024;
                P.dtb = a.in[I_SDTB][(l * 2 + d) * 8 + h]; P.A = -__expf(a.in[I_SALOG][(l * 2 + d) * 8 + h]); P.Dskip = a.in[I_SD][l * 8 + h]; P.b = b; P.h = h; P.d = d;
                ssd::unit(P);
                NEXT_UNIT();
            }
            while ((MK_UNIT & 2) && uid < 256) {
                const int u = uid - 128; const int b = u >> 4, n = (u >> 1) & 7, d = u & 1;
                lru::Par P; P.ZZ = ZZ; P.Hout = SCR + (size_t)d * MTOK * 512; P.conv_w = a.in[I_LCW] + (size_t)l * 4 * 512; P.conv_b = a.in[I_LCB] + l * 512;
                P.wa = a.in[I_LWA] + (size_t)((l * 2 + d) * 8 + n) * 4096; P.wi = a.in[I_LWI] + (size_t)((l * 2 + d) * 8 + n) * 4096;
                P.ba = a.in[I_LBA] + (l * 2 + d) * 512; P.bi = a.in[I_LBI] + (l * 2 + d) * 512; P.lam = a.in[I_LLAM] + (l * 2 + d) * 512; P.b = b; P.n = n; P.d = d;
                lru::unit(P);
                NEXT_UNIT();
            }
            if (MK_UNIT & 4) {
                float d0 = 0.f, d1 = 0.f;
                for (int i = 0; i < 64; ++i) { d0 += a.in[I_LAMQ][(l * 2 + 0) * 64 + i] * a.in[I_LAMK][(l * 2 + 0) * 64 + i]; d1 += a.in[I_LAMQ][(l * 2 + 1) * 64 + i] * a.in[I_LAMK][(l * 2 + 1) * 64 + i]; }
                const float lam = __expf(d0) - __expf(d1) + lam_init;
                while (uid < nunits) {
                    int qrow0, h, krowA, ntA, krowB, NT;
                    if (uid < 1280) { const int u = uid - 256; const int b = u >> 7; h = (u >> 5) & 3; const int qb = u & 31; qrow0 = b * SEQ + qb * 128; krowA = b * SEQ; ntA = 64; krowB = NLAT + b * CTXL; NT = 68; }
                    else { const int u = uid - 1280; const int b = u >> 3; h = (u >> 1) & 3; const int cq = u & 1; qrow0 = NLAT + b * CTXL + cq * 128; krowA = NLAT + b * CTXL; ntA = 4; krowB = krowA; NT = 4; }
                    att::attn_unit(ZZ, qrow0, h, krowA, ntA, krowB, NT, lam, a.in[I_ATTNG] + (size_t)(l * 4 + h) * 128, 1.0f - lam_init);
                    NEXT_UNIT();
                }
            }
#undef NEXT_UNIT
        }
        SEAM(pb + 1);

        if (SELP(4) && IN(pb + 2)) { phase_mixer_finalize(a, l, nrows); }
        SEAM(pb + 2);

        if (SELP(5) && IN(pb + 3)) {
            GeoMergeA g{ZZ, (const bf16*)(W + W_BR), 512, ZLD, 512};
            pg8::StaticOrder S; S.init(ntile, 12, G, (int)blockIdx.x);
            EpiMergeA E{ZZ};
            pg8::gemm_phase(lds, g, S, E);
        }
        SEAM(pb + 3);

        if (SELP(6) && IN(pb + 4)) {
            GeoPlain g{ZZ + ZC_GATE, (const bf16*)(W + W_OUT), 3072, ZLD, 3072};
            pg8::StaticOrder S; S.init(ntile, 4, G, (int)blockIdx.x);
            EpiBf16Plain E{ZZ + ZC_MIX, ZLD};
            pg8::gemm_phase(lds, g, S, E);
        }
        SEAM(pb + 4);

        if (SELP(7) && IN(pb + 5)) { phase_ln1(a, l, nrows); }
        SEAM(pb + 5);

        if (SELP(8) && IN(pb + 6)) {
            { GeoPlain g{ZZ + ZC_H2, (const bf16*)(W + W_SU), 1024, ZLD, 1024};
              pg8::StaticOrder S; S.init(ntile, 2, G, (int)blockIdx.x);
              EpiSwiGLU<false> E{(bf16*)(ws + WS_ACTS), nullptr};
              pg8::gemm_phase(lds, g, S, E); }
            { GeoPlain g{ZZ + ZC_H2, (const bf16*)(W + W_RT), 2048, ZLD, 2048};
              pg8::StaticOrder S; S.init(ntile, 1, G, (int)((blockIdx.x + 128) % G));
              EpiRouter E{(float*)(ws + WS_LOGIT)};
              pg8::gemm_phase(lds, g, S, E); }
        }
        SEAM(pb + 6);

        if (SELP(9) && IN(pb + 7)) { phase_route_a(a, l, nrows, (LAS unsigned*)lds); }
        SEAM(pb + 7);
        if (SELP(10) && IN(pb + 8)) { phase_route_b(a, nrows, (LAS int*)lds); }
        SEAM(pb + 8);

        if (SELP(11) && IN(pb + 9)) {
            const int nt_ = *(const int*)(ws + WS_NTILES);
            GeoMoeUp g{ZZ + ZC_H2, (const bf16*)(W + W_UP), (const int*)(ws + WS_ROWTOK), (const int*)(ws + WS_TILEE), 1024, ZLD, 1024};
            pg8::StaticOrder S; S.init(nt_, 2, G, (int)blockIdx.x);
            EpiSwiGLU<true> E{(bf16*)(ws + WS_ACT), (const float*)(ws + WS_ROWW)};
            pg8::gemm_phase(lds, g, S, E);
        }
        SEAM(pb + 9);

        if (SELP(12) && IN(pb + 10)) {
            { const int nt_ = *(const int*)(ws + WS_NTILES);
              GeoMoeDown g{(const bf16*)(ws + WS_ACT), (const bf16*)(W + W_DN), (const int*)(ws + WS_TILEE), 256, 256, 256};
              pg8::StaticOrder S; S.init(nt_, 4, G, (int)blockIdx.x);
              EpiBf16Plain E{(bf16*)(ws + WS_YE), 1024};
              pg8::gemm_phase(lds, g, S, E); }
            { GeoPlain g{(const bf16*)(ws + WS_ACTS), (const bf16*)(W + W_SD), 256, 256, 256};
              pg8::StaticOrder S; S.init(ntile, 4, G, (int)blockIdx.x);
              EpiSharedDown E{X, modl};
              pg8::gemm_phase(lds, g, S, E); }
        }
        SEAM(pb + 10);

        if (SELP(13) && IN(pb + 11)) {
            phase_ln2(a, l, nrows);
            if (!last) { __syncthreads(); convert_layer_weights(a, l + 1, (LAS float*)lds); }
        }
        SEAM(pb + 11);
    }
#undef IN
#undef SEAM
}

extern "C" void kernel_launch(void* const* d_in, const int* in_sizes, int n_in, void* d_out, int out_size, void* d_ws, size_t ws_size, hipStream_t stream) {
    static int grid = 0;
    if (grid == 0) {
        if (n_in != 35 || in_sizes[0] != NLAT * DM || out_size != NLAT * DM || ws_size < WS_END) {
            fprintf(stderr, "kernel_launch: shape/workspace mismatch: n_in %d in0 %d out %d ws %zu (need %zu)\n", n_in, n_in > 0 ? in_sizes[0] : -1, out_size, ws_size, (size_t)WS_END); grid = -1; return; }
        int dev = 0, cus = 0, per_cu = 0;
        if (hipGetDevice(&dev) != hipSuccess || hipDeviceGetAttribute(&cus, hipDeviceAttributeMultiprocessorCount, dev) != hipSuccess) { fprintf(stderr, "kernel_launch: device query failed\n"); grid = -1; return; }
        if (hipFuncSetAttribute((const void*)mega_fwd, hipFuncAttributeMaxDynamicSharedMemorySize, LDS_BYTES) != hipSuccess) { fprintf(stderr, "kernel_launch: hipFuncSetAttribute failed\n"); grid = -1; return; }
        if (hipOccupancyMaxActiveBlocksPerMultiprocessor(&per_cu, (const void*)mega_fwd, 512, LDS_BYTES) != hipSuccess || per_cu < 1) fprintf(stderr, "kernel_launch: occupancy query reports %d\n", per_cu);
        (void)hipGetLastError();
        grid = cus;
    }
    if (grid < 0) return;
    if (hipMemsetAsync((char*)d_ws + WS_CTL, 0, CTL_ZERO_BYTES, stream) != hipSuccess) { fprintf(stderr, "kernel_launch: memset failed\n"); return; }
    Args a{};
    for (int i = 0; i < 35; ++i) a.in[i] = (const float*)d_in[i];
    a.out = (float*)d_out; a.ws = (unsigned char*)d_ws;
#if MK_PER_PHASE
    for (int p = 0; p < NPHASE; ++p) { a.ph_lo = p; a.ph_hi = p + 1; hipLaunchKernelGGL(mega_fwd, dim3(grid), dim3(512), LDS_BYTES, stream, a); }
#else
    a.ph_lo = 0; a.ph_hi = NPHASE;
    hipLaunchKernelGGL(mega_fwd, dim3(grid), dim3(512), LDS_BYTES, stream, a);
#endif
    const hipError_t le = hipPeekAtLastError();
    if (le != hipSuccess) fprintf(stderr, "kernel_launch: launch failed: %s\n", hipGetErrorName(le));
}
```

```cpp
#include <hip/hip_runtime.h>
#include <cstdio>
#include <cstdint>

#define GAS __attribute__((address_space(1)))
#define LAS __attribute__((address_space(3)))
typedef unsigned short bf16;
typedef short bf16x8 __attribute__((ext_vector_type(8)));
typedef short s16x4 __attribute__((ext_vector_type(4)));
typedef float f32x2 __attribute__((ext_vector_type(2)));
typedef float f32x4 __attribute__((ext_vector_type(4)));
typedef float f32x16 __attribute__((ext_vector_type(16)));
typedef unsigned u32x2 __attribute__((ext_vector_type(2)));
typedef unsigned u32x4 __attribute__((ext_vector_type(4)));

constexpr int DM = 1024, NBATCH = 8, SEQ = 4096, CTXL = 256, DEPTH = 2;
constexpr int NLAT = NBATCH * SEQ, NCTX = NBATCH * CTXL, MTOK = NLAT + NCTX;
constexpr int IN_TOTAL = 7184, ZLD = 7424;
constexpr int ZC_Q = 0, ZC_K = 512, ZC_V = 1024, ZC_LX = 1536, ZC_LG = 2048, ZC_Z = 2560, ZC_XBC = 3072, ZC_GATE = 4096, ZC_DT = 7168;
constexpr int ZC_MIX = 512;
constexpr int NEXP = 64, TOPK = 8, EXPF = 256;
constexpr int PMAX_TILES = 1152, PMAX = PMAX_TILES * 256;
constexpr float DN_ALPHA = 1.41421356237309515f;
constexpr float LN_EPS = 1e-5f, RMS_EPS = 1e-6f;

constexpr size_t MiB = 1u << 20;
constexpr size_t WS_CTL = 0, CTL_ZERO_BYTES = 1 * MiB;
constexpr size_t WS_MOD = 1 * MiB;
constexpr size_t WS_ROPE = 2 * MiB;
constexpr size_t WS_LOGIT = 4 * MiB;
constexpr size_t WS_ACTS = 13 * MiB;
constexpr size_t WS_SELE = 30 * MiB;
constexpr size_t WS_SELW = 32 * MiB;
constexpr size_t WS_SELR = 34 * MiB;
constexpr size_t WS_TSLOT = 36 * MiB;
constexpr size_t WS_ROWTOK = 38 * MiB;
constexpr size_t WS_ROWW = 40 * MiB;
constexpr size_t WS_WGHIST = 42 * MiB;
constexpr size_t WS_TILEE = 42 * MiB + 65536;
constexpr size_t WS_NTILES = 42 * MiB + 131072;
constexpr size_t WS_W = 44 * MiB;
constexpr size_t W_IN = 0;
constexpr size_t W_BR = W_IN + (size_t)ZLD * 1024 * 2;
constexpr size_t W_OUT = W_BR + (size_t)3072 * 512 * 2;
constexpr size_t W_RT = W_OUT + (size_t)1024 * 3072 * 2;
constexpr size_t W_SU = W_RT + (size_t)256 * 2048 * 2;
constexpr size_t W_SD = W_SU + (size_t)512 * 1024 * 2;
constexpr size_t W_UP = W_SD + (size_t)1024 * 256 * 2;
constexpr size_t W_DN = W_UP + (size_t)64 * 512 * 1024 * 2;
constexpr size_t W_END = W_DN + (size_t)64 * 1024 * 256 * 2;
static_assert(W_END <= 122 * MiB, "weights");
constexpr int ZC_H2 = 4096;
constexpr size_t WS_X = 166 * MiB;
constexpr size_t WS_ACT = 302 * MiB;
constexpr size_t WS_H = 446 * MiB;
constexpr size_t WS_ZZ = 514 * MiB;
constexpr size_t WS_YE = WS_H;
constexpr size_t WS_END = 1022 * MiB;
static_assert(WS_X + (size_t)MTOK * 1024 * 4 <= WS_ACT && WS_ACT + (size_t)PMAX * 256 * 2 <= WS_H && WS_H + (size_t)MTOK * 1024 * 2 <= WS_ZZ, "ws map 1");
static_assert(WS_ZZ + (size_t)MTOK * ZLD * 2 <= WS_END && WS_YE + (size_t)PMAX * 1024 * 2 <= WS_END, "ws map 2");
constexpr size_t SCR_STRIDE = (size_t)MTOK * 512 * 2;
static_assert(4 * SCR_STRIDE <= (size_t)PMAX * 256 * 2, "scan scratch fits the act region");
constexpr int CW_BAR = 4096;
constexpr int CW_QUEUE = 16384;

constexpr int LDS_BYTES = 147456;
constexpr int MISC_OFF = 131072 + 320;

#define LDS_WAIT() asm volatile("s_waitcnt lgkmcnt(0)" ::: "memory")
#define VM_WAIT() asm volatile("s_waitcnt vmcnt(0)" ::: "memory")
__device__ __forceinline__ unsigned f2bf(float f) { unsigned u = __builtin_bit_cast(unsigned, f); return (u + 0x7fffu + ((u >> 16) & 1u)) >> 16; }
__device__ __forceinline__ float bf2f(unsigned h) { return __builtin_bit_cast(float, h << 16); }
__device__ __forceinline__ unsigned cvt_pk_bf16(float lo, float hi) { unsigned r; asm volatile("v_cvt_pk_bf16_f32 %0, %1, %2" : "=v"(r) : "v"(lo), "v"(hi)); return r; }
__device__ __forceinline__ float bflo(unsigned w) { return __builtin_bit_cast(float, w << 16); }
__device__ __forceinline__ float bfhi(unsigned w) { return __builtin_bit_cast(float, w & 0xffff0000u); }
__device__ __forceinline__ float fexp(float x) { return __builtin_amdgcn_exp2f(x * 1.4426950408889634f); }
__device__ __forceinline__ float sigmoidf_(float x) { return __builtin_amdgcn_rcpf(1.0f + fexp(-x)); }
__device__ __forceinline__ float siluf_(float x) { return x * sigmoidf_(x); }
__device__ __forceinline__ float softplusf_(float x) { const float e = fexp(-fabsf(x)); const float lp = e < 1e-3f ? e * (1.f - 0.5f * e + 0.33333333f * e * e) : __builtin_amdgcn_logf(1.f + e) * 0.6931471805599453f; return fmaxf(x, 0.f) + lp; }
__device__ __forceinline__ float gelu_tanh(float x) { const float u = 0.7978845608028654f * (x + 0.044715f * x * x * x); const float e = fexp(2.f * u); const float th = 1.f - 2.f * __builtin_amdgcn_rcpf(e + 1.f); return 0.5f * x * (1.f + th); }
__device__ __forceinline__ float wave_sum(float v) {
#pragma unroll
    for (int o = 1; o < 64; o <<= 1) v += __shfl_xor(v, o);
    return v;
}

template <class T> __device__ __forceinline__ T* uni(T* p) { const unsigned long long v = (unsigned long long)p; const unsigned lo = __builtin_amdgcn_readfirstlane((unsigned)v), hi = __builtin_amdgcn_readfirstlane((unsigned)(v >> 32)); return (T*)(((unsigned long long)hi << 32) | lo); }
__device__ __forceinline__ int uni(int v) { return __builtin_amdgcn_readfirstlane(v); }
__device__ __forceinline__ float uni(float v) { return __builtin_bit_cast(float, __builtin_amdgcn_readfirstlane(__builtin_bit_cast(int, v))); }
extern __shared__ __attribute__((aligned(16))) unsigned char lds_raw[];
constexpr int WVTAB_OFF = 131072 + 320 + 128 + 320;
__device__ __forceinline__ int otid() {
    const unsigned key = (unsigned)__builtin_amdgcn_s_getreg(((6 - 1) << 11) | 4) & 63u;
    int off_ = WVTAB_OFF + (int)key * 4; asm volatile("" : "+v"(off_));
    const unsigned wv = (unsigned)__builtin_amdgcn_readfirstlane((int)*(const volatile LAS unsigned*)((LAS unsigned char*)lds_raw + off_));
    unsigned z = 0u; asm volatile("" : "+v"(z));
    const unsigned ln = __builtin_amdgcn_mbcnt_hi(~0u, __builtin_amdgcn_mbcnt_lo(~0u, z));
    int t = (int)(wv * 64u + ln); asm volatile("" : "+v"(t)); return t;
}
__device__ __forceinline__ int osg(int v) { asm volatile("" : "+s"(v)); return v; }

#define XB_TMO      128
#define XB_XCNT(j)  (256  + 64 * (j))
#define XB_XSUB(j)  (1280 + 64 * (j))
#define XB_XGEN(j)  (2304 + 64 * (j))
#define XB_TOP      3328
#define XB_TOPGEN   3392
#define XCD_BAR_WORDS 3456
#define XB_SPIN_CAP (1u << 20)
__device__ __forceinline__ unsigned xb_ld(unsigned* p)              { return __hip_atomic_load(p, __ATOMIC_RELAXED, __HIP_MEMORY_SCOPE_AGENT); }
__device__ __forceinline__ unsigned xb_add(unsigned* p, unsigned v) { return __hip_atomic_fetch_add(p, v, __ATOMIC_RELAXED, __HIP_MEMORY_SCOPE_AGENT); }
__device__ __forceinline__ unsigned xb_xcc_id() { return (unsigned)__builtin_amdgcn_s_getreg((3 << 11) | 20) & 0xFu; }
#define XB_SPIN(cond, bar) do { unsigned _sp = 0; while (cond) { __builtin_amdgcn_s_sleep(1); \
    if ((++_sp & 255u) == 0u) { if (xb_ld(&(bar)[XB_TMO])) break; if (_sp > XB_SPIN_CAP) { atomicAdd(&(bar)[XB_TMO], 1u); break; } } } } while (0)
struct XcdBarrier { unsigned* bar; unsigned x; volatile LAS unsigned* st; };
__device__ __forceinline__ XcdBarrier xcd_barrier_post(unsigned* bar, volatile LAS unsigned* st) {
    XcdBarrier b; b.bar = bar; b.x = xb_xcc_id(); b.st = st;
    if (otid() == 0) (void)xb_add(&bar[XB_XCNT(b.x)], 1u);
    return b;
}
__device__ __forceinline__ void xcd_barrier_complete(unsigned* bar, unsigned x, unsigned& nloc, unsigned& nx) {
    const unsigned G = gridDim.x * gridDim.y * gridDim.z;
    unsigned sum, cnt, mine, sp = 0u;
    for (;;) {
        sum = 0u; cnt = 0u; mine = 0u;
#pragma unroll
        for (unsigned j = 0; j < 16; ++j) { const unsigned c = xb_ld(&bar[XB_XCNT(j)]); sum += c; cnt += (c > 0u) ? 1u : 0u; mine = (j == x) ? c : mine; }
        if (sum == G) break;
        __builtin_amdgcn_s_sleep(1);
        if ((++sp & 255u) == 0u) { if (xb_ld(&bar[XB_TMO])) break; if (sp > XB_SPIN_CAP) { atomicAdd(&bar[XB_TMO], 1u); break; } }
    }
    nloc = mine > 0u ? mine : 1u; nx = cnt > 0u ? cnt : 1u;
}
__device__ __forceinline__ void xcd_barrier(const XcdBarrier& b) {
    asm volatile("s_waitcnt vmcnt(0)" ::: "memory");
    __syncthreads();
    if (otid() == 0) {
        unsigned* bar = b.bar;
        __builtin_amdgcn_s_waitcnt(0);
        unsigned nloc = b.st[0], nx = b.st[1];
        if (nloc == 0u) { xcd_barrier_complete(bar, b.x, nloc, nx); b.st[0] = nloc; b.st[1] = nx; }
        const unsigned old = xb_add(&bar[XB_XSUB(b.x)], 1u);
        const unsigned gen = old / nloc;
        if (old + 1u == (gen + 1u) * nloc) {
            __builtin_amdgcn_fence(__ATOMIC_RELEASE, "agent");
            asm volatile("s_waitcnt vmcnt(0)" ::: "memory");
            const unsigned og = xb_add(&bar[XB_TOP], 1u);
            const unsigned tg = og / nx;
            if (og + 1u == (tg + 1u) * nx) xb_add(&bar[XB_TOPGEN], 1u);
            else XB_SPIN(xb_ld(&bar[XB_TOPGEN]) == tg, bar);
            __builtin_amdgcn_fence(__ATOMIC_ACQUIRE, "agent");
            xb_add(&bar[XB_XGEN(b.x)], 1u);
            asm volatile("s_waitcnt vmcnt(0)" ::: "memory");
        } else {
            XB_SPIN(xb_ld(&bar[XB_XGEN(b.x)]) == gen, bar);
            __builtin_amdgcn_fence(__ATOMIC_ACQUIRE, "agent");
            asm volatile("s_waitcnt vmcnt(0)" ::: "memory");
        }
    }
    __syncthreads();
}

namespace pg8 {
constexpr int BM = 256, BK = 64, HALF = 128, HTB = HALF * BK * 2, STAGE_BYTES = 8 * HTB, NXCD = 8, WGM = 8;
__host__ __device__ __forceinline__ int lds_byte(int r, int c) { const int st = (r >> 4) * 2 + (c >> 5), rr = r & 15, cc = c & 31, ob = rr * 64 + cc * 2; return st * 1024 + (ob ^ (((ob >> 9) & 1) << 5)); }
__host__ __device__ __forceinline__ void stage_rc(int b, int& R, int& C) { const int st = b / 1024, sb = b % 1024, swz = sb ^ (((sb >> 9) & 1) << 5); R = (st >> 1) * 16 + swz / 64; C = (st & 1) * 32 + (swz % 64) / 2; }
__host__ __device__ __forceinline__ int perm32(int rho) { const int n = rho >> 4, i = rho & 15; return 8 * (i >> 2) + 4 * n + (i & 3); }
struct Unit { int pm, pn; };
struct StaticOrder {
    int nM, nN, nwg, G, c;
    __device__ void init(int nM_, int nN_, int G_, int c_) { nM = nM_; nN = nN_; nwg = nM * nN; G = G_; c = c_; }
    __device__ bool next(int i, Unit& u) const {
        const long L = (long)i * G + c; if (L >= nwg) return false;
        int wgid = (int)L; { const int q = nwg / NXCD, r = nwg % NXCD, xcd = wgid % NXCD, off = wgid / NXCD; wgid = (xcd < r ? xcd * (q + 1) : r * (q + 1) + (xcd - r) * q) + off; }
        const int nig = WGM * nN, gid = wgid / nig, fm = gid * WGM, gsz = (nM - fm) < WGM ? (nM - fm) : WGM;
        u.pm = __builtin_amdgcn_readfirstlane(fm + ((wgid % nig) % gsz)); u.pn = __builtin_amdgcn_readfirstlane((wgid % nig) / gsz); return true;
    }
};
template <class Geo, class Epi, class Sched>
__device__ __forceinline__ void gemm_phase(LAS unsigned char* lds, const Geo& g, const Sched& S, const Epi& E) {
    const int tid = otid(), wid = __builtin_amdgcn_readfirstlane(tid >> 6), lane = tid & 63, wr = wid >> 2, wc = wid & 3, fr = lane & 15, fq = lane >> 4;
    const int K = g.K, nt = K / BK;
    int Rs[2], Cs[2];
    unsigned voffB[2], vC[2][2];
#pragma unroll
    for (int i = 0; i < 2; ++i) { stage_rc(tid * 16 + i * 8192, Rs[i], Cs[i]); const int Rb = Epi::PERM ? ((Rs[i] & ~31) + perm32(Rs[i] & 31)) : Rs[i];
        voffB[i] = (unsigned)(Rb * g.ldb + Cs[i]) * 2u; }
    const size_t kstep = (size_t)(BK * 2);
    const size_t hstepB = (size_t)HALF * g.ldb * 2;
    const unsigned ldsw = (unsigned)wid * 1024u;
    const int aoff = lds_byte(wr * 64 + fr, fq * 8), boff = lds_byte(wc * 32 + fr, fq * 8);
#define PG8_SA(b, h) (((b) * 2 + (h)) * HTB)
#define PG8_SB(b, h) ((4 + (b) * 2 + (h)) * HTB)
#define PG8_STAGE(bufoff, gbase, voff) do { _Pragma("unroll") for (int _i = 0; _i < 2; ++_i) \
        __builtin_amdgcn_global_load_lds((const unsigned*)((const char*)(gbase) + (voff)[_i]), (LAS unsigned*)(lds + (bufoff) + ldsw + _i * 8192), 16, 0, 0); } while (0)
#define PG8_LDA(dst, b, h) do { _Pragma("unroll") for (int m = 0; m < 4; ++m) _Pragma("unroll") for (int k = 0; k < 2; ++k) dst[m][k] = *(const LAS bf16x8*)(lds + PG8_SA(b, h) + aoff + m * 2048 + k * 1024); } while (0)
#define PG8_LDB(dst, b, h) do { _Pragma("unroll") for (int n = 0; n < 2; ++n) _Pragma("unroll") for (int k = 0; k < 2; ++k) dst[n][k] = *(const LAS bf16x8*)(lds + PG8_SB(b, h) + boff + n * 2048 + k * 1024); } while (0)
#define PG8_MMA(ai, bj, At, Bt) do { __builtin_amdgcn_s_setprio(1); _Pragma("unroll") for (int m = 0; m < 4; ++m) _Pragma("unroll") for (int n = 0; n < 2; ++n) _Pragma("unroll") for (int k = 0; k < 2; ++k) \
        acc[ai][bj][m][n] = __builtin_amdgcn_mfma_f32_16x16x32_bf16(Bt[n][k], At[m][k], acc[ai][bj][m][n], 0, 0, 0); __builtin_amdgcn_s_setprio(0); } while (0)
#define PG8_WAIT_V(n) asm volatile("s_waitcnt vmcnt(" #n ")" ::: "memory")
#define PG8_WAIT_L(n) asm volatile("s_waitcnt lgkmcnt(" #n ")" ::: "memory")
#define PG8_BAR __builtin_amdgcn_s_barrier()
#define PG8_SCHED __builtin_amdgcn_sched_barrier(0)
#define PG8_SETV(v, u) do { _Pragma("unroll") for (int _h = 0; _h < 2; ++_h) _Pragma("unroll") for (int _i = 0; _i < 2; ++_i) { \
        const unsigned _row = Geo::GATHER ? g.a_row((u), _h * HALF + Rs[_i]) : (unsigned)(_h * HALF + Rs[_i]); v[_h][_i] = (_row * (unsigned)g.lda + (unsigned)Cs[_i]) * 2u; } } while (0)
    Unit cur, nxt; int ui = 0;
    if (!S.next(0, cur)) return;
    f32x4 acc[2][2][4][2];
#pragma unroll
    for (int a = 0; a < 2; ++a)
#pragma unroll
        for (int b = 0; b < 2; ++b)
#pragma unroll
            for (int m = 0; m < 4; ++m)
#pragma unroll
                for (int n = 0; n < 2; ++n) acc[a][b][m][n] = (f32x4){0.f, 0.f, 0.f, 0.f};
    bf16x8 At[4][2], B0[2][2], B1[2][2];
    const char* cA = g.a_tile(cur); const char* cB = g.b_tile(cur);
    PG8_SETV(vC, cur);
    if (Geo::GATHER) { PG8_WAIT_V(0); }
    PG8_STAGE(PG8_SB(0, 0), cB, voffB); PG8_STAGE(PG8_SB(0, 1), cB + hstepB, voffB); PG8_STAGE(PG8_SA(0, 0), cA, vC[0]); PG8_STAGE(PG8_SA(0, 1), cA, vC[1]);
    if (wr == 1) PG8_BAR;
    PG8_WAIT_V(2); PG8_BAR;
    PG8_STAGE(PG8_SB(1, 0), cB + kstep, voffB); PG8_STAGE(PG8_SA(1, 0), cA + kstep, vC[0]); PG8_STAGE(PG8_SB(1, 1), cB + hstepB + kstep, voffB);
    PG8_WAIT_V(6); PG8_BAR;
    for (;;) {
        const bool has_next = S.next(ui + 1, nxt);
        const char* nA = has_next ? g.a_tile(nxt) : cA; const char* nB = has_next ? g.b_tile(nxt) : cB;
        for (int t = 0; t < nt; t += 2) {
            const bool last = (t == nt - 2);
            const char* a1 = cA + (size_t)(t + 1) * kstep;
            const char* a2 = last ? nA : cA + (size_t)(t + 2) * kstep; const char* b2 = last ? nB : cB + (size_t)(t + 2) * kstep;
            const char* a3 = a2 + kstep; const char* b3 = b2 + kstep;
            unsigned t1[2] = {0u, 0u};
            if (Geo::GATHER && last && has_next) {
#pragma unroll
                for (int _i = 0; _i < 2; ++_i) { vC[0][_i] = (g.a_row(nxt, Rs[_i]) * (unsigned)g.lda + (unsigned)Cs[_i]) * 2u; t1[_i] = (g.a_row(nxt, HALF + Rs[_i]) * (unsigned)g.lda + (unsigned)Cs[_i]) * 2u; }
            }
            PG8_LDB(B0, 0, 0); PG8_LDB(B1, 0, 1); PG8_SCHED; PG8_LDA(At, 0, 0); PG8_STAGE(PG8_SA(1, 1), a1, vC[1]);
            if (Geo::GATHER && last && has_next) { vC[1][0] = t1[0]; vC[1][1] = t1[1]; }
            PG8_WAIT_V(8); PG8_WAIT_L(0); PG8_BAR; PG8_MMA(0, 0, At, B0); PG8_MMA(0, 1, At, B1); PG8_BAR; PG8_SCHED;
            PG8_LDA(At, 0, 1); PG8_STAGE(PG8_SB(0, 0), b2, voffB); PG8_STAGE(PG8_SB(0, 1), b2 + hstepB, voffB); PG8_STAGE(PG8_SA(0, 0), a2, vC[0]);
            PG8_WAIT_V(8); PG8_WAIT_L(0); PG8_BAR; PG8_MMA(1, 0, At, B0); PG8_MMA(1, 1, At, B1); PG8_BAR; PG8_SCHED;
            PG8_LDB(B0, 1, 0); PG8_LDB(B1, 1, 1); PG8_SCHED; PG8_LDA(At, 1, 0); PG8_STAGE(PG8_SA(0, 1), a2, vC[1]);
            PG8_WAIT_V(8); PG8_WAIT_L(0); PG8_BAR; PG8_MMA(0, 0, At, B0); PG8_MMA(0, 1, At, B1); PG8_BAR; PG8_SCHED;
            PG8_LDA(At, 1, 1); PG8_STAGE(PG8_SB(1, 0), b3, voffB); PG8_STAGE(PG8_SB(1, 1), b3 + hstepB, voffB); PG8_STAGE(PG8_SA(1, 0), a3, vC[0]);
            PG8_WAIT_V(8); PG8_WAIT_L(0); PG8_BAR; PG8_MMA(1, 0, At, B0); PG8_MMA(1, 1, At, B1); PG8_BAR; PG8_SCHED;
        }
        if (wr == 0) PG8_BAR;
        E(acc, cur, wr, wc, fr, fq);
        if (!has_next) break;
#pragma unroll
        for (int a = 0; a < 2; ++a)
#pragma unroll
            for (int b = 0; b < 2; ++b)
#pragma unroll
                for (int m = 0; m < 4; ++m)
#pragma unroll
                    for (int n = 0; n < 2; ++n) acc[a][b][m][n] = (f32x4){0.f, 0.f, 0.f, 0.f};
        cur = nxt; cA = nA; cB = nB; ++ui;
        if (wr == 1) PG8_BAR;
    }
    PG8_WAIT_V(0);
    PG8_BAR;
#undef PG8_SA
#undef PG8_SB
#undef PG8_STAGE
#undef PG8_LDA
#undef PG8_LDB
#undef PG8_MMA
#undef PG8_WAIT_V
#undef PG8_WAIT_L
#undef PG8_BAR
#undef PG8_SCHED
#undef PG8_SETV
}
}

struct GeoPlain {
    static constexpr bool GATHER = false;
    const bf16* A; const bf16* Bt; int K, lda, ldb;
    __device__ __forceinline__ const char* a_tile(const pg8::Unit& u) const { return (const char*)(A + (size_t)u.pm * 256 * lda); }
    __device__ __forceinline__ const char* b_tile(const pg8::Unit& u) const { return (const char*)(Bt + (size_t)u.pn * 256 * ldb); }
    __device__ __forceinline__ unsigned a_row(const pg8::Unit&, int R) const { return (unsigned)R; }
};
struct GeoMergeA {
    static constexpr bool GATHER = false;
    const bf16* ZZ; const bf16* Bt; int K, lda, ldb;
    __device__ __forceinline__ const char* a_tile(const pg8::Unit& u) const { const int br = u.pn >> 2; const int co = br == 0 ? ZC_Q : (br == 1 ? ZC_LG : ZC_Z); return (const char*)(ZZ + (size_t)u.pm * 256 * ZLD + co); }
    __device__ __forceinline__ const char* b_tile(const pg8::Unit& u) const { return (const char*)(Bt + (size_t)u.pn * 256 * 512); }
    __device__ __forceinline__ unsigned a_row(const pg8::Unit&, int R) const { return (unsigned)R; }
};
struct GeoMoeUp {
    static constexpr bool GATHER = true;
    const bf16* A; const bf16* Bt; const int* row_tok; const int* tile_e; int K, lda, ldb;
    __device__ __forceinline__ const char* a_tile(const pg8::Unit&) const { return (const char*)A; }
    __device__ __forceinline__ const char* b_tile(const pg8::Unit& u) const { const int e = __builtin_amdgcn_readfirstlane(tile_e[u.pm]); return (const char*)(Bt + ((size_t)e * 512 + (size_t)u.pn * 256) * 1024); }
    __device__ __forceinline__ unsigned a_row(const pg8::Unit& u, int R) const { return (unsigned)row_tok[u.pm * 256 + R]; }
};
struct GeoMoeDown {
    static constexpr bool GATHER = false;
    const bf16* A; const bf16* Bt; const int* tile_e; int K, lda, ldb;
    __device__ __forceinline__ const char* a_tile(const pg8::Unit& u) const { return (const char*)(A + (size_t)u.pm * 256 * 256); }
    __device__ __forceinline__ const char* b_tile(const pg8::Unit& u) const { const int e = __builtin_amdgcn_readfirstlane(tile_e[u.pm]); return (const char*)(Bt + ((size_t)e * 1024 + (size_t)u.pn * 256) * 256); }
    __device__ __forceinline__ unsigned a_row(const pg8::Unit&, int R) const { return (unsigned)R; }
};

struct EpiInProj {
    static constexpr bool PERM = true;
    bf16* ZZ; const float* cosT; const float* sinT;
    __device__ __forceinline__ void operator()(const f32x4 (&acc)[2][2][4][2], const pg8::Unit& u, int wr, int wc, int fr, int fq) const {
        const int row0 = u.pm * 256 + wr * 64 + fr, colt = u.pn * 256 + wc * 32 + 8 * fq;
        const int kind = u.pn < 4 ? 0 : ((u.pn >= 16 && u.pn < 28) ? 2 : 1);
#pragma unroll
        for (int ai = 0; ai < 2; ++ai)
#pragma unroll
            for (int m = 0; m < 4; ++m) {
                const int row = row0 + ai * 128 + m * 16;
                bf16* rowp = ZZ + (size_t)row * ZLD + colt;
#pragma unroll
                for (int bj = 0; bj < 2; ++bj) {
                    f32x4 v0 = acc[ai][bj][m][0], v1 = acc[ai][bj][m][1];
                    if (kind == 0) {
                        if (row < NLAT) {
                            const int t = row & 4095, i0 = ((colt + bj * 128) & 63) >> 1;
                            const f32x4 c = *(const f32x4*)(cosT + t * 32 + i0), s = *(const f32x4*)(sinT + t * 32 + i0);
                            f32x4 a, b;
                            a[0] = v0[0] * c[0] - v0[1] * s[0]; a[1] = v0[1] * c[0] + v0[0] * s[0];
                            a[2] = v0[2] * c[1] - v0[3] * s[1]; a[3] = v0[3] * c[1] + v0[2] * s[1];
                            b[0] = v1[0] * c[2] - v1[1] * s[2]; b[1] = v1[1] * c[2] + v1[0] * s[2];
                            b[2] = v1[2] * c[3] - v1[3] * s[3]; b[3] = v1[3] * c[3] + v1[2] * s[3];
                            v0 = a; v1 = b;
                        }
                    } else if (kind == 2) {
#pragma unroll
                        for (int j = 0; j < 4; ++j) { v0[j] = sigmoidf_(v0[j]); v1[j] = sigmoidf_(v1[j]); }
                    }
                    u32x4 w; w.x = cvt_pk_bf16(v0[0], v0[1]); w.y = cvt_pk_bf16(v0[2], v0[3]); w.z = cvt_pk_bf16(v1[0], v1[1]); w.w = cvt_pk_bf16(v1[2], v1[3]);
                    *(u32x4*)(rowp + bj * 128) = w;
                }
                asm volatile("" ::: "memory");
            }
    }
};
struct EpiMergeA {
    static constexpr bool PERM = true;
    bf16* ZZ;
    __device__ __forceinline__ void operator()(const f32x4 (&acc)[2][2][4][2], const pg8::Unit& u, int wr, int wc, int fr, int fq) const {
        const int row0 = u.pm * 256 + wr * 64 + fr, colt = ZC_GATE + u.pn * 256 + wc * 32 + 8 * fq;
#pragma unroll
        for (int ai = 0; ai < 2; ++ai)
#pragma unroll
            for (int m = 0; m < 4; ++m) {
                bf16* rowp = ZZ + (size_t)(row0 + ai * 128 + m * 16) * ZLD + colt;
#pragma unroll
                for (int bj = 0; bj < 2; ++bj) {
                    const u32x4 gq = *(const u32x4*)(rowp + bj * 128);
                    const f32x4 v0 = acc[ai][bj][m][0], v1 = acc[ai][bj][m][1];
                    u32x4 w;
                    w.x = cvt_pk_bf16(v0[0] * bflo(gq.x), v0[1] * bfhi(gq.x)); w.y = cvt_pk_bf16(v0[2] * bflo(gq.y), v0[3] * bfhi(gq.y));
                    w.z = cvt_pk_bf16(v1[0] * bflo(gq.z), v1[1] * bfhi(gq.z)); w.w = cvt_pk_bf16(v1[2] * bflo(gq.w), v1[3] * bfhi(gq.w));
                    *(u32x4*)(rowp + bj * 128) = w;
                }
                asm volatile("" ::: "memory");
            }
    }
};
struct EpiBf16Plain {
    static constexpr bool PERM = true;
    bf16* O; int ldc;
    __device__ __forceinline__ void operator()(const f32x4 (&acc)[2][2][4][2], const pg8::Unit& u, int wr, int wc, int fr, int fq) const {
        const int row0 = u.pm * 256 + wr * 64 + fr, colt = u.pn * 256 + wc * 32 + 8 * fq;
#pragma unroll
        for (int ai = 0; ai < 2; ++ai)
#pragma unroll
            for (int m = 0; m < 4; ++m) {
                bf16* rowp = O + (size_t)(row0 + ai * 128 + m * 16) * ldc + colt;
#pragma unroll
                for (int bj = 0; bj < 2; ++bj) {
                    const f32x4 v0 = acc[ai][bj][m][0], v1 = acc[ai][bj][m][1];
                    u32x4 w; w.x = cvt_pk_bf16(v0[0], v0[1]); w.y = cvt_pk_bf16(v0[2], v0[3]); w.z = cvt_pk_bf16(v1[0], v1[1]); w.w = cvt_pk_bf16(v1[2], v1[3]);
                    *(u32x4*)(rowp + bj * 128) = w;
                }
            }
    }
};
template <bool ROUTED> struct EpiSwiGLU {
    static constexpr bool PERM = true;
    bf16* O; const float* roww;
    __device__ __forceinline__ void operator()(const f32x4 (&acc)[2][2][4][2], const pg8::Unit& u, int wr, int wc, int fr, int fq) const {
        const int row0 = u.pm * 256 + wr * 64 + fr, colt = u.pn * 128 + wc * 32 + 8 * fq;
#pragma unroll
        for (int ai = 0; ai < 2; ++ai)
#pragma unroll
            for (int m = 0; m < 4; ++m) {
                const int row = row0 + ai * 128 + m * 16;
                const float rw = ROUTED ? roww[row] : 1.0f;
                const f32x4 g0 = acc[ai][0][m][0], g1 = acc[ai][0][m][1], u0 = acc[ai][1][m][0], u1 = acc[ai][1][m][1];
                f32x4 a, b;
#pragma unroll
                for (int j = 0; j < 4; ++j) { a[j] = siluf_(g0[j]) * u0[j] * rw; b[j] = siluf_(g1[j]) * u1[j] * rw; }
                u32x4 w; w.x = cvt_pk_bf16(a[0], a[1]); w.y = cvt_pk_bf16(a[2], a[3]); w.z = cvt_pk_bf16(b[0], b[1]); w.w = cvt_pk_bf16(b[2], b[3]);
                *(u32x4*)(O + (size_t)row * 256 + colt) = w;
                asm volatile("" ::: "memory");
            }
    }
};
struct EpiRouter {
    static constexpr bool PERM = false;
    float* L;
    __device__ __forceinline__ void operator()(const f32x4 (&acc)[2][2][4][2], const pg8::Unit& u, int wr, int wc, int fr, int fq) const {
        if (wc >= 2) return;
        const int row0 = u.pm * 256 + wr * 64 + fr, col0 = wc * 32 + 4 * fq;
#pragma unroll
        for (int ai = 0; ai < 2; ++ai)
#pragma unroll
            for (int m = 0; m < 4; ++m) {
                float* rowp = L + (size_t)(row0 + ai * 128 + m * 16) * 64 + col0;
#pragma unroll
                for (int n = 0; n < 2; ++n) *(f32x4*)(rowp + n * 16) = acc[ai][0][m][n] + acc[ai][1][m][n];
            }
    }
};
struct EpiSharedDown {
    static constexpr bool PERM = false;
    float* X; const float* modl;
    __device__ __forceinline__ void operator()(const f32x4 (&acc)[2][2][4][2], const pg8::Unit& u, int wr, int wc, int fr, int fq) const {
        const int row0 = u.pm * 256 + wr * 64 + fr, col0 = u.pn * 256 + wc * 32 + 4 * fq;
#pragma unroll
        for (int ai = 0; ai < 2; ++ai)
#pragma unroll
            for (int m = 0; m < 4; ++m) {
                const int row = row0 + ai * 128 + m * 16;
                const int mr = row < NLAT ? (row >> 12) : 8;
                float* rowp = X + (size_t)row * 1024 + col0;
                const float* m5 = modl + (size_t)mr * 6144 + 5 * 1024 + col0;
#pragma unroll
                for (int bj = 0; bj < 2; ++bj)
#pragma unroll
                    for (int n = 0; n < 2; ++n) {
                        const f32x4 xv = *(const f32x4*)(rowp + bj * 128 + n * 16), gv = *(const f32x4*)(m5 + bj * 128 + n * 16);
                        *(f32x4*)(rowp + bj * 128 + n * 16) = xv * DN_ALPHA + gv * acc[ai][bj][m][n];
                    }
                asm volatile("" ::: "memory");
            }
    }
};

namespace att {
constexpr int KVBLK = 64;
constexpr float SCALE = 0.125f, THR = 8.f;
constexpr size_t SHM_V = KVBLK * 128 * 2, SHM_K = KVBLK * 128 * 2;
constexpr size_t SHM_ATTN = 2 * SHM_V + 2 * SHM_K + 8 * 64 * 4;
#define KSWZ(row, colB) ((row) * 256 + ((colB) ^ (((row) & 7) << 4)))
#define SBAR() __builtin_amdgcn_sched_barrier(0)
__device__ __forceinline__ int crow(int r, int hi) { return (r & 3) + 8 * (r >> 2) + 4 * hi; }
__device__ __forceinline__ void partialSM(f32x16& p0, f32x16& p1, float& m_reg, float& mn, float& alpha) {
  constexpr float C = SCALE * 1.4426950408889634f;
  float pmax = p0[0];
#pragma unroll
  for (int r = 1; r < 16; ++r) pmax = fmaxf(pmax, p0[r]);
#pragma unroll
  for (int r = 0; r < 16; ++r) pmax = fmaxf(pmax, p1[r]);
  { auto rr = __builtin_amdgcn_permlane32_swap(__float_as_uint(pmax), __float_as_uint(pmax), false, false);
    pmax = fmaxf(__uint_as_float(rr[0]), __uint_as_float(rr[1])); }
  if (__builtin_expect(__all(pmax - m_reg <= THR / SCALE), 1)) { mn = m_reg; alpha = 1.f; }
  else { mn = fmaxf(m_reg, pmax); alpha = __builtin_amdgcn_exp2f((m_reg - mn) * C); m_reg = mn; }
  float mnC = -mn * C;
#pragma unroll
  for (int r = 0; r < 16; ++r) p0[r] = fmaf(p0[r], C, mnC);
#pragma unroll
  for (int r = 0; r < 16; ++r) p1[r] = fmaf(p1[r], C, mnC);
#pragma unroll
  for (int r = 0; r < 16; ++r) p0[r] = __builtin_amdgcn_exp2f(p0[r]);
}
__device__ __forceinline__ void finishSM(f32x16& p0, f32x16& p1, float alpha, float& l_reg, bf16x8& pa0, bf16x8& pa1, bf16x8& pa2, bf16x8& pa3) {
#pragma unroll
  for (int r = 0; r < 16; ++r) p1[r] = __builtin_amdgcn_exp2f(p1[r]);
  float ps = 0;
#pragma unroll
  for (int r = 0; r < 16; ++r) ps += p0[r];
#pragma unroll
  for (int r = 0; r < 16; ++r) ps += p1[r];
  { auto rr = __builtin_amdgcn_permlane32_swap(__float_as_uint(ps), __float_as_uint(ps), false, false);
    ps = __uint_as_float(rr[0]) + __uint_as_float(rr[1]); }
  l_reg = l_reg * alpha + ps;
#define PK4(P, BASE, OUT) do { unsigned a0 = cvt_pk_bf16(P[BASE + 0], P[BASE + 1]), a1 = cvt_pk_bf16(P[BASE + 2], P[BASE + 3]);   \
    unsigned b0 = cvt_pk_bf16(P[BASE + 4], P[BASE + 5]), b1 = cvt_pk_bf16(P[BASE + 6], P[BASE + 7]);                              \
    auto r0 = __builtin_amdgcn_permlane32_swap(a0, b0, false, false); auto r1 = __builtin_amdgcn_permlane32_swap(a1, b1, false, false); \
    u32x4 w = {r0[0], r1[0], r0[1], r1[1]}; OUT = *reinterpret_cast<bf16x8*>(&w); } while (0)
  PK4(p0, 0, pa0); PK4(p0, 8, pa1); PK4(p1, 0, pa2); PK4(p1, 8, pa3);
#undef PK4
}
__device__ __forceinline__ void qkt(f32x16& p0, f32x16& p1, const char* Ks, const bf16x8 (&qr)[4], int r32, int hi, int mcol) {
  p0 = f32x16{}; p1 = f32x16{};
#pragma unroll
  for (int d0 = 0; d0 < 4; ++d0) { int cb = (mcol + d0 * 16 + hi * 8) * 2;
    bf16x8 b0 = *reinterpret_cast<const bf16x8*>(Ks + KSWZ(r32, cb));
    bf16x8 b1 = *reinterpret_cast<const bf16x8*>(Ks + KSWZ(32 + r32, cb));
    p0 = __builtin_amdgcn_mfma_f32_32x32x16_bf16(b0, qr[d0], p0, 0, 0, 0);
    p1 = __builtin_amdgcn_mfma_f32_32x32x16_bf16(b1, qr[d0], p1, 0, 0, 0); }
}
__device__ __forceinline__ int v_st(int k, int c) { const int kk = (k & ~0xC) | ((k & 4) << 1) | ((k & 8) >> 1); return ((kk >> 3) * 4 + (c >> 5)) * 512 + ((kk & 7) * 32 + (c & 31)) * 2; }
__device__ __forceinline__ int v_rd_base(int lane) { return ((lane & 3) << 3) | (((lane >> 2) & 3) << 6) | (((lane >> 4) & 1) << 5) | (((lane >> 5) & 1) << 8); }
constexpr int v_rd_off(int d0, int ks, int half) { return d0 * 512 + ks * 4096 + half * 2048; }
template <int OFF> __device__ __forceinline__ s16x4 tr_read(int vb) {
  s16x4 r; asm volatile("ds_read_b64_tr_b16 %0, %1 offset:%2" : "=&v"(r) : "v"(vb), "i"(OFF) : "memory"); return r;
}
template <int D0> __device__ __forceinline__ void pv_one(f32x16& od, int vb, bf16x8 pa0, bf16x8 pa1, bf16x8 pa2, bf16x8 pa3) {
  const s16x4 l0 = tr_read<v_rd_off(D0, 0, 0)>(vb), h0 = tr_read<v_rd_off(D0, 0, 1)>(vb), l1 = tr_read<v_rd_off(D0, 1, 0)>(vb), h1 = tr_read<v_rd_off(D0, 1, 1)>(vb);
  const s16x4 l2 = tr_read<v_rd_off(D0, 2, 0)>(vb), h2 = tr_read<v_rd_off(D0, 2, 1)>(vb), l3 = tr_read<v_rd_off(D0, 3, 0)>(vb), h3 = tr_read<v_rd_off(D0, 3, 1)>(vb);
  asm volatile("s_waitcnt lgkmcnt(0)" ::: "memory"); SBAR();
#define PK(L, H) (bf16x8){L[0], L[1], L[2], L[3], H[0], H[1], H[2], H[3]}
  od = __builtin_amdgcn_mfma_f32_32x32x16_bf16(pa0, PK(l0, h0), od, 0, 0, 0);
  od = __builtin_amdgcn_mfma_f32_32x32x16_bf16(pa1, PK(l1, h1), od, 0, 0, 0);
  od = __builtin_amdgcn_mfma_f32_32x32x16_bf16(pa2, PK(l2, h2), od, 0, 0, 0);
  od = __builtin_amdgcn_mfma_f32_32x32x16_bf16(pa3, PK(l3, h3), od, 0, 0, 0);
#undef PK
}
__device__ __forceinline__ void pv_d0(f32x16* o, int vb, bf16x8 pa0, bf16x8 pa1, bf16x8 pa2, bf16x8 pa3) {
  pv_one<0>(o[0], vb, pa0, pa1, pa2, pa3); pv_one<1>(o[1], vb, pa0, pa1, pa2, pa3); pv_one<2>(o[2], vb, pa0, pa1, pa2, pa3); pv_one<3>(o[3], vb, pa0, pa1, pa2, pa3);
}
static __device__ __forceinline__ void attn_unit(bf16* __restrict__ ZZ_, int qrow0_, int h_, int krowA_, int ntA_, int krowB_, int NT_, float lam_, const float* __restrict__ gn_, float oscale_) {
  bf16* __restrict__ ZZ = uni(ZZ_); const int qrow0 = uni(qrow0_), h = uni(h_), krowA = uni(krowA_), ntA = uni(ntA_), krowB = uni(krowB_), NT = uni(NT_); const float lam = uni(lam_), oscale = uni(oscale_); const float* __restrict__ gn = uni(gn_);
  char* lds = (char*)lds_raw;
  const int tid = otid(), wid = tid >> 6, lane = tid & 63, r32 = lane & 31, hi = lane >> 5;
  const int map = wid >> 2, wq = wid & 3, mcol = map * 64;
  char* V_lds = lds; char* K_lds = lds + 2 * SHM_V;
  float* ws = (float*)(lds + 2 * SHM_V + 2 * SHM_K) + wid * 64; float* li_l = ws; float* al_l = ws + 32;
  float m_reg = -1e30f, l_reg = 0; f32x16 o[4] = {}; bf16x8 qr[4];
  const bf16* Qw = ZZ + (size_t)(qrow0 + wq * 32 + r32) * ZLD + ZC_Q + h * 128 + mcol + hi * 8;
#pragma unroll
  for (int d0 = 0; d0 < 4; ++d0) qr[d0] = *reinterpret_cast<const bf16x8*>(Qw + d0 * 16);
  const int sr = tid >> 4, sc = (tid & 15) * 8, vst0 = v_st(sr, sc), vst1 = v_st(32 + sr, sc);
  const int vb0 = (int)(uintptr_t)(LAS char*)V_lds + v_rd_base(lane);
  const bf16* Kcol = ZZ + ZC_K + h * 128 + sc; const bf16* Vcol = ZZ + ZC_V + h * 128 + sc;
  struct { bf16x8 vs0, vs1, ks0, ks1; } sr_[2];
#define KROW(j) ((j) < ntA ? krowA + (j) * KVBLK : krowB + ((j) - ntA) * KVBLK)
#define SLOAD(i, j) do { const size_t _r0 = (size_t)(KROW(j) + sr) * ZLD, _r1 = _r0 + (size_t)32 * ZLD; \
    sr_[i].vs0 = *reinterpret_cast<const bf16x8*>(Vcol + _r0); sr_[i].vs1 = *reinterpret_cast<const bf16x8*>(Vcol + _r1); \
    sr_[i].ks0 = *reinterpret_cast<const bf16x8*>(Kcol + _r0); sr_[i].ks1 = *reinterpret_cast<const bf16x8*>(Kcol + _r1); } while (0)
#define SWRITE(b, i) do { *(bf16x8*)(V_lds + (b) * SHM_V + vst0) = sr_[i].vs0;          \
    *(bf16x8*)(V_lds + (b) * SHM_V + vst1) = sr_[i].vs1; int kc = sc * 2;               \
    *(bf16x8*)(K_lds + (b) * SHM_K + KSWZ(sr, kc)) = sr_[i].ks0;                       \
    *(bf16x8*)(K_lds + (b) * SHM_K + KSWZ(32 + sr, kc)) = sr_[i].ks1; } while (0)
#define SWAIT() asm volatile("s_waitcnt vmcnt(4)" ::: "memory")
#define RESC(a) do { if (__any((a) < 1.f)) { if (hi == 0) al_l[r32] = (a); asm volatile("s_waitcnt lgkmcnt(0)" ::: "memory"); \
    _Pragma("unroll") for (int d = 0; d < 4; ++d) _Pragma("unroll") for (int r = 0; r < 16; ++r) o[d][r] *= al_l[crow(r, hi)]; } } while (0)
  f32x16 pA0, pA1, pB0, pB1; float mnA, mnB, alA, alB; bf16x8 pa0, pa1, pa2, pa3;
  constexpr int SE = 0, SO = 1;
  SLOAD(SE, 0); asm volatile("s_waitcnt vmcnt(0)" ::: "memory"); SWRITE(0, SE); __syncthreads();
  qkt(pA0, pA1, K_lds, qr, r32, hi, mcol); partialSM(pA0, pA1, m_reg, mnA, alA);
  SLOAD(SO, 1); if (2 < NT) SLOAD(SE, 2);
  SWAIT(); SWRITE(1, SO); __syncthreads();
  for (int j = 1; j + 1 < NT; j += 2) {
    SBAR(); qkt(pB0, pB1, K_lds + SHM_K, qr, r32, hi, mcol);
    finishSM(pA0, pA1, alA, l_reg, pa0, pa1, pa2, pa3); SBAR();
    SLOAD(SO, j + 2); SBAR();
    pv_d0(o, vb0, pa0, pa1, pa2, pa3); partialSM(pB0, pB1, m_reg, mnB, alB);
    __syncthreads(); SWAIT(); SWRITE(0, SE);
    RESC(alB); __syncthreads();
    SBAR(); qkt(pA0, pA1, K_lds, qr, r32, hi, mcol);
    finishSM(pB0, pB1, alB, l_reg, pa0, pa1, pa2, pa3); SBAR();
    if (j + 3 < NT) SLOAD(SE, j + 3); SBAR();
    pv_d0(o, vb0 + (int)SHM_V, pa0, pa1, pa2, pa3); partialSM(pA0, pA1, m_reg, mnA, alA);
    __syncthreads(); SWAIT(); SWRITE(1, SO);
    RESC(alA); __syncthreads();
  }
  SBAR(); qkt(pB0, pB1, K_lds + SHM_K, qr, r32, hi, mcol);
  finishSM(pA0, pA1, alA, l_reg, pa0, pa1, pa2, pa3); SBAR();
  pv_d0(o, vb0, pa0, pa1, pa2, pa3); partialSM(pB0, pB1, m_reg, mnB, alB);
  __syncthreads(); RESC(alB);
  finishSM(pB0, pB1, alB, l_reg, pa0, pa1, pa2, pa3); SBAR();
  pv_d0(o, vb0 + (int)SHM_V, pa0, pa1, pa2, pa3);
  if (hi == 0) li_l[r32] = l_reg; asm volatile("s_waitcnt lgkmcnt(0)" ::: "memory");
  float rli[16];
#pragma unroll
  for (int r = 0; r < 16; ++r) rli[r] = __builtin_amdgcn_rcpf(li_l[crow(r, hi)]);
  __syncthreads();
  float* xch = (float*)lds + (size_t)wq * 4096;
  if (map == 1) {
#pragma unroll
    for (int d0 = 0; d0 < 4; ++d0)
#pragma unroll
      for (int r = 0; r < 16; ++r) xch[(d0 * 16 + r) * 64 + lane] = o[d0][r] * rli[r];
  }
  __syncthreads();
  if (map == 0) {
    float ss[16];
#pragma unroll
    for (int r = 0; r < 16; ++r) ss[r] = 0.f;
#pragma unroll
    for (int d0 = 0; d0 < 4; ++d0)
#pragma unroll
      for (int r = 0; r < 16; ++r) { const float v = o[d0][r] * rli[r] - lam * xch[(d0 * 16 + r) * 64 + lane]; o[d0][r] = v; ss[r] += v * v; }
#pragma unroll
    for (int r = 0; r < 16; ++r) {
#pragma unroll
      for (int off = 1; off < 32; off <<= 1) ss[r] += __shfl_xor(ss[r], off);
      ss[r] = __builtin_amdgcn_rsqf(ss[r] * (1.0f / 128.0f) + RMS_EPS) * oscale;
    }
    float gv[4];
#pragma unroll
    for (int d0 = 0; d0 < 4; ++d0) gv[d0] = gn[d0 * 32 + r32];
    bf16* Ow = ZZ + (size_t)(qrow0 + wq * 32) * ZLD + ZC_Q + h * 128 + r32;
#pragma unroll
    for (int r = 0; r < 16; ++r) { const int orow = crow(r, hi);
#pragma unroll
      for (int d0 = 0; d0 < 4; ++d0) Ow[(size_t)orow * ZLD + d0 * 32] = (bf16)f2bf(o[d0][r] * ss[r] * gv[d0]); }
  }
#undef KROW
#undef SLOAD
#undef SWRITE
#undef SWAIT
#undef RESC
}
#undef KSWZ
#undef SBAR
}

__device__ __forceinline__ f32x4 mma_tile(const LAS char* A, int sa, const LAS char* B, int sb, int ksteps, int lane, f32x4 acc) {
    const int r = lane & 15, q = lane >> 4;
    for (int k = 0; k < ksteps; ++k) {
        const bf16x8 a = *(const LAS bf16x8*)(A + r * sa + (k * 32 + q * 8) * 2);
        const bf16x8 b = *(const LAS bf16x8*)(B + r * sb + (k * 32 + q * 8) * 2);
        acc = __builtin_amdgcn_mfma_f32_16x16x32_bf16(a, b, acc, 0, 0, 0);
    }
    return acc;
}

namespace ssd {
constexpr int PC = 272, PX = 144;
constexpr int BUFB = 64 * PC * 2 + 64 * PX;
constexpr int O_C = 0, O_B = 64 * PC, O_X = 2 * 64 * PC, O_XW = 2 * BUFB, O_MM = O_XW + 64 * PX, O_SB = O_MM + 64 * PX, O_ACS = O_SB + 64 * PC, O_END = O_ACS + 2 * 128 * 4;
static_assert(O_END <= 131072, "ssd lds");
struct Par { const bf16* XA; const float* DT; const float* ACS; bf16* Y; float Dskip; int b, h, d; };
__device__ __forceinline__ bf16x8 tr_frag(const LAS char* T, int pitch, int kbase, int idx0, int lane) {
    const int gq = lane >> 4, j = lane & 15;
    const LAS char* p0 = T + (kbase + 8 * gq + (j >> 2)) * pitch + (idx0 + 4 * (j & 3)) * 2;
    const s16x4 lo = __builtin_amdgcn_ds_read_tr16_b64_v4i16((LAS s16x4*)p0), hi = __builtin_amdgcn_ds_read_tr16_b64_v4i16((LAS s16x4*)(p0 + 4 * pitch));
    return (bf16x8){lo[0], lo[1], lo[2], lo[3], hi[0], hi[1], hi[2], hi[3]};
}
static __device__ __forceinline__ void unit(Par P_) {
    Par P; P.XA = uni(P_.XA); P.DT = uni(P_.DT); P.ACS = uni(P_.ACS); P.Y = uni(P_.Y); P.Dskip = uni(P_.Dskip); P.b = uni(P_.b); P.h = uni(P_.h); P.d = uni(P_.d);
    LAS char* lds = (LAS char*)lds_raw;
    const int tid = otid(), wid = __builtin_amdgcn_readfirstlane(tid >> 6), lane = tid & 63, fr = lane & 15, fq = lane >> 4;
    const int g = P.h >> 2, dh = P.d * 8 + P.h;
    for (int i = tid; i < 64 * PC / 4; i += 512) ((LAS unsigned*)(lds + O_SB))[i] = 0u;
    f32x4 Sacc[4];
#pragma unroll
    for (int i = 0; i < 4; ++i) Sacc[i] = (f32x4){0.f, 0.f, 0.f, 0.f};
    u32x4 st[5]; float sa = 0.f;
#define CH_ROW(ch, pos) (((ch) < 4 ? NLAT + P.b * CTXL : P.b * SEQ) + (P.d ? ((ch) < 4 ? CTXL : SEQ) - 1 - ((((ch) < 4) ? (ch) : (ch) - 4) * 64 + (pos)) : (((ch) < 4) ? (ch) : (ch) - 4) * 64 + (pos)))
#define SSD_LOAD(ch) do { \
        _Pragma("unroll") for (int i_ = 0; i_ < 5; ++i_) { const int q_ = tid + 512 * i_; \
            const int row_ = i_ < 4 ? ((q_ & 1023) >> 4) : ((q_ - 2048) >> 3); const int pc_ = i_ < 4 ? (q_ & 15) : (q_ & 7); \
            const int col_ = i_ < 2 ? 768 + g * 128 + pc_ * 8 : (i_ < 4 ? 512 + g * 128 + pc_ * 8 : P.h * 64 + pc_ * 8); \
            st[i_] = *(const u32x4*)(P.XA + (size_t)CH_ROW(ch, row_) * 1024 + col_); } \
        if (tid < 128) { const int r_ = CH_ROW(ch, tid & 63); sa = tid < 64 ? P.ACS[(size_t)r_ * 16 + dh] : P.DT[(size_t)r_ * 16 + dh]; } } while (0)
#define SSD_WRITE(bf) do { \
        _Pragma("unroll") for (int i_ = 0; i_ < 5; ++i_) { const int q_ = tid + 512 * i_; \
            const int row_ = i_ < 4 ? ((q_ & 1023) >> 4) : ((q_ - 2048) >> 3); const int pc_ = i_ < 4 ? (q_ & 15) : (q_ & 7); \
            const int off_ = i_ < 2 ? O_C + row_ * PC + pc_ * 16 : (i_ < 4 ? O_B + row_ * PC + pc_ * 16 : O_X + row_ * PX + pc_ * 16); \
            *(LAS u32x4*)(lds + (bf) * BUFB + off_) = st[i_]; } \
        if (tid < 128) *(LAS float*)(lds + O_ACS + (bf) * 512 + tid * 4) = sa; } while (0)
    SSD_LOAD(0); SSD_WRITE(0); SSD_LOAD(1);
    __syncthreads();
    for (int ch = 0; ch < 68; ++ch) {
        const int bf = ch & 1;
        if (ch + 1 < 68) SSD_WRITE(bf ^ 1);
        if (ch + 2 < 68) SSD_LOAD(ch + 2);
        const LAS char* Cb = lds + bf * BUFB + O_C; const LAS char* Bb = lds + bf * BUFB + O_B; const LAS char* Xb = lds + bf * BUFB + O_X;
        const LAS float* ACSb = (const LAS float*)(lds + O_ACS + bf * 512); const LAS float* DTb = ACSb + 64;
        const float acs_end = ACSb[63];
        { const int s_ = tid >> 3, pc = tid & 7; const float sc = DTb[s_] * fexp(acs_end - ACSb[s_]);
          const u32x4 xv = *(const LAS u32x4*)(Xb + s_ * PX + pc * 16); u32x4 w;
          w.x = cvt_pk_bf16(bflo(xv.x) * sc, bfhi(xv.x) * sc); w.y = cvt_pk_bf16(bflo(xv.y) * sc, bfhi(xv.y) * sc); w.z = cvt_pk_bf16(bflo(xv.z) * sc, bfhi(xv.z) * sc); w.w = cvt_pk_bf16(bflo(xv.w) * sc, bfhi(xv.w) * sc);
          *(LAS u32x4*)(lds + O_XW + s_ * PX + pc * 16) = w; }
        const int lt = wid >> 1, h2 = wid & 1;
        f32x4 yo[2];
#pragma unroll
        for (int i = 0; i < 2; ++i) {
            const int st_ = h2 * 2 + i;
            f32x4 gacc = (f32x4){0.f, 0.f, 0.f, 0.f};
            if (st_ <= lt) gacc = mma_tile(Cb + lt * 16 * PC, PC, Bb + st_ * 16 * PC, PC, 4, lane, gacc);
            const int s = st_ * 16 + fr; const float as = ACSb[s], ds = DTb[s];
#pragma unroll
            for (int jj = 0; jj < 4; ++jj) { const int l = lt * 16 + fq * 4 + jj; const float v = (s <= l) ? gacc[jj] * fexp(ACSb[l] - as) * ds : 0.f;
                *(LAS bf16*)(lds + O_MM + l * PX + s * 2) = (bf16)f2bf(v); }
            yo[i] = mma_tile(Cb + lt * 16 * PC, PC, lds + O_SB + st_ * 16 * PC, PC, 4, lane, (f32x4){0.f, 0.f, 0.f, 0.f});
        }
        __syncthreads();
#pragma unroll
        for (int i = 0; i < 2; ++i) {
            const int pt = h2 * 2 + i;
            f32x4 yd = (f32x4){0.f, 0.f, 0.f, 0.f};
#pragma unroll
            for (int ks = 0; ks < 2; ++ks) { const bf16x8 af = *(const LAS bf16x8*)(lds + O_MM + (lt * 16 + fr) * PX + (ks * 32 + fq * 8) * 2); const bf16x8 bfr = tr_frag(Xb, PX, ks * 32, pt * 16, lane);
                yd = __builtin_amdgcn_mfma_f32_16x16x32_bf16(af, bfr, yd, 0, 0, 0); }
            const int p = pt * 16 + fr;
#pragma unroll
            for (int jj = 0; jj < 4; ++jj) { const int l = lt * 16 + fq * 4 + jj; float y = yd[jj] + fexp(ACSb[l]) * yo[i][jj];
                if (P.d == 0) y += P.Dskip * bf2f(*(const LAS bf16*)(Xb + l * PX + p * 2));
                P.Y[(size_t)CH_ROW(ch, l) * 512 + P.h * 64 + p] = (bf16)f2bf(y); }
        }
        { const float dec = fexp(acs_end); const int pt = lt;
          bf16x8 af[2];
#pragma unroll
          for (int ks = 0; ks < 2; ++ks) af[ks] = tr_frag(lds + O_XW, PX, ks * 32, pt * 16, lane);
#pragma unroll
          for (int i = 0; i < 4; ++i) { const int nt = h2 * 4 + i;
              f32x4 acc = Sacc[i] * dec;
#pragma unroll
              for (int ks = 0; ks < 2; ++ks) { const bf16x8 bfr = tr_frag(Bb, PC, ks * 32, nt * 16, lane); acc = __builtin_amdgcn_mfma_f32_16x16x32_bf16(af[ks], bfr, acc, 0, 0, 0); }
              Sacc[i] = acc;
              const int n = nt * 16 + fr;
#pragma unroll
              for (int jj = 0; jj < 4; ++jj) { const int p = pt * 16 + fq * 4 + jj; *(LAS bf16*)(lds + O_SB + p * PC + n * 2) = (bf16)f2bf(acc[jj]); } } }
        __syncthreads();
    }
#undef CH_ROW
#undef SSD_LOAD
#undef SSD_WRITE
}
}

namespace lru {
constexpr int SS = 72 * 2;
constexpr int O_U = 0, O_WA = O_U + 128 * SS, O_WI = O_WA + 64 * SS, O_HL = O_WI + 64 * SS, O_CP = O_HL + 32768, O_AGG = O_CP + 32768, O_CW = O_AGG + 8 * 2 * 64 * 4, O_END = O_CW + 64 * 5 * 4;
static_assert(O_END <= 131072, "lru lds");
struct Par { const bf16* ZZ; bf16* Hout; const float* conv_w; const float* conv_b; const float* wa; const float* wi; const float* ba; const float* bi; const float* lam; int b, n, d; };
static __device__ __forceinline__ void unit(Par P_) {
    Par P; P.ZZ = uni(P_.ZZ); P.Hout = uni(P_.Hout); P.conv_w = uni(P_.conv_w); P.conv_b = uni(P_.conv_b); P.wa = uni(P_.wa); P.wi = uni(P_.wi); P.ba = uni(P_.ba); P.bi = uni(P_.bi); P.lam = uni(P_.lam); P.b = uni(P_.b); P.n = uni(P_.n); P.d = uni(P_.d);
    LAS char* lds = (LAS char*)lds_raw;
    const int tid = otid(), wid = __builtin_amdgcn_readfirstlane(tid >> 6), lane = tid & 63, fr = lane & 15, fq = lane >> 4;
    LAS float* HL = (LAS float*)(lds + O_HL) + wid * 1024; LAS float* CP = (LAS float*)(lds + O_CP) + wid * 1024;
    LAS float* AGG = (LAS float*)(lds + O_AGG); LAS float* CW = (LAS float*)(lds + O_CW);
    for (int i = tid; i < 64 * 5; i += 512) { const int lc = i / 5, j = i % 5; const int c = P.n * 64 + lc; CW[i] = j < 4 ? P.conv_w[j * 512 + c] : P.conv_b[c]; }
    for (int i = tid; i < 4096; i += 512) { const int k = i >> 6, j = i & 63;
        *(LAS bf16*)(lds + O_WA + j * SS + k * 2) = (bf16)f2bf(P.wa[i]); *(LAS bf16*)(lds + O_WI + j * SS + k * 2) = (bf16)f2bf(P.wi[i]); }
    const int chn = P.n * 64 + lane;
    const float ba = P.ba[chn], bi = P.bi[chn], c8 = -8.0f * softplusf_(-P.lam[chn]);
    float hc = 0.f;
    __syncthreads();
    for (int ch = 0; ch < 34; ++ch) {
        const bool isctx = ch < 2; const int cc = isctx ? ch : ch - 2; const int Ls = isctx ? CTXL : SEQ; const int rseg = isctx ? NLAT + P.b * CTXL : P.b * SEQ;
        for (int it = tid; it < 128 * 8; it += 512) {
            const int pos = it >> 3, lc0 = (it & 7) * 8;
            const int sp = cc * 128 + pos; const int tk = P.d ? Ls - 1 - sp : sp;
            float u[8];
#pragma unroll
            for (int e = 0; e < 8; ++e) u[e] = CW[(lc0 + e) * 5 + 4];
#pragma unroll
            for (int j = 0; j < 4; ++j) { const int t2 = tk + j - 2;
                if (t2 >= 0 && t2 < Ls) { const u32x4 xv = *(const u32x4*)(P.ZZ + (size_t)(rseg + t2) * ZLD + ZC_LX + P.n * 64 + lc0);
                    u[0] += bflo(xv.x) * CW[(lc0 + 0) * 5 + j]; u[1] += bfhi(xv.x) * CW[(lc0 + 1) * 5 + j]; u[2] += bflo(xv.y) * CW[(lc0 + 2) * 5 + j]; u[3] += bfhi(xv.y) * CW[(lc0 + 3) * 5 + j];
                    u[4] += bflo(xv.z) * CW[(lc0 + 4) * 5 + j]; u[5] += bfhi(xv.z) * CW[(lc0 + 5) * 5 + j]; u[6] += bflo(xv.w) * CW[(lc0 + 6) * 5 + j]; u[7] += bfhi(xv.w) * CW[(lc0 + 7) * 5 + j]; } }
            u32x4 w; w.x = cvt_pk_bf16(u[0], u[1]); w.y = cvt_pk_bf16(u[2], u[3]); w.z = cvt_pk_bf16(u[4], u[5]); w.w = cvt_pk_bf16(u[6], u[7]);
            *(LAS u32x4*)(lds + O_U + pos * SS + lc0 * 2) = w;
        }
        __syncthreads();
#pragma unroll
        for (int jt = 0; jt < 4; ++jt) {
            const f32x4 ga = mma_tile(lds + O_U + wid * 16 * SS, SS, lds + O_WA + jt * 16 * SS, SS, 2, lane, (f32x4){0.f, 0.f, 0.f, 0.f});
            const f32x4 gi = mma_tile(lds + O_U + wid * 16 * SS, SS, lds + O_WI + jt * 16 * SS, SS, 2, lane, (f32x4){0.f, 0.f, 0.f, 0.f});
#pragma unroll
            for (int jj = 0; jj < 4; ++jj) { HL[(fq * 4 + jj) * 64 + jt * 16 + fr] = ga[jj]; CP[(fq * 4 + jj) * 64 + jt * 16 + fr] = gi[jj]; }
        }
        LDS_WAIT();
        float h = 0.f, Pp = 1.f;
        for (int i = 0; i < 16; ++i) {
            const float uo = bf2f(*(const LAS bf16*)(lds + O_U + (wid * 16 + i) * SS + lane * 2));
            const float r = sigmoidf_(HL[i * 64 + lane] + ba), ig = sigmoidf_(CP[i * 64 + lane] + bi), la = c8 * r;
            const float a = __expf(la), bb = sqrtf(-expm1f(2.0f * la)) * (ig * uo);
            h = a * h + bb; Pp *= a;
            HL[i * 64 + lane] = h; CP[i * 64 + lane] = Pp;
        }
        AGG[(wid * 2 + 0) * 64 + lane] = Pp; AGG[(wid * 2 + 1) * 64 + lane] = h;
        __syncthreads();
        float cin = hc, call = hc;
#pragma unroll
        for (int w = 0; w < 8; ++w) { const float pw = AGG[(w * 2 + 0) * 64 + lane], hw = AGG[(w * 2 + 1) * 64 + lane]; call = pw * call + hw; if (w < wid) cin = call; }
        hc = call;
        for (int i = 0; i < 16; ++i) {
            const float hf = HL[i * 64 + lane] + CP[i * 64 + lane] * cin;
            const int sp = cc * 128 + wid * 16 + i; const int tk = P.d ? Ls - 1 - sp : sp;
            P.Hout[(size_t)(rseg + tk) * 512 + chn] = (bf16)f2bf(hf);
        }
        __syncthreads();
    }
}
}

struct Args { const float* in[35]; float* out; unsigned char* ws; int ph_lo, ph_hi; };
constexpr int CTX_OFF = MISC_OFF + 128;
struct Ctx {
    static __device__ __forceinline__ unsigned long long ldp(int i) { int off_ = CTX_OFF + 8 * i; asm volatile("" : "+v"(off_)); const volatile LAS unsigned* p = (const volatile LAS unsigned*)((LAS unsigned char*)lds_raw + off_);
        const unsigned lo = __builtin_amdgcn_readfirstlane(p[0]), hi = __builtin_amdgcn_readfirstlane(p[1]); return ((unsigned long long)hi << 32) | lo; }
    __device__ __forceinline__ const float* in(int i) const { return (const float*)ldp(i); }
    __device__ __forceinline__ float* out() const { return (float*)ldp(35); }
    __device__ __forceinline__ unsigned char* ws() const { return (unsigned char*)ldp(36); }
};
enum { I_X = 0, I_C, I_CTX, I_CCTX, I_WMOD, I_BMOD, I_WIN, I_LAMQ, I_LAMK, I_ATTNG, I_LCW, I_LCB, I_LWA, I_LBA, I_LWI, I_LBI, I_LLAM, I_SCW, I_SCB, I_SDTB, I_SALOG, I_SD, I_SNG,
       I_WBR, I_WOUT, I_LN1G, I_LN1B, I_WRT, I_RBIAS, I_WUP, I_WDN, I_WSU, I_WSD, I_LN2G, I_LN2B };

__device__ __forceinline__ int map_win(int n) {
    if (n < 1024) { const int o = n & 63; return (n & ~63) + 2 * (o & 31) + (o >> 5); }
    if (n < 4096) return n;
    if (n < 4112) return ZC_DT + (n - 4096);
    return ZC_GATE + (n - 4112);
}
__device__ __forceinline__ int map_up(int n) { const int j = n & 255, isu = n >> 8; return (j >> 7) * 256 + isu * 128 + (j & 127); }
template <int MODE> __device__ __forceinline__ void cvt_tile(const float* __restrict__ src, int lds_, int K, int N, bf16* __restrict__ dst, int ldd, int item, LAS float* scr) {
    const int tid = otid(); const int nblk = (N + 63) >> 6; const int kb = item / nblk, nb = item % nblk, k0 = kb * 64, n0 = nb * 64;
    { const int nn = tid & 63, n = n0 + nn;
#pragma unroll
      for (int i = 0; i < 8; ++i) { const int kk = (tid >> 6) + 8 * i; scr[kk * 65 + nn] = (n < N) ? src[(size_t)(k0 + kk) * lds_ + n] : 0.f; } }
    __syncthreads();
    { const int nn = tid >> 3, kc = (tid & 7) * 8, n = n0 + nn;
      if (n < N) {
          const LAS float* s = scr + kc * 65 + nn;
          u32x4 o; o.x = cvt_pk_bf16(s[0], s[65]); o.y = cvt_pk_bf16(s[2 * 65], s[3 * 65]); o.z = cvt_pk_bf16(s[4 * 65], s[5 * 65]); o.w = cvt_pk_bf16(s[6 * 65], s[7 * 65]);
          const int r = MODE == 1 ? map_win(n) : (MODE == 2 ? map_up(n) : n);
          bf16* d = dst + (size_t)r * ldd + k0 + kc;
          *(u32x4*)d = o;
          if (MODE == 3) { *(u32x4*)(d + 1024) = o; *(u32x4*)(d + 2048) = o; }
      } }
    __syncthreads();
}
__device__ __forceinline__ void convert_layer_weights(const Ctx a, int l, LAS float* scr) {
    unsigned char* W = a.ws() + WS_W;
    constexpr int N0 = 16 * 113, N1 = 3 * 8 * 16, N2 = 256, N3 = 16, N4 = 128, N5 = 64, N6 = 64 * 128, N7 = 64 * 64;
    constexpr int NIT = N0 + N1 + N2 + N3 + N4 + N5 + N6 + N7;
    for (int it = blockIdx.x; it < NIT; it += gridDim.x) {
        int r = it;
        if (r < N0) { cvt_tile<1>(a.in(I_WIN) + (size_t)l * 1024 * IN_TOTAL, IN_TOTAL, 1024, IN_TOTAL, (bf16*)(W + W_IN), 1024, r, scr); continue; } r -= N0;
        if (r < N1) { const int br = r / 128; cvt_tile<0>(a.in(I_WBR) + (size_t)(l * 3 + br) * 512 * 1024, 1024, 512, 1024, (bf16*)(W + W_BR) + (size_t)br * 1024 * 512, 512, r % 128, scr); continue; } r -= N1;
        if (r < N2) { cvt_tile<3>(a.in(I_WOUT) + (size_t)l * 1024 * 1024, 1024, 1024, 1024, (bf16*)(W + W_OUT), 3072, r, scr); continue; } r -= N2;
        if (r < N3) { const float* wr = a.in(I_WRT) + (size_t)l * 1024 * 64; bf16* o = (bf16*)(W + W_RT);
            for (int i = r * 4096 + otid(); i < (r + 1) * 4096; i += 512) { const int k = i >> 6, n = i & 63; const float v = wr[i]; const unsigned hi = f2bf(v); const unsigned lo = f2bf(v - bf2f(hi));
                o[(size_t)n * 2048 + k] = (bf16)hi; o[(size_t)n * 2048 + 1024 + k] = (bf16)hi; o[(size_t)(128 + n) * 2048 + k] = (bf16)lo; o[(size_t)(128 + n) * 2048 + 1024 + k] = (bf16)0; }
            continue; } r -= N3;
        if (r < N4) { cvt_tile<2>(a.in(I_WSU) + (size_t)l * 1024 * 512, 512, 1024, 512, (bf16*)(W + W_SU), 1024, r, scr); continue; } r -= N4;
        if (r < N5) { cvt_tile<0>(a.in(I_WSD) + (size_t)l * 256 * 1024, 1024, 256, 1024, (bf16*)(W + W_SD), 256, r, scr); continue; } r -= N5;
        if (r < N6) { const int e = r / 128; cvt_tile<2>(a.in(I_WUP) + (size_t)(l * 64 + e) * 1024 * 512, 512, 1024, 512, (bf16*)(W + W_UP) + (size_t)e * 512 * 1024, 1024, r % 128, scr); continue; } r -= N6;
        { const int e = r / 64; cvt_tile<0>(a.in(I_WDN) + (size_t)(l * 64 + e) * 256 * 1024, 1024, 256, 1024, (bf16*)(W + W_DN) + (size_t)e * 1024 * 256, 256, r % 64, scr); }
    }
}

__device__ __forceinline__ void phase_mod_rope(const Ctx a, LAS float* lds) {
    const int tid = otid();
    float* mod = (float*)(a.ws() + WS_MOD); float* cosT = (float*)(a.ws() + WS_ROPE); float* sinT = cosT + 4096 * 32;
    LAS float* S = lds; LAS float* RED = lds + 9 * 1024;
    for (int i = tid; i < 9 * 1024; i += 512) { const float v = i < 8192 ? a.in(I_C)[i] : a.in(I_CCTX)[i - 8192]; S[i] = siluf_(v); }
    __syncthreads();
    for (int un = blockIdx.x; un < 2 * 96; un += gridDim.x) {
        const int l = un / 96, cb = un % 96, kg = tid >> 6, j = tid & 63, col = cb * 64 + j;
        const float* w = a.in(I_WMOD) + (size_t)l * 1024 * 6144 + col;
        float acc[9];
#pragma unroll
        for (int r = 0; r < 9; ++r) acc[r] = 0.f;
        for (int k = kg * 128; k < kg * 128 + 128; ++k) { const float wv = w[(size_t)k * 6144];
#pragma unroll
            for (int r = 0; r < 9; ++r) acc[r] += S[r * 1024 + k] * wv; }
#pragma unroll
        for (int r = 0; r < 9; ++r) RED[(kg * 9 + r) * 64 + j] = acc[r];
        __syncthreads();
        for (int o = tid; o < 9 * 64; o += 512) { const int r = o >> 6, jj = o & 63; float s = a.in(I_BMOD)[l * 6144 + cb * 64 + jj];
#pragma unroll
            for (int g = 0; g < 8; ++g) s += RED[(g * 9 + r) * 64 + jj];
            mod[((size_t)l * 9 + r) * 6144 + cb * 64 + jj] = s; }
        __syncthreads();
    }
    for (int i = blockIdx.x * 512 + tid; i < 4096 * 32; i += gridDim.x * 512) {
        const int t = i >> 5, f = i & 31; const float pos = (float)(f < 16 ? (t >> 6) : (t & 63));
        const float inv = powf(10000.0f, -(float)(f & 15) / 16.0f); const float ang = pos * inv;
        cosT[i] = cosf(ang); sinT[i] = sinf(ang);
    }
}

__device__ __forceinline__ const float* xrow_in(const Ctx a, int l, int row) {
    if (l == 0) return row < NLAT ? a.in(I_X) + (size_t)row * 1024 : a.in(I_CTX) + (size_t)(row - NLAT) * 1024;
    return (const float*)(a.ws() + WS_X) + (size_t)row * 1024;
}
__device__ __forceinline__ void store_h_row(bf16* hrow, const f32x4 (&v)[4], const float* m0, const float* m1, int lane) {
#pragma unroll
    for (int j = 0; j < 4; ++j) { const int c = 4 * lane + 256 * j; const f32x4 s = *(const f32x4*)(m1 + c), t = *(const f32x4*)(m0 + c);
        u32x2 w; w.x = cvt_pk_bf16(v[j][0] * (1.f + s[0]) + t[0], v[j][1] * (1.f + s[1]) + t[1]); w.y = cvt_pk_bf16(v[j][2] * (1.f + s[2]) + t[2], v[j][3] * (1.f + s[3]) + t[3]);
        *(u32x2*)(hrow + c) = w; }
}
__device__ __forceinline__ void layer_norm_row(f32x4 (&v)[4], const float* g, const float* b, int lane) {
    float s = 0.f;
#pragma unroll
    for (int j = 0; j < 4; ++j) s += (v[j][0] + v[j][1]) + (v[j][2] + v[j][3]);
    const float mean = wave_sum(s) * (1.f / 1024.f); float q = 0.f;
#pragma unroll
    for (int j = 0; j < 4; ++j) { v[j] = v[j] - mean; q += (v[j][0] * v[j][0] + v[j][1] * v[j][1]) + (v[j][2] * v[j][2] + v[j][3] * v[j][3]); }
    const float rstd = __builtin_amdgcn_rsqf(wave_sum(q) * (1.f / 1024.f) + LN_EPS);
#pragma unroll
    for (int j = 0; j < 4; ++j) { const int c = 4 * lane + 256 * j; const f32x4 gg = *(const f32x4*)(g + c), bb = *(const f32x4*)(b + c); v[j] = v[j] * rstd * gg + bb; }
}
__device__ __forceinline__ void phase_modulate0(const Ctx a) {
    const int tid_ = otid(); const int lane = tid_ & 63, gw = blockIdx.x * 8 + (tid_ >> 6), NGW = gridDim.x * 8;
    const float* mod = (const float*)(a.ws() + WS_MOD); bf16* H = (bf16*)(a.ws() + WS_H);
    for (int row = gw; row < MTOK; row += NGW) {
        const float* xr = xrow_in(a, 0, row); const int mr = row < NLAT ? (row >> 12) : 8; const float* mm = mod + (size_t)mr * 6144;
        f32x4 v[4];
#pragma unroll
        for (int j = 0; j < 4; ++j) v[j] = *(const f32x4*)(xr + 4 * lane + 256 * j);
        store_h_row(H + (size_t)row * 1024, v, mm, mm + 1024, lane);
    }
}
__device__ __forceinline__ void phase_scan_prep(const Ctx a, int l) {
    const int tid = otid(), lane = tid & 63;
    const bf16* ZZ = (const bf16*)(a.ws() + WS_ZZ); bf16* XA = (bf16*)(a.ws() + WS_H); float* DT = (float*)(a.ws() + WS_LOGIT); float* ACS = DT + (size_t)MTOK * 16;
    const float* cw = a.in(I_SCW) + (size_t)l * 4 * 1024; const float* cb = a.in(I_SCB) + l * 1024;
    for (int it = blockIdx.x * 512 + tid; it < (MTOK / 4) * 128; it += gridDim.x * 512) {
        const int oc = it & 127, row0 = (it >> 7) * 4, c0 = oc * 8;
        int segbase, Ls; if (row0 < NLAT) { segbase = row0 & ~(SEQ - 1); Ls = SEQ; } else { segbase = NLAT + ((row0 - NLAT) & ~(CTXL - 1)); Ls = CTXL; }
        const int t0 = row0 - segbase;
        float w[4][8], acc[4][8];
#pragma unroll
        for (int j = 0; j < 4; ++j) { const f32x4 w0 = *(const f32x4*)(cw + j * 1024 + c0), w1 = *(const f32x4*)(cw + j * 1024 + c0 + 4);
            w[j][0] = w0[0]; w[j][1] = w0[1]; w[j][2] = w0[2]; w[j][3] = w0[3]; w[j][4] = w1[0]; w[j][5] = w1[1]; w[j][6] = w1[2]; w[j][7] = w1[3]; }
        { const f32x4 b0 = *(const f32x4*)(cb + c0), b1 = *(const f32x4*)(cb + c0 + 4);
#pragma unroll
          for (int o = 0; o < 4; ++o) { acc[o][0] = b0[0]; acc[o][1] = b0[1]; acc[o][2] = b0[2]; acc[o][3] = b0[3]; acc[o][4] = b1[0]; acc[o][5] = b1[1]; acc[o][6] = b1[2]; acc[o][7] = b1[3]; } }
#pragma unroll
        for (int jr = 0; jr < 7; ++jr) { const int t = t0 - 2 + jr;
            if (t >= 0 && t < Ls) { const u32x4 xv = *(const u32x4*)(ZZ + (size_t)(segbase + t) * ZLD + ZC_XBC + c0);
                float x[8]; x[0] = bflo(xv.x); x[1] = bfhi(xv.x); x[2] = bflo(xv.y); x[3] = bfhi(xv.y); x[4] = bflo(xv.z); x[5] = bfhi(xv.z); x[6] = bflo(xv.w); x[7] = bfhi(xv.w);
#pragma unroll
                for (int o = 0; o < 4; ++o) { const int j = jr - o; if (j >= 0 && j < 4) {
#pragma unroll
                    for (int e = 0; e < 8; ++e) acc[o][e] += x[e] * w[j][e]; } } } }
#pragma unroll
        for (int o = 0; o < 4; ++o) { u32x4 ov; ov.x = cvt_pk_bf16(siluf_(acc[o][0]), siluf_(acc[o][1])); ov.y = cvt_pk_bf16(siluf_(acc[o][2]), siluf_(acc[o][3])); ov.z = cvt_pk_bf16(siluf_(acc[o][4]), siluf_(acc[o][5])); ov.w = cvt_pk_bf16(siluf_(acc[o][6]), siluf_(acc[o][7]));
            *(u32x4*)(XA + (size_t)(row0 + o) * 1024 + c0) = ov; }
    }
    for (int blk = blockIdx.x * 8 + (tid >> 6); blk < MTOK / 64; blk += gridDim.x * 8) {
        const int row = blk * 64 + lane;
        const u32x4 r0 = *(const u32x4*)(ZZ + (size_t)row * ZLD + ZC_DT), r1 = *(const u32x4*)(ZZ + (size_t)row * ZLD + ZC_DT + 8);
        float raw[16];
        raw[0] = bflo(r0.x); raw[1] = bfhi(r0.x); raw[2] = bflo(r0.y); raw[3] = bfhi(r0.y); raw[4] = bflo(r0.z); raw[5] = bfhi(r0.z); raw[6] = bflo(r0.w); raw[7] = bfhi(r0.w);
        raw[8] = bflo(r1.x); raw[9] = bfhi(r1.x); raw[10] = bflo(r1.y); raw[11] = bfhi(r1.y); raw[12] = bflo(r1.z); raw[13] = bfhi(r1.z); raw[14] = bflo(r1.w); raw[15] = bfhi(r1.w);
        float dtv[16], acv[16];
#pragma unroll
        for (int c = 0; c < 16; ++c) {
            const float dt = softplusf_(raw[c] + a.in(I_SDTB)[l * 16 + c]); float v = dt * -__expf(a.in(I_SALOG)[l * 16 + c]);
            if (c < 8) {
#pragma unroll
                for (int off = 1; off < 64; off <<= 1) { const float t = __shfl_up(v, off); if (lane >= off) v += t; }
            } else {
#pragma unroll
                for (int off = 1; off < 64; off <<= 1) { const float t = __shfl_down(v, off); if (lane + off < 64) v += t; }
            }
            dtv[c] = dt; acv[c] = v;
        }
#pragma unroll
        for (int c4 = 0; c4 < 4; ++c4) { *(f32x4*)(DT + (size_t)row * 16 + c4 * 4) = (f32x4){dtv[c4 * 4], dtv[c4 * 4 + 1], dtv[c4 * 4 + 2], dtv[c4 * 4 + 3]};
            *(f32x4*)(ACS + (size_t)row * 16 + c4 * 4) = (f32x4){acv[c4 * 4], acv[c4 * 4 + 1], acv[c4 * 4 + 2], acv[c4 * 4 + 3]}; }
    }
}
__device__ __forceinline__ void phase_mixer_finalize(const Ctx a, int l, int nrows) {
    const int tid_ = otid(); const int lane = tid_ & 63, gw = blockIdx.x * 8 + (tid_ >> 6), NGW = gridDim.x * 8;
    bf16* ZZ = (bf16*)(a.ws() + WS_ZZ); const bf16* SCR = (const bf16*)(a.ws() + WS_ACT); const size_t SS_ = (size_t)MTOK * 512;
    const float* ng = a.in(I_SNG) + l * 512 + 8 * lane;
    const f32x4 g0 = *(const f32x4*)ng, g1 = *(const f32x4*)(ng + 4);
    for (int row = gw; row < nrows; row += NGW) {
        const size_t so = (size_t)row * 512 + 8 * lane;
        const u32x4 h0 = *(const u32x4*)(SCR + so), h1 = *(const u32x4*)(SCR + SS_ + so), y0 = *(const u32x4*)(SCR + 2 * SS_ + so), y1 = *(const u32x4*)(SCR + 3 * SS_ + so);
        bf16* zr = ZZ + (size_t)row * ZLD;
        const u32x4 lg = *(const u32x4*)(zr + ZC_LG + 8 * lane), zz = *(const u32x4*)(zr + ZC_Z + 8 * lane);
        float hb[8], t[8], lgv[8], zv[8];
        hb[0] = bflo(h0.x) + bflo(h1.x); hb[1] = bfhi(h0.x) + bfhi(h1.x); hb[2] = bflo(h0.y) + bflo(h1.y); hb[3] = bfhi(h0.y) + bfhi(h1.y);
        hb[4] = bflo(h0.z) + bflo(h1.z); hb[5] = bfhi(h0.z) + bfhi(h1.z); hb[6] = bflo(h0.w) + bflo(h1.w); hb[7] = bfhi(h0.w) + bfhi(h1.w);
        t[0] = bflo(y0.x) + bflo(y1.x); t[1] = bfhi(y0.x) + bfhi(y1.x); t[2] = bflo(y0.y) + bflo(y1.y); t[3] = bfhi(y0.y) + bfhi(y1.y);
        t[4] = bflo(y0.z) + bflo(y1.z); t[5] = bfhi(y0.z) + bfhi(y1.z); t[6] = bflo(y0.w) + bflo(y1.w); t[7] = bfhi(y0.w) + bfhi(y1.w);
        lgv[0] = bflo(lg.x); lgv[1] = bfhi(lg.x); lgv[2] = bflo(lg.y); lgv[3] = bfhi(lg.y); lgv[4] = bflo(lg.z); lgv[5] = bfhi(lg.z); lgv[6] = bflo(lg.w); lgv[7] = bfhi(lg.w);
        zv[0] = bflo(zz.x); zv[1] = bfhi(zz.x); zv[2] = bflo(zz.y); zv[3] = bfhi(zz.y); zv[4] = bflo(zz.z); zv[5] = bfhi(zz.z); zv[6] = bflo(zz.w); zv[7] = bfhi(zz.w);
        float ss = 0.f;
#pragma unroll
        for (int e = 0; e < 8; ++e) { hb[e] *= gelu_tanh(lgv[e]); t[e] *= siluf_(zv[e]); ss += t[e] * t[e]; }
#pragma unroll
        for (int off = 1; off < 32; off <<= 1) ss += __shfl_xor(ss, off);
        const float ri = __builtin_amdgcn_rsqf(ss * (1.f / 256.f) + RMS_EPS);
        u32x4 wb, wc;
        wb.x = cvt_pk_bf16(hb[0], hb[1]); wb.y = cvt_pk_bf16(hb[2], hb[3]); wb.z = cvt_pk_bf16(hb[4], hb[5]); wb.w = cvt_pk_bf16(hb[6], hb[7]);
        wc.x = cvt_pk_bf16(t[0] * ri * g0[0], t[1] * ri * g0[1]); wc.y = cvt_pk_bf16(t[2] * ri * g0[2], t[3] * ri * g0[3]);
        wc.z = cvt_pk_bf16(t[4] * ri * g1[0], t[5] * ri * g1[1]); wc.w = cvt_pk_bf16(t[6] * ri * g1[2], t[7] * ri * g1[3]);
        *(u32x4*)(zr + ZC_LG + 8 * lane) = wb; *(u32x4*)(zr + ZC_Z + 8 * lane) = wc;
    }
}
__device__ __forceinline__ void phase_ln1(const Ctx a, int l, int nrows) {
    const int tid_ = otid(); const int lane = tid_ & 63, gw = blockIdx.x * 8 + (tid_ >> 6), NGW = gridDim.x * 8;
    const float* mod = (const float*)(a.ws() + WS_MOD) + (size_t)l * 9 * 6144; bf16* H = (bf16*)(a.ws() + WS_H); float* X = (float*)(a.ws() + WS_X); const bf16* ZZ = (const bf16*)(a.ws() + WS_ZZ);
    const float* g = a.in(I_LN1G) + l * 1024; const float* b = a.in(I_LN1B) + l * 1024;
    for (int row = gw; row < nrows; row += NGW) {
        const float* xr = xrow_in(a, l, row); const int mr = row < NLAT ? (row >> 12) : 8; const float* mm = mod + (size_t)mr * 6144;
        const bf16* mx = ZZ + (size_t)row * ZLD + ZC_MIX;
        f32x4 v[4];
#pragma unroll
        for (int j = 0; j < 4; ++j) { const int c = 4 * lane + 256 * j; const f32x4 xv = *(const f32x4*)(xr + c), gt = *(const f32x4*)(mm + 2 * 1024 + c); const u32x2 mw = *(const u32x2*)(mx + c);
            v[j][0] = DN_ALPHA * xv[0] + gt[0] * bflo(mw.x); v[j][1] = DN_ALPHA * xv[1] + gt[1] * bfhi(mw.x); v[j][2] = DN_ALPHA * xv[2] + gt[2] * bflo(mw.y); v[j][3] = DN_ALPHA * xv[3] + gt[3] * bfhi(mw.y); }
        layer_norm_row(v, g, b, lane);
        float* xo = X + (size_t)row * 1024;
#pragma unroll
        for (int j = 0; j < 4; ++j) *(f32x4*)(xo + 4 * lane + 256 * j) = v[j];
        { bf16* hrow = (bf16*)(a.ws() + WS_ZZ) + (size_t)row * ZLD + ZC_H2; const float* m3 = mm + 3 * 1024; const float* m4 = mm + 4 * 1024;
#pragma unroll
          for (int j = 0; j < 4; ++j) { const int c = 4 * lane + 256 * j; const f32x4 sc = *(const f32x4*)(m4 + c), sh = *(const f32x4*)(m3 + c);
              float hv[4]; unsigned hh[4], hl[4];
#pragma unroll
              for (int e = 0; e < 4; ++e) { hv[e] = v[j][e] * (1.f + sc[e]) + sh[e]; hh[e] = f2bf(hv[e]); hl[e] = f2bf(hv[e] - bf2f(hh[e])); }
              u32x2 w; w.x = hh[0] | (hh[1] << 16); w.y = hh[2] | (hh[3] << 16); *(u32x2*)(hrow + c) = w;
              u32x2 wl; wl.x = hl[0] | (hl[1] << 16); wl.y = hl[2] | (hl[3] << 16); *(u32x2*)(hrow + 1024 + c) = wl; } }
    }
}
__device__ __forceinline__ void phase_ln2(const Ctx a, int l, int nrows) {
    const int tid_ = otid(); const int lane = tid_ & 63, gw = blockIdx.x * 8 + (tid_ >> 6), NGW = gridDim.x * 8;
    const float* mod = (const float*)(a.ws() + WS_MOD) + (size_t)l * 9 * 6144; const float* modn = (const float*)(a.ws() + WS_MOD) + (size_t)(l + 1) * 9 * 6144;
    bf16* H = (bf16*)(a.ws() + WS_ACT); float* X = (float*)(a.ws() + WS_X); const bf16* YE = (const bf16*)(a.ws() + WS_YE); const int* tslot = (const int*)(a.ws() + WS_TSLOT);
    const float* g = a.in(I_LN2G) + l * 1024; const float* b = a.in(I_LN2B) + l * 1024;
    const bool last = (l == DEPTH - 1);
    for (int row = gw; row < nrows; row += NGW) {
        const int mr = row < NLAT ? (row >> 12) : 8; const float* mm = mod + (size_t)mr * 6144;
        float* xo = X + (size_t)row * 1024;
        f32x4 f[4];
#pragma unroll
        for (int j = 0; j < 4; ++j) f[j] = (f32x4){0.f, 0.f, 0.f, 0.f};
#pragma unroll
        for (int k = 0; k < 8; ++k) { const int slot = tslot[row * 8 + k]; const bf16* yr = YE + (size_t)slot * 1024;
#pragma unroll
            for (int j = 0; j < 4; ++j) { const u32x2 w = *(const u32x2*)(yr + 4 * lane + 256 * j); f[j][0] += bflo(w.x); f[j][1] += bfhi(w.x); f[j][2] += bflo(w.y); f[j][3] += bfhi(w.y); } }
        f32x4 v[4];
#pragma unroll
        for (int j = 0; j < 4; ++j) { const int c = 4 * lane + 256 * j; v[j] = *(const f32x4*)(xo + c) + *(const f32x4*)(mm + 5 * 1024 + c) * f[j]; }
        layer_norm_row(v, g, b, lane);
        if (last) { float* o = a.out() + (size_t)row * 1024;
#pragma unroll
            for (int j = 0; j < 4; ++j) *(f32x4*)(o + 4 * lane + 256 * j) = v[j];
        } else {
#pragma unroll
            for (int j = 0; j < 4; ++j) *(f32x4*)(xo + 4 * lane + 256 * j) = v[j];
            const float* mn = modn + (size_t)mr * 6144;
            store_h_row(H + (size_t)row * 1024, v, mn, mn + 1024, lane);
        }
    }
}

__device__ __forceinline__ void phase_route_a(const Ctx a, int l, int ntok, LAS unsigned* hist) {
    const int tid = otid(), lane = tid & 63, wid = tid >> 6;
    const float* L = (const float*)(a.ws() + WS_LOGIT); int* selE = (int*)(a.ws() + WS_SELE); float* selW = (float*)(a.ws() + WS_SELW); int* selR = (int*)(a.ws() + WS_SELR); int* wgh = (int*)(a.ws() + WS_WGHIST);
    if (tid < 64) hist[tid] = 0u;
    __syncthreads();
    const float bias = a.in(I_RBIAS)[l * 64 + lane];
    const int tpw = (ntok + gridDim.x - 1) / gridDim.x; const int t0 = blockIdx.x * tpw, t1 = min(ntok, t0 + tpw);
    for (int row = t0 + wid; row < t1; row += 8) {
        const float s = sigmoidf_(L[(size_t)row * 64 + lane]); const float sel = s + bias;
        float m1 = sel;
        m1 = fmaxf(m1, __shfl_xor(m1, 1)); m1 = fmaxf(m1, __shfl_xor(m1, 2)); m1 = fmaxf(m1, __shfl_xor(m1, 4));
        const unsigned long long bm = __ballot(sel == m1); const unsigned gbits = (unsigned)((bm >> (lane & ~7)) & 0xffull);
        const int first = (lane & ~7) + (__ffs(gbits) - 1);
        float m2 = (lane == first) ? -INFINITY : sel;
        m2 = fmaxf(m2, __shfl_xor(m2, 1)); m2 = fmaxf(m2, __shfl_xor(m2, 2)); m2 = fmaxf(m2, __shfl_xor(m2, 4));
        const float gs = m1 + m2; const int myg = lane >> 3;
        int grank = 0;
#pragma unroll
        for (int gq = 0; gq < 8; ++gq) { const float o = __builtin_bit_cast(float, __builtin_amdgcn_readlane(__builtin_bit_cast(int, gs), gq * 8)); grank += (o > gs || (o == gs && gq < myg)) ? 1 : 0; }
        const float sel2 = grank < 4 ? sel : -INFINITY;
        int erank = 0;
#pragma unroll 4
        for (int e = 0; e < 64; ++e) { const float o = __builtin_bit_cast(float, __builtin_amdgcn_readlane(__builtin_bit_cast(int, sel2), e)); erank += (o > sel2 || (o == sel2 && e < lane)) ? 1 : 0; }
        const bool chosen = (erank < 8) && (grank < 4);
        const unsigned long long cm = __ballot(chosen);
        const float wsum = wave_sum(chosen ? s : 0.f);
        if (chosen) {
            const int kidx = __popcll(cm & ((1ull << lane) - 1ull));
            const unsigned rk = __hip_atomic_fetch_add(&hist[lane], 1u, __ATOMIC_RELAXED, __HIP_MEMORY_SCOPE_WORKGROUP);
            selE[row * 8 + kidx] = lane; selW[row * 8 + kidx] = s / wsum * 2.5f; selR[row * 8 + kidx] = (int)rk;
        }
    }
    __syncthreads();
    if (tid < 64) wgh[blockIdx.x * 64 + tid] = (int)hist[tid];
}
__device__ __forceinline__ void phase_route_b(const Ctx a, int ntok, LAS int* sm) {
    const int tid = otid(), lane = tid & 63, wid = tid >> 6;
    const int* selE = (const int*)(a.ws() + WS_SELE); const float* selW = (const float*)(a.ws() + WS_SELW); const int* selR = (const int*)(a.ws() + WS_SELR); const int* wgh = (const int*)(a.ws() + WS_WGHIST);
    int* tslot = (int*)(a.ws() + WS_TSLOT); int* rowtok = (int*)(a.ws() + WS_ROWTOK); float* roww = (float*)(a.ws() + WS_ROWW); int* tileE = (int*)(a.ws() + WS_TILEE); int* ntiles = (int*)(a.ws() + WS_NTILES);
    LAS int* OFF = sm; LAS int* CNT = sm + 64; LAS int* PST = sm + 128; LAS int* PEN = sm + 192;
    if (wid == 0) {
        int cnt = 0, base = 0;
        for (int w = 0; w < (int)gridDim.x; ++w) { const int v = wgh[w * 64 + lane]; cnt += v; if (w < (int)blockIdx.x) base += v; }
        const int padded = (cnt + 255) & ~255; int inc = padded;
#pragma unroll
        for (int off = 1; off < 64; off <<= 1) { const int t = __shfl_up(inc, off); if (lane >= off) inc += t; }
        OFF[lane] = inc - padded + base; CNT[lane] = cnt; PST[lane] = inc - padded; PEN[lane] = inc;
    }
    __syncthreads();
    const int tpw = (ntok + gridDim.x - 1) / gridDim.x; const int t0 = blockIdx.x * tpw, t1 = min(ntok, t0 + tpw);
    for (int i = t0 * 8 + tid; i < t1 * 8; i += 512) { const int e = selE[i]; const int slot = OFF[e] + selR[i]; tslot[i] = slot; rowtok[slot] = i >> 3; roww[slot] = selW[i]; }
    for (int e = blockIdx.x; e < 64; e += gridDim.x) {
        const int ps = PST[e], pe = PEN[e], cn = CNT[e];
        for (int i = ps + cn + tid; i < pe; i += 512) { rowtok[i] = 0; roww[i] = 0.f; }
        for (int t = (ps >> 8) + tid; t < (pe >> 8); t += 512) tileE[t] = e;
    }
    if (blockIdx.x == 0 && tid == 0) *ntiles = PEN[63] >> 8;
}

#ifndef MK_PER_PHASE
#define MK_PER_PHASE 0
#endif
constexpr int NPHASE = 2 + 13 * DEPTH;

__global__ void __launch_bounds__(512, 2) mega_fwd(Args ka) {
    LAS unsigned char* lds = (LAS unsigned char*)lds_raw;
    volatile LAS unsigned* MISC = (volatile LAS unsigned*)(lds + MISC_OFF);
    { const int t0_ = threadIdx.x; const unsigned key_ = (unsigned)__builtin_amdgcn_s_getreg(((6 - 1) << 11) | 4) & 63u;
      if ((t0_ & 63) == 0) *(volatile LAS unsigned*)(lds + WVTAB_OFF + key_ * 4) = (unsigned)(t0_ >> 6);
      if (t0_ < 74) ((LAS unsigned*)(lds + CTX_OFF))[t0_] = ((const unsigned*)&ka)[t0_];
      if (t0_ < 32) ((volatile LAS unsigned*)(lds + MISC_OFF))[t0_] = 0u; }
    __syncthreads();
    const int G = gridDim.x;
    unsigned* ctl = (unsigned*)(ka.ws + WS_CTL);
    const Ctx a;
    const int lo = ka.ph_lo, hi = ka.ph_hi;
    XcdBarrier bar; bar.bar = ctl + CW_BAR; bar.x = 0; bar.st = nullptr;
    if (hi - lo > 1) bar = xcd_barrier_post(ctl + CW_BAR, MISC + 8);
#ifndef MK_ONLY
#define MK_ONLY -1
#endif
#define SELP(k) ((MK_ONLY) < 0 || (MK_ONLY) == (k))
#ifndef MK_DUP
#define MK_DUP -1
#endif
#define REP(k) for (int rep_ = 0; rep_ < ((MK_DUP) == (k) ? 2 : 1); ++rep_)
#define IN(k) (lo <= (k) && (k) < hi)
#define SEAM(k) do { if (IN(k) && IN((k) + 1)) xcd_barrier(bar); } while (0)
#define WSP (a.ws())
#define ZZP ((bf16*)(a.ws() + WS_ZZ))
#define HP ((bf16*)(a.ws() + WS_H))
#define XP ((float*)(a.ws() + WS_X))
#define WP (a.ws() + WS_W)

    if (SELP(0) && IN(0)) { phase_mod_rope(a, (LAS float*)lds); }
    SEAM(0);
    if (SELP(1) && IN(1)) { REP(1) convert_layer_weights(a, 0, (LAS float*)lds); REP(100) phase_modulate0(a); }
    SEAM(1);

    for (int l = 0; l < DEPTH; ++l) {
        const int pb = 2 + 13 * l;
        const bool last = (l == DEPTH - 1);
        const int nrows = last ? NLAT : MTOK;
        const int ntile = nrows / 256;
        const float* modl = (const float*)(WSP + WS_MOD) + (size_t)l * 9 * 6144;

        if (SELP(2) && IN(pb + 0)) REP(2) {
            const bf16* Hin = (l == 0) ? HP : (const bf16*)(WSP + WS_ACT);
            GeoPlain g{Hin, (const bf16*)(WP + W_IN), 1024, 1024, 1024};
            pg8::StaticOrder S; S.init(MTOK / 256, ZLD / 256, G, (int)blockIdx.x);
            EpiInProj E{ZZP, (const float*)(WSP + WS_ROPE), (const float*)(WSP + WS_ROPE) + 4096 * 32};
            pg8::gemm_phase(lds, g, S, E);
        }
        SEAM(pb + 0);

        if (SELP(14) && IN(pb + 1)) { phase_scan_prep(a, l); }
        SEAM(pb + 1);

        if (SELP(3) && IN(pb + 2)) {
            unsigned* qhead = ctl + CW_QUEUE + 64 * l;
            const int nunits = 256 + 1024 + (last ? 0 : 64);
            const float lam_init = 0.8f - 0.6f * __expf(-0.3f * (float)l);
            bf16* SCR = (bf16*)(WSP + WS_ACT);
#ifndef MK_UNIT
#define MK_UNIT 7
#endif
#define NEXT_UNIT() do { __syncthreads(); if (otid() == 0) MISC[0] = atomicAdd(qhead, 1u); __syncthreads(); uid = (int)MISC[0]; } while (0)
            int uid; NEXT_UNIT();
            while ((MK_UNIT & 1) && uid < 128) {
                const int b = uid >> 4, h = (uid >> 1) & 7, d = uid & 1;
                ssd::Par P; P.XA = (const bf16*)(WSP + WS_H); P.DT = (const float*)(WSP + WS_LOGIT); P.ACS = (const float*)(WSP + WS_LOGIT) + (size_t)MTOK * 16; P.Y = SCR + (size_t)(2 + d) * MTOK * 512;
                P.Dskip = a.in(I_SD)[l * 8 + h]; P.b = b; P.h = h; P.d = d;
                REP(30) ssd::unit(P);
                NEXT_UNIT();
            }
            while ((MK_UNIT & 2) && uid < 256) {
                const int u = uid - 128; const int b = u >> 4, n = (u >> 1) & 7, d = u & 1;
                lru::Par P; P.ZZ = ZZP; P.Hout = SCR + (size_t)d * MTOK * 512; P.conv_w = a.in(I_LCW) + (size_t)l * 4 * 512; P.conv_b = a.in(I_LCB) + l * 512;
                P.wa = a.in(I_LWA) + (size_t)((l * 2 + d) * 8 + n) * 4096; P.wi = a.in(I_LWI) + (size_t)((l * 2 + d) * 8 + n) * 4096;
                P.ba = a.in(I_LBA) + (l * 2 + d) * 512; P.bi = a.in(I_LBI) + (l * 2 + d) * 512; P.lam = a.in(I_LLAM) + (l * 2 + d) * 512; P.b = b; P.n = n; P.d = d;
                REP(31) lru::unit(P);
                NEXT_UNIT();
            }
            if (MK_UNIT & 4) {
                float d0 = 0.f, d1 = 0.f;
                for (int i = 0; i < 64; ++i) { d0 += a.in(I_LAMQ)[(l * 2 + 0) * 64 + i] * a.in(I_LAMK)[(l * 2 + 0) * 64 + i]; d1 += a.in(I_LAMQ)[(l * 2 + 1) * 64 + i] * a.in(I_LAMK)[(l * 2 + 1) * 64 + i]; }
                const float lam = __expf(d0) - __expf(d1) + lam_init;
                while (uid < nunits) {
                    int qrow0, h, krowA, ntA, krowB, NT;
                    if (uid < 1280) { const int u = uid - 256; const int b = u >> 7; h = (u >> 5) & 3; const int qb = u & 31; qrow0 = b * SEQ + qb * 128; krowA = b * SEQ; ntA = 64; krowB = NLAT + b * CTXL; NT = 68; }
                    else { const int u = uid - 1280; const int b = u >> 3; h = (u >> 1) & 3; const int cq = u & 1; qrow0 = NLAT + b * CTXL + cq * 128; krowA = NLAT + b * CTXL; ntA = 4; krowB = krowA; NT = 4; }
                    att::attn_unit(ZZP, qrow0, h, krowA, ntA, krowB, NT, lam, a.in(I_ATTNG) + (size_t)(l * 4 + h) * 128, 1.0f - lam_init);
                    NEXT_UNIT();
                }
            }
#undef NEXT_UNIT
        }
        SEAM(pb + 2);

        if (SELP(4) && IN(pb + 3)) { phase_mixer_finalize(a, l, nrows); }
        SEAM(pb + 3);

        if (SELP(5) && IN(pb + 4)) {
            GeoMergeA g{ZZP, (const bf16*)(WP + W_BR), 512, ZLD, 512};
            pg8::StaticOrder S; S.init(ntile, 12, G, (int)blockIdx.x);
            EpiMergeA E{ZZP};
            pg8::gemm_phase(lds, g, S, E);
        }
        SEAM(pb + 4);

        if (SELP(6) && IN(pb + 5)) REP(6) {
            GeoPlain g{ZZP + ZC_GATE, (const bf16*)(WP + W_OUT), 3072, ZLD, 3072};
            pg8::StaticOrder S; S.init(ntile, 4, G, (int)blockIdx.x);
            EpiBf16Plain E{ZZP + ZC_MIX, ZLD};
            pg8::gemm_phase(lds, g, S, E);
        }
        SEAM(pb + 5);

        if (SELP(7) && IN(pb + 6)) { phase_ln1(a, l, nrows); }
        SEAM(pb + 6);

        if (SELP(8) && IN(pb + 7)) {
            REP(80) { GeoPlain g{ZZP + ZC_H2, (const bf16*)(WP + W_SU), 1024, ZLD, 1024};
              pg8::StaticOrder S; S.init(ntile, 2, G, (int)blockIdx.x);
              EpiSwiGLU<false> E{(bf16*)(WSP + WS_ACTS), nullptr};
              pg8::gemm_phase(lds, g, S, E); }
            REP(81) { GeoPlain g{ZZP + ZC_H2, (const bf16*)(WP + W_RT), 2048, ZLD, 2048};
              pg8::StaticOrder S; S.init(ntile, 1, G, (int)((blockIdx.x + 128) % G));
              EpiRouter E{(float*)(WSP + WS_LOGIT)};
              pg8::gemm_phase(lds, g, S, E); }
        }
        SEAM(pb + 7);

        if (SELP(9) && IN(pb + 8)) { phase_route_a(a, l, nrows, (LAS unsigned*)lds); }
        SEAM(pb + 8);
        if (SELP(10) && IN(pb + 9)) { phase_route_b(a, nrows, (LAS int*)lds); }
        SEAM(pb + 9);

        if (SELP(11) && IN(pb + 10)) REP(11) {
            const int nt_ = __builtin_amdgcn_readfirstlane(*(const int*)(WSP + WS_NTILES));
            GeoMoeUp g{ZZP + ZC_H2, (const bf16*)(WP + W_UP), (const int*)(WSP + WS_ROWTOK), (const int*)(WSP + WS_TILEE), 1024, ZLD, 1024};
            pg8::StaticOrder S; S.init(nt_, 2, G, (int)blockIdx.x);
            EpiSwiGLU<true> E{(bf16*)(WSP + WS_ACT), (const float*)(WSP + WS_ROWW)};
            pg8::gemm_phase(lds, g, S, E);
        }
        SEAM(pb + 10);

        if (SELP(12) && IN(pb + 11)) {
            REP(12) { const int nt_ = __builtin_amdgcn_readfirstlane(*(const int*)(WSP + WS_NTILES));
              GeoMoeDown g{(const bf16*)(WSP + WS_ACT), (const bf16*)(WP + W_DN), (const int*)(WSP + WS_TILEE), 256, 256, 256};
              pg8::StaticOrder S; S.init(nt_, 4, G, (int)blockIdx.x);
              EpiBf16Plain E{(bf16*)(WSP + WS_YE), 1024};
              pg8::gemm_phase(lds, g, S, E); }
            { GeoPlain g{(const bf16*)(WSP + WS_ACTS), (const bf16*)(WP + W_SD), 256, 256, 256};
              pg8::StaticOrder S; S.init(ntile, 4, G, (int)blockIdx.x);
              EpiSharedDown E{XP, modl};
              pg8::gemm_phase(lds, g, S, E); }
        }
        SEAM(pb + 11);

        if (SELP(13) && IN(pb + 12)) {
            phase_ln2(a, l, nrows);
            if (!last) { __syncthreads(); convert_layer_weights(a, l + 1, (LAS float*)lds); }
        }
        SEAM(pb + 12);
    }
#undef IN
#undef SEAM
#undef WSP
#undef ZZP
#undef HP
#undef XP
#undef WP
}

extern "C" void kernel_launch(void* const* d_in, const int* in_sizes, int n_in, void* d_out, int out_size, void* d_ws, size_t ws_size, hipStream_t stream) {
    static int grid = 0;
    if (grid == 0) {
        if (n_in != 35 || in_sizes[0] != NLAT * DM || out_size != NLAT * DM || ws_size < WS_END) {
            fprintf(stderr, "kernel_launch: shape/workspace mismatch: n_in %d in0 %d out %d ws %zu (need %zu)\n", n_in, n_in > 0 ? in_sizes[0] : -1, out_size, ws_size, (size_t)WS_END); grid = -1; return; }
        int dev = 0, cus = 0, per_cu = 0;
        if (hipGetDevice(&dev) != hipSuccess || hipDeviceGetAttribute(&cus, hipDeviceAttributeMultiprocessorCount, dev) != hipSuccess) { fprintf(stderr, "kernel_launch: device query failed\n"); grid = -1; return; }
        if (hipFuncSetAttribute((const void*)mega_fwd, hipFuncAttributeMaxDynamicSharedMemorySize, LDS_BYTES) != hipSuccess) { fprintf(stderr, "kernel_launch: hipFuncSetAttribute failed\n"); grid = -1; return; }
        if (hipOccupancyMaxActiveBlocksPerMultiprocessor(&per_cu, (const void*)mega_fwd, 512, LDS_BYTES) != hipSuccess || per_cu < 1) fprintf(stderr, "kernel_launch: occupancy query reports %d\n", per_cu);
        (void)hipGetLastError();
        grid = cus;
    }
    if (grid < 0) return;
    if (hipMemsetAsync((char*)d_ws + WS_CTL, 0, CTL_ZERO_BYTES, stream) != hipSuccess) { fprintf(stderr, "kernel_launch: memset failed\n"); return; }
    Args a{};
    for (int i = 0; i < 35; ++i) a.in[i] = (const float*)d_in[i];
    a.out = (float*)d_out; a.ws = (unsigned char*)d_ws;
#if MK_PER_PHASE
    for (int p = 0; p < NPHASE; ++p) { a.ph_lo = p; a.ph_hi = p + 1; hipLaunchKernelGGL(mega_fwd, dim3(grid), dim3(512), LDS_BYTES, stream, a); }
#else
    a.ph_lo = 0; a.ph_hi = NPHASE;
    hipLaunchKernelGGL(mega_fwd, dim3(grid), dim3(512), LDS_BYTES, stream, a);
#endif
    const hipError_t le = hipPeekAtLastError();
    if (le != hipSuccess) fprintf(stderr, "kernel_launch: launch failed: %s\n", hipGetErrorName(le));
}
```

```cpp
#include <hip/hip_runtime.h>
#include <cstdio>
#include <cstdint>

#define GAS __attribute__((address_space(1)))
#define LAS __attribute__((address_space(3)))
typedef unsigned short bf16;
typedef short bf16x8 __attribute__((ext_vector_type(8)));
typedef short s16x4 __attribute__((ext_vector_type(4)));
typedef float f32x2 __attribute__((ext_vector_type(2)));
typedef float f32x4 __attribute__((ext_vector_type(4)));
typedef float f32x16 __attribute__((ext_vector_type(16)));
typedef unsigned u32x2 __attribute__((ext_vector_type(2)));
typedef unsigned u32x4 __attribute__((ext_vector_type(4)));

constexpr int DM = 1024, NBATCH = 8, SEQ = 4096, CTXL = 256, DEPTH = 2;
constexpr int NLAT = NBATCH * SEQ, NCTX = NBATCH * CTXL, MTOK = NLAT + NCTX;
constexpr int IN_TOTAL = 7184, ZLD = 7424;
constexpr int ZC_Q = 0, ZC_K = 512, ZC_V = 1024, ZC_LX = 1536, ZC_LG = 2048, ZC_Z = 2560, ZC_XBC = 3072, ZC_GATE = 4096, ZC_DT = 7168;
constexpr int ZC_MRG = 512;
constexpr int ZC_MIX = 1536;
constexpr int NEXP = 64, TOPK = 8, EXPF = 256;
constexpr int PMAX_TILES = 1152, PMAX = PMAX_TILES * 256;
constexpr float DN_ALPHA = 1.41421356237309515f;
constexpr float LN_EPS = 1e-5f, RMS_EPS = 1e-6f;

constexpr size_t MiB = 1u << 20;
constexpr size_t WS_CTL = 0, CTL_ZERO_BYTES = 1 * MiB;
constexpr size_t WS_MOD = 1 * MiB;
constexpr size_t WS_ROPE = 2 * MiB;
constexpr size_t WS_LOGIT = 4 * MiB;
constexpr size_t WS_ACTS = 13 * MiB;
constexpr size_t WS_SELE = 30 * MiB;
constexpr size_t WS_SELW = 32 * MiB;
constexpr size_t WS_SELR = 34 * MiB;
constexpr size_t WS_TSLOT = 36 * MiB;
constexpr size_t WS_ROWTOK = 38 * MiB;
constexpr size_t WS_ROWW = 40 * MiB;
constexpr size_t WS_WGHIST = 42 * MiB;
constexpr size_t WS_TILEE = 42 * MiB + 65536;
constexpr size_t WS_NTILES = 42 * MiB + 131072;
constexpr size_t WS_W = 44 * MiB;
constexpr size_t W_IN = 0;
constexpr size_t W_BR = W_IN + (size_t)ZLD * 1024 * 2;
constexpr size_t W_OUT = W_BR + (size_t)3072 * 512 * 2;
constexpr size_t W_RT = W_OUT + (size_t)1024 * 1024 * 2;
constexpr size_t W_SU = W_RT + (size_t)256 * 2048 * 2;
constexpr size_t W_SD = W_SU + (size_t)512 * 1024 * 2;
constexpr size_t W_UP = W_SD + (size_t)1024 * 256 * 2;
constexpr size_t W_DN = W_UP + (size_t)64 * 512 * 1024 * 2;
constexpr size_t W_END = W_DN + (size_t)64 * 1024 * 256 * 2;
static_assert(W_END <= 122 * MiB, "weights");
constexpr int ZC_H2 = 4096;
constexpr size_t WS_X = 166 * MiB;
constexpr size_t WS_ACT = 302 * MiB;
constexpr size_t WS_H = 446 * MiB;
constexpr size_t WS_ZZ = 514 * MiB;
constexpr size_t WS_YE = WS_H;
constexpr size_t WS_END = 1022 * MiB;
static_assert(WS_X + (size_t)MTOK * 1024 * 4 <= WS_ACT && WS_ACT + (size_t)PMAX * 256 * 2 <= WS_H && WS_H + (size_t)MTOK * 1024 * 2 <= WS_ZZ, "ws map 1");
static_assert(WS_ZZ + (size_t)MTOK * ZLD * 2 <= WS_END && WS_YE + (size_t)PMAX * 1024 * 2 <= WS_END, "ws map 2");
constexpr size_t SCR_STRIDE = (size_t)MTOK * 512 * 2;
static_assert(4 * SCR_STRIDE <= (size_t)PMAX * 256 * 2, "scan scratch fits the act region");
constexpr int CW_BAR = 4096;
constexpr int CW_QUEUE = 16384;

constexpr int LDS_BYTES = 147456;
constexpr int MISC_OFF = 131072 + 320;

#define LDS_WAIT() asm volatile("s_waitcnt lgkmcnt(0)" ::: "memory")
#define VM_WAIT() asm volatile("s_waitcnt vmcnt(0)" ::: "memory")
__device__ __forceinline__ unsigned f2bf(float f) { unsigned u = __builtin_bit_cast(unsigned, f); return (u + 0x7fffu + ((u >> 16) & 1u)) >> 16; }
__device__ __forceinline__ float bf2f(unsigned h) { return __builtin_bit_cast(float, h << 16); }
__device__ __forceinline__ unsigned cvt_pk_bf16(float lo, float hi) { unsigned r; asm volatile("v_cvt_pk_bf16_f32 %0, %1, %2" : "=v"(r) : "v"(lo), "v"(hi)); return r; }
__device__ __forceinline__ float bflo(unsigned w) { return __builtin_bit_cast(float, w << 16); }
__device__ __forceinline__ float bfhi(unsigned w) { return __builtin_bit_cast(float, w & 0xffff0000u); }
__device__ __forceinline__ float fexp(float x) { return __builtin_amdgcn_exp2f(x * 1.4426950408889634f); }
__device__ __forceinline__ float sigmoidf_(float x) { return __builtin_amdgcn_rcpf(1.0f + fexp(-x)); }
__device__ __forceinline__ float siluf_(float x) { return x * sigmoidf_(x); }
__device__ __forceinline__ float softplusf_(float x) { const float e = fexp(-fabsf(x)); const float lp = e < 1e-3f ? e * (1.f - 0.5f * e + 0.33333333f * e * e) : __builtin_amdgcn_logf(1.f + e) * 0.6931471805599453f; return fmaxf(x, 0.f) + lp; }
__device__ __forceinline__ float gelu_tanh(float x) { const float u = 0.7978845608028654f * (x + 0.044715f * x * x * x); const float e = fexp(2.f * u); const float th = 1.f - 2.f * __builtin_amdgcn_rcpf(e + 1.f); return 0.5f * x * (1.f + th); }
__device__ __forceinline__ float wave_sum(float v) {
#pragma unroll
    for (int o = 1; o < 64; o <<= 1) v += __shfl_xor(v, o);
    return v;
}

template <class T> __device__ __forceinline__ T* uni(T* p) { const unsigned long long v = (unsigned long long)p; const unsigned lo = __builtin_amdgcn_readfirstlane((unsigned)v), hi = __builtin_amdgcn_readfirstlane((unsigned)(v >> 32)); return (T*)(((unsigned long long)hi << 32) | lo); }
__device__ __forceinline__ int uni(int v) { return __builtin_amdgcn_readfirstlane(v); }
__device__ __forceinline__ float uni(float v) { return __builtin_bit_cast(float, __builtin_amdgcn_readfirstlane(__builtin_bit_cast(int, v))); }
extern __shared__ __attribute__((aligned(16))) unsigned char lds_raw[];
constexpr int WVTAB_OFF = 131072 + 320 + 128 + 320;
__device__ __forceinline__ int otid() {
    const unsigned key = (unsigned)__builtin_amdgcn_s_getreg(((6 - 1) << 11) | 4) & 63u;
    int off_ = WVTAB_OFF + (int)key * 4; asm volatile("" : "+v"(off_));
    const unsigned wv = (unsigned)__builtin_amdgcn_readfirstlane((int)*(const volatile LAS unsigned*)((LAS unsigned char*)lds_raw + off_));
    unsigned z = 0u; asm volatile("" : "+v"(z));
    const unsigned ln = __builtin_amdgcn_mbcnt_hi(~0u, __builtin_amdgcn_mbcnt_lo(~0u, z));
    int t = (int)(wv * 64u + ln); asm volatile("" : "+v"(t)); return t;
}
__device__ __forceinline__ int osg(int v) { asm volatile("" : "+s"(v)); return v; }

#define XB_TMO      128
#define XB_XCNT(j)  (256  + 64 * (j))
#define XB_XSUB(j)  (1280 + 64 * (j))
#define XB_XGEN(j)  (2304 + 64 * (j))
#define XB_TOP      3328
#define XB_TOPGEN   3392
#define XCD_BAR_WORDS 3456
#define XB_SPIN_CAP (1u << 20)
__device__ __forceinline__ unsigned xb_ld(unsigned* p)              { return __hip_atomic_load(p, __ATOMIC_RELAXED, __HIP_MEMORY_SCOPE_AGENT); }
__device__ __forceinline__ unsigned xb_add(unsigned* p, unsigned v) { return __hip_atomic_fetch_add(p, v, __ATOMIC_RELAXED, __HIP_MEMORY_SCOPE_AGENT); }
__device__ __forceinline__ unsigned xb_xcc_id() { return (unsigned)__builtin_amdgcn_s_getreg((3 << 11) | 20) & 0xFu; }
#define XB_SPIN(cond, bar) do { unsigned _sp = 0; while (cond) { __builtin_amdgcn_s_sleep(1); \
    if ((++_sp & 255u) == 0u) { if (xb_ld(&(bar)[XB_TMO])) break; if (_sp > XB_SPIN_CAP) { atomicAdd(&(bar)[XB_TMO], 1u); break; } } } } while (0)
struct XcdBarrier { unsigned* bar; unsigned x; volatile LAS unsigned* st; };
__device__ __forceinline__ XcdBarrier xcd_barrier_post(unsigned* bar, volatile LAS unsigned* st) {
    XcdBarrier b; b.bar = bar; b.x = xb_xcc_id(); b.st = st;
    if (otid() == 0) (void)xb_add(&bar[XB_XCNT(b.x)], 1u);
    return b;
}
__device__ __forceinline__ void xcd_barrier_complete(unsigned* bar, unsigned x, unsigned& nloc, unsigned& nx) {
    const unsigned G = gridDim.x * gridDim.y * gridDim.z;
    unsigned sum, cnt, mine, sp = 0u;
    for (;;) {
        sum = 0u; cnt = 0u; mine = 0u;
#pragma unroll
        for (unsigned j = 0; j < 16; ++j) { const unsigned c = xb_ld(&bar[XB_XCNT(j)]); sum += c; cnt += (c > 0u) ? 1u : 0u; mine = (j == x) ? c : mine; }
        if (sum == G) break;
        __builtin_amdgcn_s_sleep(1);
        if ((++sp & 255u) == 0u) { if (xb_ld(&bar[XB_TMO])) break; if (sp > XB_SPIN_CAP) { atomicAdd(&bar[XB_TMO], 1u); break; } }
    }
    nloc = mine > 0u ? mine : 1u; nx = cnt > 0u ? cnt : 1u;
}
__device__ __forceinline__ void xcd_barrier(const XcdBarrier& b) {
    asm volatile("s_waitcnt vmcnt(0)" ::: "memory");
    __syncthreads();
    if (otid() == 0) {
        unsigned* bar = b.bar;
        __builtin_amdgcn_s_waitcnt(0);
        unsigned nloc = b.st[0], nx = b.st[1];
        if (nloc == 0u) { xcd_barrier_complete(bar, b.x, nloc, nx); b.st[0] = nloc; b.st[1] = nx; }
        const unsigned old = xb_add(&bar[XB_XSUB(b.x)], 1u);
        const unsigned gen = old / nloc;
        if (old + 1u == (gen + 1u) * nloc) {
            __builtin_amdgcn_fence(__ATOMIC_RELEASE, "agent");
            asm volatile("s_waitcnt vmcnt(0)" ::: "memory");
            const unsigned og = xb_add(&bar[XB_TOP], 1u);
            const unsigned tg = og / nx;
            if (og + 1u == (tg + 1u) * nx) xb_add(&bar[XB_TOPGEN], 1u);
            else XB_SPIN(xb_ld(&bar[XB_TOPGEN]) == tg, bar);
            __builtin_amdgcn_fence(__ATOMIC_ACQUIRE, "agent");
            xb_add(&bar[XB_XGEN(b.x)], 1u);
            asm volatile("s_waitcnt vmcnt(0)" ::: "memory");
        } else {
            XB_SPIN(xb_ld(&bar[XB_XGEN(b.x)]) == gen, bar);
            __builtin_amdgcn_fence(__ATOMIC_ACQUIRE, "agent");
            asm volatile("s_waitcnt vmcnt(0)" ::: "memory");
        }
    }
    __syncthreads();
}

namespace pg8 {
constexpr int BM = 256, BK = 64, HALF = 128, HTB = HALF * BK * 2, STAGE_BYTES = 8 * HTB, NXCD = 8, WGM = 8;
__host__ __device__ __forceinline__ int lds_byte(int r, int c) { const int st = (r >> 4) * 2 + (c >> 5), rr = r & 15, cc = c & 31, ob = rr * 64 + cc * 2; return st * 1024 + (ob ^ (((ob >> 9) & 1) << 5)); }
__host__ __device__ __forceinline__ void stage_rc(int b, int& R, int& C) { const int st = b / 1024, sb = b % 1024, swz = sb ^ (((sb >> 9) & 1) << 5); R = (st >> 1) * 16 + swz / 64; C = (st & 1) * 32 + (swz % 64) / 2; }
__host__ __device__ __forceinline__ int perm32(int rho) { const int n = rho >> 4, i = rho & 15; return 8 * (i >> 2) + 4 * n + (i & 3); }
struct Unit { int pm, pn; };
struct StaticOrder {
    int nM, nN, nwg, G, c;
    __device__ void init(int nM_, int nN_, int G_, int c_) { nM = nM_; nN = nN_; nwg = nM * nN; G = G_; c = c_; }
    __device__ bool next(int i, Unit& u) const {
        const long L = (long)i * G + c; if (L >= nwg) return false;
        int wgid = (int)L; { const int q = nwg / NXCD, r = nwg % NXCD, xcd = wgid % NXCD, off = wgid / NXCD; wgid = (xcd < r ? xcd * (q + 1) : r * (q + 1) + (xcd - r) * q) + off; }
        const int nig = WGM * nN, gid = wgid / nig, fm = gid * WGM, gsz = (nM - fm) < WGM ? (nM - fm) : WGM;
        u.pm = __builtin_amdgcn_readfirstlane(fm + ((wgid % nig) % gsz)); u.pn = __builtin_amdgcn_readfirstlane((wgid % nig) / gsz); return true;
    }
};
template <class Geo, class Epi, class Sched>
__device__ __forceinline__ void gemm_phase(LAS unsigned char* lds, const Geo& g, const Sched& S, const Epi& E) {
    const int tid = otid(), wid = __builtin_amdgcn_readfirstlane(tid >> 6), lane = tid & 63, wr = wid >> 2, wc = wid & 3, fr = lane & 15, fq = lane >> 4;
    const int K = g.K, nt = K / BK;
    int Rs[2], Cs[2];
    unsigned voffB[2], vC[2][2];
#pragma unroll
    for (int i = 0; i < 2; ++i) { stage_rc(tid * 16 + i * 8192, Rs[i], Cs[i]); const int Rb = Epi::PERM ? ((Rs[i] & ~31) + perm32(Rs[i] & 31)) : Rs[i];
        voffB[i] = (unsigned)(Rb * g.ldb + Cs[i]) * 2u; }
    const size_t kstep = (size_t)(BK * 2);
    const size_t hstepB = (size_t)HALF * g.ldb * 2;
    const unsigned ldsw = (unsigned)wid * 1024u;
    const int aoff = lds_byte(wr * 64 + fr, fq * 8), boff = lds_byte(wc * 32 + fr, fq * 8);
#define PG8_SA(b, h) (((b) * 2 + (h)) * HTB)
#define PG8_SB(b, h) ((4 + (b) * 2 + (h)) * HTB)
#define PG8_STAGE(bufoff, gbase, voff) do { _Pragma("unroll") for (int _i = 0; _i < 2; ++_i) \
        __builtin_amdgcn_global_load_lds((const unsigned*)((const char*)(gbase) + (voff)[_i]), (LAS unsigned*)(lds + (bufoff) + ldsw + _i * 8192), 16, 0, 0); } while (0)
#define PG8_LDA(dst, b, h) do { _Pragma("unroll") for (int m = 0; m < 4; ++m) _Pragma("unroll") for (int k = 0; k < 2; ++k) dst[m][k] = *(const LAS bf16x8*)(lds + PG8_SA(b, h) + aoff + m * 2048 + k * 1024); } while (0)
#define PG8_LDB(dst, b, h) do { _Pragma("unroll") for (int n = 0; n < 2; ++n) _Pragma("unroll") for (int k = 0; k < 2; ++k) dst[n][k] = *(const LAS bf16x8*)(lds + PG8_SB(b, h) + boff + n * 2048 + k * 1024); } while (0)
#define PG8_MMA(ai, bj, At, Bt) do { __builtin_amdgcn_s_setprio(1); _Pragma("unroll") for (int m = 0; m < 4; ++m) _Pragma("unroll") for (int n = 0; n < 2; ++n) _Pragma("unroll") for (int k = 0; k < 2; ++k) \
        acc[ai][bj][m][n] = __builtin_amdgcn_mfma_f32_16x16x32_bf16(Bt[n][k], At[m][k], acc[ai][bj][m][n], 0, 0, 0); __builtin_amdgcn_s_setprio(0); } while (0)
#define PG8_WAIT_V(n) asm volatile("s_waitcnt vmcnt(" #n ")" ::: "memory")
#define PG8_WAIT_L(n) asm volatile("s_waitcnt lgkmcnt(" #n ")" ::: "memory")
#define PG8_BAR __builtin_amdgcn_s_barrier()
#define PG8_SCHED __builtin_amdgcn_sched_barrier(0)
#define PG8_SETV(v, u) do { _Pragma("unroll") for (int _h = 0; _h < 2; ++_h) _Pragma("unroll") for (int _i = 0; _i < 2; ++_i) { \
        const unsigned _row = Geo::GATHER ? g.a_row((u), _h * HALF + Rs[_i]) : (unsigned)(_h * HALF + Rs[_i]); v[_h][_i] = (_row * (unsigned)g.lda + (unsigned)Cs[_i]) * 2u; } } while (0)
    Unit cur, nxt; int ui = 0;
    if (!S.next(0, cur)) return;
    f32x4 acc[2][2][4][2];
#pragma unroll
    for (int a = 0; a < 2; ++a)
#pragma unroll
        for (int b = 0; b < 2; ++b)
#pragma unroll
            for (int m = 0; m < 4; ++m)
#pragma unroll
                for (int n = 0; n < 2; ++n) acc[a][b][m][n] = (f32x4){0.f, 0.f, 0.f, 0.f};
    bf16x8 At[4][2], B0[2][2], B1[2][2];
    const char* cA = g.a_tile(cur); const char* cB = g.b_tile(cur);
    PG8_SETV(vC, cur);
    if (Geo::GATHER) { PG8_WAIT_V(0); }
    PG8_STAGE(PG8_SB(0, 0), cB, voffB); PG8_STAGE(PG8_SB(0, 1), cB + hstepB, voffB); PG8_STAGE(PG8_SA(0, 0), cA, vC[0]); PG8_STAGE(PG8_SA(0, 1), cA, vC[1]);
    if (wr == 1) PG8_BAR;
    PG8_WAIT_V(2); PG8_BAR;
    PG8_STAGE(PG8_SB(1, 0), cB + kstep, voffB); PG8_STAGE(PG8_SA(1, 0), cA + kstep, vC[0]); PG8_STAGE(PG8_SB(1, 1), cB + hstepB + kstep, voffB);
    PG8_WAIT_V(6); PG8_BAR;
    for (;;) {
        const bool has_next = S.next(ui + 1, nxt);
        const char* nA = has_next ? g.a_tile(nxt) : cA; const char* nB = has_next ? g.b_tile(nxt) : cB;
        for (int t = 0; t < nt; t += 2) {
            const bool last = (t == nt - 2);
            const char* a1 = cA + (size_t)(t + 1) * kstep;
            const char* a2 = last ? nA : cA + (size_t)(t + 2) * kstep; const char* b2 = last ? nB : cB + (size_t)(t + 2) * kstep;
            const char* a3 = a2 + kstep; const char* b3 = b2 + kstep;
            unsigned t1[2] = {0u, 0u};
            if (Geo::GATHER && last && has_next) {
#pragma unroll
                for (int _i = 0; _i < 2; ++_i) { vC[0][_i] = (g.a_row(nxt, Rs[_i]) * (unsigned)g.lda + (unsigned)Cs[_i]) * 2u; t1[_i] = (g.a_row(nxt, HALF + Rs[_i]) * (unsigned)g.lda + (unsigned)Cs[_i]) * 2u; }
            }
            PG8_LDB(B0, 0, 0); PG8_LDB(B1, 0, 1); PG8_SCHED; PG8_LDA(At, 0, 0); PG8_STAGE(PG8_SA(1, 1), a1, vC[1]);
            if (Geo::GATHER && last && has_next) { vC[1][0] = t1[0]; vC[1][1] = t1[1]; }
            PG8_WAIT_V(8); PG8_WAIT_L(0); PG8_BAR; PG8_MMA(0, 0, At, B0); PG8_MMA(0, 1, At, B1); PG8_BAR; PG8_SCHED;
            PG8_LDA(At, 0, 1); PG8_STAGE(PG8_SB(0, 0), b2, voffB); PG8_STAGE(PG8_SB(0, 1), b2 + hstepB, voffB); PG8_STAGE(PG8_SA(0, 0), a2, vC[0]);
            PG8_WAIT_V(8); PG8_WAIT_L(0); PG8_BAR; PG8_MMA(1, 0, At, B0); PG8_MMA(1, 1, At, B1); PG8_BAR; PG8_SCHED;
            PG8_LDB(B0, 1, 0); PG8_LDB(B1, 1, 1); PG8_SCHED; PG8_LDA(At, 1, 0); PG8_STAGE(PG8_SA(0, 1), a2, vC[1]);
            PG8_WAIT_V(8); PG8_WAIT_L(0); PG8_BAR; PG8_MMA(0, 0, At, B0); PG8_MMA(0, 1, At, B1); PG8_BAR; PG8_SCHED;
            PG8_LDA(At, 1, 1); PG8_STAGE(PG8_SB(1, 0), b3, voffB); PG8_STAGE(PG8_SB(1, 1), b3 + hstepB, voffB); PG8_STAGE(PG8_SA(1, 0), a3, vC[0]);
            PG8_WAIT_V(8); PG8_WAIT_L(0); PG8_BAR; PG8_MMA(1, 0, At, B0); PG8_MMA(1, 1, At, B1); PG8_BAR; PG8_SCHED;
        }
        if (wr == 0) PG8_BAR;
        E(acc, cur, wr, wc, fr, fq);
        if (!has_next) break;
        if (!E.keep(cur)) {
#pragma unroll
        for (int a = 0; a < 2; ++a)
#pragma unroll
            for (int b = 0; b < 2; ++b)
#pragma unroll
                for (int m = 0; m < 4; ++m)
#pragma unroll
                    for (int n = 0; n < 2; ++n) acc[a][b][m][n] = (f32x4){0.f, 0.f, 0.f, 0.f};
        }
        cur = nxt; cA = nA; cB = nB; ++ui;
        if (wr == 1) PG8_BAR;
    }
    PG8_WAIT_V(0);
    PG8_BAR;
#undef PG8_SA
#undef PG8_SB
#undef PG8_STAGE
#undef PG8_LDA
#undef PG8_LDB
#undef PG8_MMA
#undef PG8_WAIT_V
#undef PG8_WAIT_L
#undef PG8_BAR
#undef PG8_SCHED
#undef PG8_SETV
}
}

struct GeoPlain {
    static constexpr bool GATHER = false;
    const bf16* A; const bf16* Bt; int K, lda, ldb;
    __device__ __forceinline__ const char* a_tile(const pg8::Unit& u) const { return (const char*)(A + (size_t)u.pm * 256 * lda); }
    __device__ __forceinline__ const char* b_tile(const pg8::Unit& u) const { return (const char*)(Bt + (size_t)u.pn * 256 * ldb); }
    __device__ __forceinline__ unsigned a_row(const pg8::Unit&, int R) const { return (unsigned)R; }
};
struct GeoMergeA {
    static constexpr bool GATHER = false;
    const bf16* ZZ; const bf16* Bt; int K, lda, ldb;
    __device__ __forceinline__ const char* a_tile(const pg8::Unit& u) const { const int br = u.pn >> 2; const int co = br == 0 ? ZC_Q : (br == 1 ? ZC_LG : ZC_Z); return (const char*)(ZZ + (size_t)u.pm * 256 * ZLD + co); }
    __device__ __forceinline__ const char* b_tile(const pg8::Unit& u) const { return (const char*)(Bt + (size_t)u.pn * 256 * 512); }
    __device__ __forceinline__ unsigned a_row(const pg8::Unit&, int R) const { return (unsigned)R; }
};
struct GeoMoeUp {
    static constexpr bool GATHER = true;
    const bf16* A; const bf16* Bt; const int* row_tok; const int* tile_e; int K, lda, ldb;
    __device__ __forceinline__ const char* a_tile(const pg8::Unit&) const { return (const char*)A; }
    __device__ __forceinline__ const char* b_tile(const pg8::Unit& u) const { const int e = __builtin_amdgcn_readfirstlane(tile_e[u.pm]); return (const char*)(Bt + ((size_t)e * 512 + (size_t)u.pn * 256) * 1024); }
    __device__ __forceinline__ unsigned a_row(const pg8::Unit& u, int R) const { return (unsigned)row_tok[u.pm * 256 + R]; }
};
struct GeoMoeDown {
    static constexpr bool GATHER = false;
    const bf16* A; const bf16* Bt; const int* tile_e; int K, lda, ldb;
    __device__ __forceinline__ const char* a_tile(const pg8::Unit& u) const { return (const char*)(A + (size_t)u.pm * 256 * 256); }
    __device__ __forceinline__ const char* b_tile(const pg8::Unit& u) const { const int e = __builtin_amdgcn_readfirstlane(tile_e[u.pm]); return (const char*)(Bt + ((size_t)e * 1024 + (size_t)u.pn * 256) * 256); }
    __device__ __forceinline__ unsigned a_row(const pg8::Unit&, int R) const { return (unsigned)R; }
};

struct EpiInProj {
    static constexpr bool PERM = true;
    __device__ __forceinline__ bool keep(const pg8::Unit&) const { return false; }
    bf16* ZZ; const float* cosT; const float* sinT;
    __device__ __forceinline__ void operator()(const f32x4 (&acc)[2][2][4][2], const pg8::Unit& u, int wr, int wc, int fr, int fq) const {
        const int row0 = u.pm * 256 + wr * 64 + fr, colt = u.pn * 256 + wc * 32 + 8 * fq;
        const int kind = u.pn < 4 ? 0 : ((u.pn >= 16 && u.pn < 28) ? 2 : 1);
#pragma unroll
        for (int ai = 0; ai < 2; ++ai)
#pragma unroll
            for (int m = 0; m < 4; ++m) {
                const int row = row0 + ai * 128 + m * 16;
                bf16* rowp = ZZ + (size_t)row * ZLD + colt;
#pragma unroll
                for (int bj = 0; bj < 2; ++bj) {
                    f32x4 v0 = acc[ai][bj][m][0], v1 = acc[ai][bj][m][1];
                    if (kind == 0) {
                        if (row < NLAT) {
                            const int t = row & 4095, i0 = ((colt + bj * 128) & 63) >> 1;
                            const f32x4 c = *(const f32x4*)(cosT + t * 32 + i0), s = *(const f32x4*)(sinT + t * 32 + i0);
                            f32x4 a, b;
                            a[0] = v0[0] * c[0] - v0[1] * s[0]; a[1] = v0[1] * c[0] + v0[0] * s[0];
                            a[2] = v0[2] * c[1] - v0[3] * s[1]; a[3] = v0[3] * c[1] + v0[2] * s[1];
                            b[0] = v1[0] * c[2] - v1[1] * s[2]; b[1] = v1[1] * c[2] + v1[0] * s[2];
                            b[2] = v1[2] * c[3] - v1[3] * s[3]; b[3] = v1[3] * c[3] + v1[2] * s[3];
                            v0 = a; v1 = b;
                        }
                    } else if (kind == 2) {
#pragma unroll
                        for (int j = 0; j < 4; ++j) { v0[j] = sigmoidf_(v0[j]); v1[j] = sigmoidf_(v1[j]); }
                    }
                    u32x4 w; w.x = cvt_pk_bf16(v0[0], v0[1]); w.y = cvt_pk_bf16(v0[2], v0[3]); w.z = cvt_pk_bf16(v1[0], v1[1]); w.w = cvt_pk_bf16(v1[2], v1[3]);
                    *(u32x4*)(rowp + bj * 128) = w;
                }
                asm volatile("" ::: "memory");
            }
    }
};
struct EpiMergeDiv {
    static constexpr bool PERM = true;
    __device__ __forceinline__ bool keep(const pg8::Unit& u) const { return (u.pn >> 2) < 2; }
    bf16* ZZ; bool dry;
    __device__ __forceinline__ void operator()(f32x4 (&acc)[2][2][4][2], const pg8::Unit& u, int wr, int wc, int fr, int fq) const {
        const int n = u.pn >> 2, pn4 = u.pn & 3;
        const int row0 = u.pm * 256 + wr * 64 + fr, colg = ZC_GATE + n * 1024 + pn4 * 256 + wc * 32 + 8 * fq, colo = ZC_MRG + pn4 * 256 + wc * 32 + 8 * fq;
#pragma unroll
        for (int ai = 0; ai < 2; ++ai)
#pragma unroll
            for (int m = 0; m < 4; ++m) {
                bf16* rowp = ZZ + (size_t)(row0 + ai * 128 + m * 16) * ZLD;
#pragma unroll
                for (int bj = 0; bj < 2; ++bj) {
                    const u32x4 gq = *(const u32x4*)(rowp + colg + bj * 128);
                    f32x4 s0, s1;
                    s0[0] = bflo(gq.x); s0[1] = bfhi(gq.x); s0[2] = bflo(gq.y); s0[3] = bfhi(gq.y); s1[0] = bflo(gq.z); s1[1] = bfhi(gq.z); s1[2] = bflo(gq.w); s1[3] = bfhi(gq.w);
                    if (n < 2) {
                        const u32x4 hq = *(const u32x4*)(rowp + colg + 1024 + bj * 128);
                        f32x4 d0, d1;
                        d0[0] = bflo(hq.x); d0[1] = bfhi(hq.x); d0[2] = bflo(hq.y); d0[3] = bfhi(hq.y); d1[0] = bflo(hq.z); d1[1] = bfhi(hq.z); d1[2] = bflo(hq.w); d1[3] = bfhi(hq.w);
#pragma unroll
                        for (int j = 0; j < 4; ++j) { acc[ai][bj][m][0][j] *= s0[j] * __builtin_amdgcn_rcpf(fmaxf(d0[j], 1e-20f)); acc[ai][bj][m][1][j] *= s1[j] * __builtin_amdgcn_rcpf(fmaxf(d1[j], 1e-20f)); }
                    } else {
                        const f32x4 v0 = acc[ai][bj][m][0] * s0, v1 = acc[ai][bj][m][1] * s1;
                        u32x4 w; w.x = cvt_pk_bf16(v0[0], v0[1]); w.y = cvt_pk_bf16(v0[2], v0[3]); w.z = cvt_pk_bf16(v1[0], v1[1]); w.w = cvt_pk_bf16(v1[2], v1[3]);
                        if (!dry) *(u32x4*)(rowp + colo + bj * 128) = w; else asm volatile("" :: "v"(w));
                    }
                }
                asm volatile("" ::: "memory");
            }
    }
};
struct MergeOrder {
    pg8::StaticOrder base;
    __device__ void init(int nM, int G, int c) { base.init(nM, 4, G, c); }
    __device__ bool next(int i, pg8::Unit& u) const { const int j = i / 3, n = i - 3 * j; if (!base.next(j, u)) return false; u.pn += 4 * n; return true; }
};
struct EpiBf16Plain {
    static constexpr bool PERM = true;
    __device__ __forceinline__ bool keep(const pg8::Unit&) const { return false; }
    bf16* O; int ldc;
    __device__ __forceinline__ void operator()(const f32x4 (&acc)[2][2][4][2], const pg8::Unit& u, int wr, int wc, int fr, int fq) const {
        const int row0 = u.pm * 256 + wr * 64 + fr, colt = u.pn * 256 + wc * 32 + 8 * fq;
#pragma unroll
        for (int ai = 0; ai < 2; ++ai)
#pragma unroll
            for (int m = 0; m < 4; ++m) {
                bf16* rowp = O + (size_t)(row0 + ai * 128 + m * 16) * ldc + colt;
#pragma unroll
                for (int bj = 0; bj < 2; ++bj) {
                    const f32x4 v0 = acc[ai][bj][m][0], v1 = acc[ai][bj][m][1];
                    u32x4 w; w.x = cvt_pk_bf16(v0[0], v0[1]); w.y = cvt_pk_bf16(v0[2], v0[3]); w.z = cvt_pk_bf16(v1[0], v1[1]); w.w = cvt_pk_bf16(v1[2], v1[3]);
                    *(u32x4*)(rowp + bj * 128) = w;
                }
            }
    }
};
template <bool ROUTED> struct EpiSwiGLU {
    static constexpr bool PERM = true;
    __device__ __forceinline__ bool keep(const pg8::Unit&) const { return false; }
    bf16* O; const float* roww;
    __device__ __forceinline__ void operator()(const f32x4 (&acc)[2][2][4][2], const pg8::Unit& u, int wr, int wc, int fr, int fq) const {
        const int row0 = u.pm * 256 + wr * 64 + fr, colt = u.pn * 128 + wc * 32 + 8 * fq;
#pragma unroll
        for (int ai = 0; ai < 2; ++ai)
#pragma unroll
            for (int m = 0; m < 4; ++m) {
                const int row = row0 + ai * 128 + m * 16;
                const float rw = ROUTED ? roww[row] : 1.0f;
                const f32x4 g0 = acc[ai][0][m][0], g1 = acc[ai][0][m][1], u0 = acc[ai][1][m][0], u1 = acc[ai][1][m][1];
                f32x4 a, b;
#pragma unroll
                for (int j = 0; j < 4; ++j) { a[j] = siluf_(g0[j]) * u0[j] * rw; b[j] = siluf_(g1[j]) * u1[j] * rw; }
                u32x4 w; w.x = cvt_pk_bf16(a[0], a[1]); w.y = cvt_pk_bf16(a[2], a[3]); w.z = cvt_pk_bf16(b[0], b[1]); w.w = cvt_pk_bf16(b[2], b[3]);
                *(u32x4*)(O + (size_t)row * 256 + colt) = w;
                asm volatile("" ::: "memory");
            }
    }
};
struct EpiRouter {
    static constexpr bool PERM = false;
    __device__ __forceinline__ bool keep(const pg8::Unit&) const { return false; }
    float* L;
    __device__ __forceinline__ void operator()(const f32x4 (&acc)[2][2][4][2], const pg8::Unit& u, int wr, int wc, int fr, int fq) const {
        if (wc >= 2) return;
        const int row0 = u.pm * 256 + wr * 64 + fr, col0 = wc * 32 + 4 * fq;
#pragma unroll
        for (int ai = 0; ai < 2; ++ai)
#pragma unroll
            for (int m = 0; m < 4; ++m) {
                float* rowp = L + (size_t)(row0 + ai * 128 + m * 16) * 64 + col0;
#pragma unroll
                for (int n = 0; n < 2; ++n) *(f32x4*)(rowp + n * 16) = acc[ai][0][m][n] + acc[ai][1][m][n];
            }
    }
};
struct EpiSharedDown {
    static constexpr bool PERM = false;
    __device__ __forceinline__ bool keep(const pg8::Unit&) const { return false; }
    float* X; const float* modl; bool dry;
    __device__ __forceinline__ void operator()(const f32x4 (&acc)[2][2][4][2], const pg8::Unit& u, int wr, int wc, int fr, int fq) const {
        const int row0 = u.pm * 256 + wr * 64 + fr, col0 = u.pn * 256 + wc * 32 + 4 * fq;
#pragma unroll
        for (int ai = 0; ai < 2; ++ai)
#pragma unroll
            for (int m = 0; m < 4; ++m) {
                const int row = row0 + ai * 128 + m * 16;
                const int mr = row < NLAT ? (row >> 12) : 8;
                float* rowp = X + (size_t)row * 1024 + col0;
                const float* m5 = modl + (size_t)mr * 6144 + 5 * 1024 + col0;
#pragma unroll
                for (int bj = 0; bj < 2; ++bj)
#pragma unroll
                    for (int n = 0; n < 2; ++n) {
                        const f32x4 xv = *(const f32x4*)(rowp + bj * 128 + n * 16), gv = *(const f32x4*)(m5 + bj * 128 + n * 16);
                        const f32x4 ov = xv * DN_ALPHA + gv * acc[ai][bj][m][n]; if (!dry) *(f32x4*)(rowp + bj * 128 + n * 16) = ov; else asm volatile("" :: "v"(ov));
                    }
                asm volatile("" ::: "memory");
            }
    }
};

namespace att {
constexpr int KVBLK = 64;
constexpr float SCALE = 0.125f, THR = 8.f;
constexpr size_t SHM_V = KVBLK * 128 * 2, SHM_K = KVBLK * 128 * 2;
constexpr size_t SHM_ATTN = 2 * SHM_V + 2 * SHM_K + 8 * 64 * 4;
#define KSWZ(row, colB) ((row) * 256 + ((colB) ^ (((row) & 7) << 4)))
#define SBAR() __builtin_amdgcn_sched_barrier(0)
__device__ __forceinline__ int crow(int r, int hi) { return (r & 3) + 8 * (r >> 2) + 4 * hi; }
__device__ __forceinline__ void partialSM(f32x16& p0, f32x16& p1, float& m_reg, float& mn, float& alpha) {
  constexpr float C = SCALE * 1.4426950408889634f;
  float pmax = p0[0];
#pragma unroll
  for (int r = 1; r < 16; ++r) pmax = fmaxf(pmax, p0[r]);
#pragma unroll
  for (int r = 0; r < 16; ++r) pmax = fmaxf(pmax, p1[r]);
  { auto rr = __builtin_amdgcn_permlane32_swap(__float_as_uint(pmax), __float_as_uint(pmax), false, false);
    pmax = fmaxf(__uint_as_float(rr[0]), __uint_as_float(rr[1])); }
  if (__builtin_expect(__all(pmax - m_reg <= THR / SCALE), 1)) { mn = m_reg; alpha = 1.f; }
  else { mn = fmaxf(m_reg, pmax); alpha = __builtin_amdgcn_exp2f((m_reg - mn) * C); m_reg = mn; }
  float mnC = -mn * C;
#pragma unroll
  for (int r = 0; r < 16; ++r) p0[r] = fmaf(p0[r], C, mnC);
#pragma unroll
  for (int r = 0; r < 16; ++r) p1[r] = fmaf(p1[r], C, mnC);
#pragma unroll
  for (int r = 0; r < 16; ++r) p0[r] = __builtin_amdgcn_exp2f(p0[r]);
}
__device__ __forceinline__ void finishSM(f32x16& p0, f32x16& p1, float alpha, float& l_reg, bf16x8& pa0, bf16x8& pa1, bf16x8& pa2, bf16x8& pa3) {
#pragma unroll
  for (int r = 0; r < 16; ++r) p1[r] = __builtin_amdgcn_exp2f(p1[r]);
  float ps = 0;
#pragma unroll
  for (int r = 0; r < 16; ++r) ps += p0[r];
#pragma unroll
  for (int r = 0; r < 16; ++r) ps += p1[r];
  { auto rr = __builtin_amdgcn_permlane32_swap(__float_as_uint(ps), __float_as_uint(ps), false, false);
    ps = __uint_as_float(rr[0]) + __uint_as_float(rr[1]); }
  l_reg = l_reg * alpha + ps;
#define PK4(P, BASE, OUT) do { unsigned a0 = cvt_pk_bf16(P[BASE + 0], P[BASE + 1]), a1 = cvt_pk_bf16(P[BASE + 2], P[BASE + 3]);   \
    unsigned b0 = cvt_pk_bf16(P[BASE + 4], P[BASE + 5]), b1 = cvt_pk_bf16(P[BASE + 6], P[BASE + 7]);                              \
    auto r0 = __builtin_amdgcn_permlane32_swap(a0, b0, false, false); auto r1 = __builtin_amdgcn_permlane32_swap(a1, b1, false, false); \
    u32x4 w = {r0[0], r1[0], r0[1], r1[1]}; OUT = *reinterpret_cast<bf16x8*>(&w); } while (0)
  PK4(p0, 0, pa0); PK4(p0, 8, pa1); PK4(p1, 0, pa2); PK4(p1, 8, pa3);
#undef PK4
}
__device__ __forceinline__ void qkt(f32x16& p0, f32x16& p1, const char* Ks, const bf16x8 (&qr)[4], int r32, int hi, int mcol) {
  p0 = f32x16{}; p1 = f32x16{};
#pragma unroll
  for (int d0 = 0; d0 < 4; ++d0) { int cb = (mcol + d0 * 16 + hi * 8) * 2;
    bf16x8 b0 = *reinterpret_cast<const bf16x8*>(Ks + KSWZ(r32, cb));
    bf16x8 b1 = *reinterpret_cast<const bf16x8*>(Ks + KSWZ(32 + r32, cb));
    p0 = __builtin_amdgcn_mfma_f32_32x32x16_bf16(b0, qr[d0], p0, 0, 0, 0);
    p1 = __builtin_amdgcn_mfma_f32_32x32x16_bf16(b1, qr[d0], p1, 0, 0, 0); }
}
__device__ __forceinline__ int v_st(int k, int c) { const int kk = (k & ~0xC) | ((k & 4) << 1) | ((k & 8) >> 1); return ((kk >> 3) * 4 + (c >> 5)) * 512 + ((kk & 7) * 32 + (c & 31)) * 2; }
__device__ __forceinline__ int v_rd_base(int lane) { return ((lane & 3) << 3) | (((lane >> 2) & 3) << 6) | (((lane >> 4) & 1) << 5) | (((lane >> 5) & 1) << 8); }
constexpr int v_rd_off(int d0, int ks, int half) { return d0 * 512 + ks * 4096 + half * 2048; }
template <int OFF> __device__ __forceinline__ s16x4 tr_read(int vb) {
  s16x4 r; asm volatile("ds_read_b64_tr_b16 %0, %1 offset:%2" : "=&v"(r) : "v"(vb), "i"(OFF) : "memory"); return r;
}
template <int D0> __device__ __forceinline__ void pv_one(f32x16& od, int vb, bf16x8 pa0, bf16x8 pa1, bf16x8 pa2, bf16x8 pa3) {
  const s16x4 l0 = tr_read<v_rd_off(D0, 0, 0)>(vb), h0 = tr_read<v_rd_off(D0, 0, 1)>(vb), l1 = tr_read<v_rd_off(D0, 1, 0)>(vb), h1 = tr_read<v_rd_off(D0, 1, 1)>(vb);
  const s16x4 l2 = tr_read<v_rd_off(D0, 2, 0)>(vb), h2 = tr_read<v_rd_off(D0, 2, 1)>(vb), l3 = tr_read<v_rd_off(D0, 3, 0)>(vb), h3 = tr_read<v_rd_off(D0, 3, 1)>(vb);
  asm volatile("s_waitcnt lgkmcnt(0)" ::: "memory"); SBAR();
#define PK(L, H) (bf16x8){L[0], L[1], L[2], L[3], H[0], H[1], H[2], H[3]}
  od = __builtin_amdgcn_mfma_f32_32x32x16_bf16(pa0, PK(l0, h0), od, 0, 0, 0);
  od = __builtin_amdgcn_mfma_f32_32x32x16_bf16(pa1, PK(l1, h1), od, 0, 0, 0);
  od = __builtin_amdgcn_mfma_f32_32x32x16_bf16(pa2, PK(l2, h2), od, 0, 0, 0);
  od = __builtin_amdgcn_mfma_f32_32x32x16_bf16(pa3, PK(l3, h3), od, 0, 0, 0);
#undef PK
}
__device__ __forceinline__ void pv_d0(f32x16* o, int vb, bf16x8 pa0, bf16x8 pa1, bf16x8 pa2, bf16x8 pa3) {
  pv_one<0>(o[0], vb, pa0, pa1, pa2, pa3); pv_one<1>(o[1], vb, pa0, pa1, pa2, pa3); pv_one<2>(o[2], vb, pa0, pa1, pa2, pa3); pv_one<3>(o[3], vb, pa0, pa1, pa2, pa3);
}
static __device__ __forceinline__ void attn_unit(bf16* __restrict__ ZZ_, int qrow0_, int h_, int krowA_, int ntA_, int krowB_, int NT_, float lam_, const float* __restrict__ gn_, float oscale_, bool dostore) {
  bf16* __restrict__ ZZ = uni(ZZ_); const int qrow0 = uni(qrow0_), h = uni(h_), krowA = uni(krowA_), ntA = uni(ntA_), krowB = uni(krowB_), NT = uni(NT_); const float lam = uni(lam_), oscale = uni(oscale_); const float* __restrict__ gn = uni(gn_);
  char* lds = (char*)lds_raw;
  const int tid = otid(), wid = tid >> 6, lane = tid & 63, r32 = lane & 31, hi = lane >> 5;
  const int map = wid >> 2, wq = wid & 3, mcol = map * 64;
  char* V_lds = lds; char* K_lds = lds + 2 * SHM_V;
  float* ws = (float*)(lds + 2 * SHM_V + 2 * SHM_K) + wid * 64; float* li_l = ws; float* al_l = ws + 32;
  float m_reg = -1e30f, l_reg = 0; f32x16 o[4] = {}; bf16x8 qr[4];
  const bf16* Qw = ZZ + (size_t)(qrow0 + wq * 32 + r32) * ZLD + ZC_Q + h * 128 + mcol + hi * 8;
#pragma unroll
  for (int d0 = 0; d0 < 4; ++d0) qr[d0] = *reinterpret_cast<const bf16x8*>(Qw + d0 * 16);
  const int sr = tid >> 4, sc = (tid & 15) * 8, vst0 = v_st(sr, sc), vst1 = v_st(32 + sr, sc);
  const int vb0 = (int)(uintptr_t)(LAS char*)V_lds + v_rd_base(lane);
  const bf16* Kcol = ZZ + ZC_K + h * 128 + sc; const bf16* Vcol = ZZ + ZC_V + h * 128 + sc;
  struct { bf16x8 vs0, vs1, ks0, ks1; } sr_[2];
#define KROW(j) ((j) < ntA ? krowA + (j) * KVBLK : krowB + ((j) - ntA) * KVBLK)
#define SLOAD(i, j) do { const size_t _r0 = (size_t)(KROW(j) + sr) * ZLD, _r1 = _r0 + (size_t)32 * ZLD; \
    sr_[i].vs0 = *reinterpret_cast<const bf16x8*>(Vcol + _r0); sr_[i].vs1 = *reinterpret_cast<const bf16x8*>(Vcol + _r1); \
    sr_[i].ks0 = *reinterpret_cast<const bf16x8*>(Kcol + _r0); sr_[i].ks1 = *reinterpret_cast<const bf16x8*>(Kcol + _r1); } while (0)
#define SWRITE(b, i) do { *(bf16x8*)(V_lds + (b) * SHM_V + vst0) = sr_[i].vs0;          \
    *(bf16x8*)(V_lds + (b) * SHM_V + vst1) = sr_[i].vs1; int kc = sc * 2;               \
    *(bf16x8*)(K_lds + (b) * SHM_K + KSWZ(sr, kc)) = sr_[i].ks0;                       \
    *(bf16x8*)(K_lds + (b) * SHM_K + KSWZ(32 + sr, kc)) = sr_[i].ks1; } while (0)
#define SWAIT() asm volatile("s_waitcnt vmcnt(4)" ::: "memory")
#define RESC(a) do { if (__any((a) < 1.f)) { if (hi == 0) al_l[r32] = (a); asm volatile("s_waitcnt lgkmcnt(0)" ::: "memory"); \
    _Pragma("unroll") for (int d = 0; d < 4; ++d) _Pragma("unroll") for (int r = 0; r < 16; ++r) o[d][r] *= al_l[crow(r, hi)]; } } while (0)
  f32x16 pA0, pA1, pB0, pB1; float mnA, mnB, alA, alB; bf16x8 pa0, pa1, pa2, pa3;
  constexpr int SE = 0, SO = 1;
  SLOAD(SE, 0); asm volatile("s_waitcnt vmcnt(0)" ::: "memory"); SWRITE(0, SE); __syncthreads();
  qkt(pA0, pA1, K_lds, qr, r32, hi, mcol); partialSM(pA0, pA1, m_reg, mnA, alA);
  SLOAD(SO, 1); if (2 < NT) SLOAD(SE, 2);
  SWAIT(); SWRITE(1, SO); __syncthreads();
  for (int j = 1; j + 1 < NT; j += 2) {
    SBAR(); qkt(pB0, pB1, K_lds + SHM_K, qr, r32, hi, mcol);
    finishSM(pA0, pA1, alA, l_reg, pa0, pa1, pa2, pa3); SBAR();
    SLOAD(SO, j + 2); SBAR();
    pv_d0(o, vb0, pa0, pa1, pa2, pa3); partialSM(pB0, pB1, m_reg, mnB, alB);
    __syncthreads(); SWAIT(); SWRITE(0, SE);
    RESC(alB); __syncthreads();
    SBAR(); qkt(pA0, pA1, K_lds, qr, r32, hi, mcol);
    finishSM(pB0, pB1, alB, l_reg, pa0, pa1, pa2, pa3); SBAR();
    if (j + 3 < NT) SLOAD(SE, j + 3); SBAR();
    pv_d0(o, vb0 + (int)SHM_V, pa0, pa1, pa2, pa3); partialSM(pA0, pA1, m_reg, mnA, alA);
    __syncthreads(); SWAIT(); SWRITE(1, SO);
    RESC(alA); __syncthreads();
  }
  SBAR(); qkt(pB0, pB1, K_lds + SHM_K, qr, r32, hi, mcol);
  finishSM(pA0, pA1, alA, l_reg, pa0, pa1, pa2, pa3); SBAR();
  pv_d0(o, vb0, pa0, pa1, pa2, pa3); partialSM(pB0, pB1, m_reg, mnB, alB);
  __syncthreads(); RESC(alB);
  finishSM(pB0, pB1, alB, l_reg, pa0, pa1, pa2, pa3); SBAR();
  pv_d0(o, vb0 + (int)SHM_V, pa0, pa1, pa2, pa3);
  if (hi == 0) li_l[r32] = l_reg; asm volatile("s_waitcnt lgkmcnt(0)" ::: "memory");
  float rli[16];
#pragma unroll
  for (int r = 0; r < 16; ++r) rli[r] = __builtin_amdgcn_rcpf(li_l[crow(r, hi)]);
  __syncthreads();
  float* xch = (float*)lds + (size_t)wq * 4096;
  if (map == 1) {
#pragma unroll
    for (int d0 = 0; d0 < 4; ++d0)
#pragma unroll
      for (int r = 0; r < 16; ++r) xch[(d0 * 16 + r) * 64 + lane] = o[d0][r] * rli[r];
  }
  __syncthreads();
  if (map == 0) {
    float ss[16];
#pragma unroll
    for (int r = 0; r < 16; ++r) ss[r] = 0.f;
#pragma unroll
    for (int d0 = 0; d0 < 4; ++d0)
#pragma unroll
      for (int r = 0; r < 16; ++r) { const float v = o[d0][r] * rli[r] - lam * xch[(d0 * 16 + r) * 64 + lane]; o[d0][r] = v; ss[r] += v * v; }
#pragma unroll
    for (int r = 0; r < 16; ++r) {
#pragma unroll
      for (int off = 1; off < 32; off <<= 1) ss[r] += __shfl_xor(ss[r], off);
      ss[r] = __builtin_amdgcn_rsqf(ss[r] * (1.0f / 128.0f) + RMS_EPS) * oscale;
    }
    float gv[4];
#pragma unroll
    for (int d0 = 0; d0 < 4; ++d0) gv[d0] = gn[d0 * 32 + r32];
    bf16* Ow = ZZ + (size_t)(qrow0 + wq * 32) * ZLD + ZC_Q + h * 128 + r32;
#pragma unroll
    for (int r = 0; r < 16; ++r) { const int orow = crow(r, hi);
#pragma unroll
      for (int d0 = 0; d0 < 4; ++d0) if (dostore) Ow[(size_t)orow * ZLD + d0 * 32] = (bf16)f2bf(o[d0][r] * ss[r] * gv[d0]); }
  }
#undef KROW
#undef SLOAD
#undef SWRITE
#undef SWAIT
#undef RESC
}
#undef KSWZ
#undef SBAR
}

__device__ __forceinline__ f32x4 mma_tile(const LAS char* A, int sa, const LAS char* B, int sb, int ksteps, int lane, f32x4 acc) {
    const int r = lane & 15, q = lane >> 4;
    for (int k = 0; k < ksteps; ++k) {
        const bf16x8 a = *(const LAS bf16x8*)(A + r * sa + (k * 32 + q * 8) * 2);
        const bf16x8 b = *(const LAS bf16x8*)(B + r * sb + (k * 32 + q * 8) * 2);
        acc = __builtin_amdgcn_mfma_f32_16x16x32_bf16(a, b, acc, 0, 0, 0);
    }
    return acc;
}

namespace ssd {
constexpr int PC = 272, PX = 144;
constexpr int BUFB = 64 * PC * 2 + 64 * PX;
constexpr int O_C = 0, O_B = 64 * PC, O_X = 2 * 64 * PC, O_XW = 2 * BUFB, O_MM = O_XW + 64 * PX, O_SB = O_MM + 64 * PX, O_ACS = O_SB + 64 * PC, O_END = O_ACS + 2 * 128 * 4;
static_assert(O_END <= 131072, "ssd lds");
struct Par { const bf16* XA; const float* DT; const float* ACS; bf16* Y; float Dskip; int b, h, d; };
__device__ __forceinline__ bf16x8 tr_frag(const LAS char* T, int pitch, int kbase, int idx0, int lane) {
    const int gq = lane >> 4, j = lane & 15;
    const LAS char* p0 = T + (kbase + 8 * gq + (j >> 2)) * pitch + (idx0 + 4 * (j & 3)) * 2;
    const s16x4 lo = __builtin_amdgcn_ds_read_tr16_b64_v4i16((LAS s16x4*)p0), hi = __builtin_amdgcn_ds_read_tr16_b64_v4i16((LAS s16x4*)(p0 + 4 * pitch));
    return (bf16x8){lo[0], lo[1], lo[2], lo[3], hi[0], hi[1], hi[2], hi[3]};
}
static __device__ __forceinline__ void unit(Par P_) {
    Par P; P.XA = uni(P_.XA); P.DT = uni(P_.DT); P.ACS = uni(P_.ACS); P.Y = uni(P_.Y); P.Dskip = uni(P_.Dskip); P.b = uni(P_.b); P.h = uni(P_.h); P.d = uni(P_.d);
    LAS char* lds = (LAS char*)lds_raw;
    const int tid = otid(), wid = __builtin_amdgcn_readfirstlane(tid >> 6), lane = tid & 63, fr = lane & 15, fq = lane >> 4;
    const int g = P.h >> 2, dh = P.d * 8 + P.h;
    for (int i = tid; i < 64 * PC / 4; i += 512) ((LAS unsigned*)(lds + O_SB))[i] = 0u;
    f32x4 Sacc[4];
#pragma unroll
    for (int i = 0; i < 4; ++i) Sacc[i] = (f32x4){0.f, 0.f, 0.f, 0.f};
    u32x4 st[5]; float sa = 0.f;
#define CH_ROW(ch, pos) (((ch) < 4 ? NLAT + P.b * CTXL : P.b * SEQ) + (P.d ? ((ch) < 4 ? CTXL : SEQ) - 1 - ((((ch) < 4) ? (ch) : (ch) - 4) * 64 + (pos)) : (((ch) < 4) ? (ch) : (ch) - 4) * 64 + (pos)))
#define SSD_LOAD(ch) do { \
        _Pragma("unroll") for (int i_ = 0; i_ < 5; ++i_) { const int q_ = tid + 512 * i_; \
            const int row_ = i_ < 4 ? ((q_ & 1023) >> 4) : ((q_ - 2048) >> 3); const int pc_ = i_ < 4 ? (q_ & 15) : (q_ & 7); \
            const int col_ = i_ < 2 ? 768 + g * 128 + pc_ * 8 : (i_ < 4 ? 512 + g * 128 + pc_ * 8 : P.h * 64 + pc_ * 8); \
            st[i_] = *(const u32x4*)(P.XA + (size_t)CH_ROW(ch, row_) * 1024 + col_); } \
        if (tid < 128) { const int r_ = CH_ROW(ch, tid & 63); sa = tid < 64 ? P.ACS[(size_t)r_ * 16 + dh] : P.DT[(size_t)r_ * 16 + dh]; } } while (0)
#define SSD_WRITE(bf) do { \
        _Pragma("unroll") for (int i_ = 0; i_ < 5; ++i_) { const int q_ = tid + 512 * i_; \
            const int row_ = i_ < 4 ? ((q_ & 1023) >> 4) : ((q_ - 2048) >> 3); const int pc_ = i_ < 4 ? (q_ & 15) : (q_ & 7); \
            const int off_ = i_ < 2 ? O_C + row_ * PC + pc_ * 16 : (i_ < 4 ? O_B + row_ * PC + pc_ * 16 : O_X + row_ * PX + pc_ * 16); \
            *(LAS u32x4*)(lds + (bf) * BUFB + off_) = st[i_]; } \
        if (tid < 128) *(LAS float*)(lds + O_ACS + (bf) * 512 + tid * 4) = sa; } while (0)
    SSD_LOAD(0); SSD_WRITE(0); SSD_LOAD(1);
    __syncthreads();
    for (int ch = 0; ch < 68; ++ch) {
        const int bf = ch & 1;
        if (ch + 1 < 68) SSD_WRITE(bf ^ 1);
        if (ch + 2 < 68) SSD_LOAD(ch + 2);
        const LAS char* Cb = lds + bf * BUFB + O_C; const LAS char* Bb = lds + bf * BUFB + O_B; const LAS char* Xb = lds + bf * BUFB + O_X;
        const LAS float* ACSb = (const LAS float*)(lds + O_ACS + bf * 512); const LAS float* DTb = ACSb + 64;
        const float acs_end = ACSb[63];
        { const int s_ = tid >> 3, pc = tid & 7; const float sc = DTb[s_] * fexp(acs_end - ACSb[s_]);
          const u32x4 xv = *(const LAS u32x4*)(Xb + s_ * PX + pc * 16); u32x4 w;
          w.x = cvt_pk_bf16(bflo(xv.x) * sc, bfhi(xv.x) * sc); w.y = cvt_pk_bf16(bflo(xv.y) * sc, bfhi(xv.y) * sc); w.z = cvt_pk_bf16(bflo(xv.z) * sc, bfhi(xv.z) * sc); w.w = cvt_pk_bf16(bflo(xv.w) * sc, bfhi(xv.w) * sc);
          *(LAS u32x4*)(lds + O_XW + s_ * PX + pc * 16) = w; }
        const int lt = wid >> 1, h2 = wid & 1;
        f32x4 yo[2];
#pragma unroll
        for (int i = 0; i < 2; ++i) {
            const int st_ = h2 * 2 + i;
            f32x4 gacc = (f32x4){0.f, 0.f, 0.f, 0.f};
            if (st_ <= lt) gacc = mma_tile(Cb + lt * 16 * PC, PC, Bb + st_ * 16 * PC, PC, 4, lane, gacc);
            const int s = st_ * 16 + fr; const float as = ACSb[s], ds = DTb[s];
#pragma unroll
            for (int jj = 0; jj < 4; ++jj) { const int l = lt * 16 + fq * 4 + jj; const float v = (s <= l) ? gacc[jj] * fexp(ACSb[l] - as) * ds : 0.f;
                *(LAS bf16*)(lds + O_MM + l * PX + s * 2) = (bf16)f2bf(v); }
            yo[i] = mma_tile(Cb + lt * 16 * PC, PC, lds + O_SB + st_ * 16 * PC, PC, 4, lane, (f32x4){0.f, 0.f, 0.f, 0.f});
        }
        __syncthreads();
#pragma unroll
        for (int i = 0; i < 2; ++i) {
            const int pt = h2 * 2 + i;
            f32x4 yd = (f32x4){0.f, 0.f, 0.f, 0.f};
#pragma unroll
            for (int ks = 0; ks < 2; ++ks) { const bf16x8 af = *(const LAS bf16x8*)(lds + O_MM + (lt * 16 + fr) * PX + (ks * 32 + fq * 8) * 2); const bf16x8 bfr = tr_frag(Xb, PX, ks * 32, pt * 16, lane);
                yd = __builtin_amdgcn_mfma_f32_16x16x32_bf16(af, bfr, yd, 0, 0, 0); }
            const int p = pt * 16 + fr;
#pragma unroll
            for (int jj = 0; jj < 4; ++jj) { const int l = lt * 16 + fq * 4 + jj; float y = yd[jj] + fexp(ACSb[l]) * yo[i][jj];
                if (P.d == 0) y += P.Dskip * bf2f(*(const LAS bf16*)(Xb + l * PX + p * 2));
                P.Y[(size_t)CH_ROW(ch, l) * 512 + P.h * 64 + p] = (bf16)f2bf(y); }
        }
        { const float dec = fexp(acs_end); const int pt = lt;
          bf16x8 af[2];
#pragma unroll
          for (int ks = 0; ks < 2; ++ks) af[ks] = tr_frag(lds + O_XW, PX, ks * 32, pt * 16, lane);
#pragma unroll
          for (int i = 0; i < 4; ++i) { const int nt = h2 * 4 + i;
              f32x4 acc = Sacc[i] * dec;
#pragma unroll
              for (int ks = 0; ks < 2; ++ks) { const bf16x8 bfr = tr_frag(Bb, PC, ks * 32, nt * 16, lane); acc = __builtin_amdgcn_mfma_f32_16x16x32_bf16(af[ks], bfr, acc, 0, 0, 0); }
              Sacc[i] = acc;
              const int n = nt * 16 + fr;
#pragma unroll
              for (int jj = 0; jj < 4; ++jj) { const int p = pt * 16 + fq * 4 + jj; *(LAS bf16*)(lds + O_SB + p * PC + n * 2) = (bf16)f2bf(acc[jj]); } } }
        __syncthreads();
    }
#undef CH_ROW
#undef SSD_LOAD
#undef SSD_WRITE
}
}

namespace lru {
constexpr int SS = 72 * 2;
constexpr int O_U = 0, O_WA = O_U + 128 * SS, O_WI = O_WA + 64 * SS, O_HL = O_WI + 64 * SS, O_CP = O_HL + 32768, O_AGG = O_CP + 32768, O_CW = O_AGG + 8 * 2 * 64 * 4, O_END = O_CW + 64 * 5 * 4;
static_assert(O_END <= 131072, "lru lds");
struct Par { const bf16* ZZ; bf16* Hout; const float* conv_w; const float* conv_b; const float* wa; const float* wi; const float* ba; const float* bi; const float* lam; int b, n, d; };
static __device__ __forceinline__ void unit(Par P_) {
    Par P; P.ZZ = uni(P_.ZZ); P.Hout = uni(P_.Hout); P.conv_w = uni(P_.conv_w); P.conv_b = uni(P_.conv_b); P.wa = uni(P_.wa); P.wi = uni(P_.wi); P.ba = uni(P_.ba); P.bi = uni(P_.bi); P.lam = uni(P_.lam); P.b = uni(P_.b); P.n = uni(P_.n); P.d = uni(P_.d);
    LAS char* lds = (LAS char*)lds_raw;
    const int tid = otid(), wid = __builtin_amdgcn_readfirstlane(tid >> 6), lane = tid & 63, fr = lane & 15, fq = lane >> 4;
    LAS float* HL = (LAS float*)(lds + O_HL) + wid * 1024; LAS float* CP = (LAS float*)(lds + O_CP) + wid * 1024;
    LAS float* AGG = (LAS float*)(lds + O_AGG); LAS float* CW = (LAS float*)(lds + O_CW);
    for (int i = tid; i < 64 * 5; i += 512) { const int lc = i / 5, j = i % 5; const int c = P.n * 64 + lc; CW[i] = j < 4 ? P.conv_w[j * 512 + c] : P.conv_b[c]; }
    for (int i = tid; i < 4096; i += 512) { const int k = i >> 6, j = i & 63;
        *(LAS bf16*)(lds + O_WA + j * SS + k * 2) = (bf16)f2bf(P.wa[i]); *(LAS bf16*)(lds + O_WI + j * SS + k * 2) = (bf16)f2bf(P.wi[i]); }
    const int chn = P.n * 64 + lane;
    const float ba = P.ba[chn], bi = P.bi[chn], c8 = -8.0f * softplusf_(-P.lam[chn]);
    float hc = 0.f;
    __syncthreads();
    for (int ch = 0; ch < 34; ++ch) {
        const bool isctx = ch < 2; const int cc = isctx ? ch : ch - 2; const int Ls = isctx ? CTXL : SEQ; const int rseg = isctx ? NLAT + P.b * CTXL : P.b * SEQ;
        for (int it = tid; it < 128 * 8; it += 512) {
            const int pos = it >> 3, lc0 = (it & 7) * 8;
            const int sp = cc * 128 + pos; const int tk = P.d ? Ls - 1 - sp : sp;
            float u[8];
#pragma unroll
            for (int e = 0; e < 8; ++e) u[e] = CW[(lc0 + e) * 5 + 4];
#pragma unroll
            for (int j = 0; j < 4; ++j) { const int t2 = tk + j - 2;
                if (t2 >= 0 && t2 < Ls) { const u32x4 xv = *(const u32x4*)(P.ZZ + (size_t)(rseg + t2) * ZLD + ZC_LX + P.n * 64 + lc0);
                    u[0] += bflo(xv.x) * CW[(lc0 + 0) * 5 + j]; u[1] += bfhi(xv.x) * CW[(lc0 + 1) * 5 + j]; u[2] += bflo(xv.y) * CW[(lc0 + 2) * 5 + j]; u[3] += bfhi(xv.y) * CW[(lc0 + 3) * 5 + j];
                    u[4] += bflo(xv.z) * CW[(lc0 + 4) * 5 + j]; u[5] += bfhi(xv.z) * CW[(lc0 + 5) * 5 + j]; u[6] += bflo(xv.w) * CW[(lc0 + 6) * 5 + j]; u[7] += bfhi(xv.w) * CW[(lc0 + 7) * 5 + j]; } }
            u32x4 w; w.x = cvt_pk_bf16(u[0], u[1]); w.y = cvt_pk_bf16(u[2], u[3]); w.z = cvt_pk_bf16(u[4], u[5]); w.w = cvt_pk_bf16(u[6], u[7]);
            *(LAS u32x4*)(lds + O_U + pos * SS + lc0 * 2) = w;
        }
        __syncthreads();
#pragma unroll
        for (int jt = 0; jt < 4; ++jt) {
            const f32x4 ga = mma_tile(lds + O_U + wid * 16 * SS, SS, lds + O_WA + jt * 16 * SS, SS, 2, lane, (f32x4){0.f, 0.f, 0.f, 0.f});
            const f32x4 gi = mma_tile(lds + O_U + wid * 16 * SS, SS, lds + O_WI + jt * 16 * SS, SS, 2, lane, (f32x4){0.f, 0.f, 0.f, 0.f});
#pragma unroll
            for (int jj = 0; jj < 4; ++jj) { HL[(fq * 4 + jj) * 64 + jt * 16 + fr] = ga[jj]; CP[(fq * 4 + jj) * 64 + jt * 16 + fr] = gi[jj]; }
        }
        LDS_WAIT();
        float h = 0.f, Pp = 1.f;
        for (int i = 0; i < 16; ++i) {
            const float uo = bf2f(*(const LAS bf16*)(lds + O_U + (wid * 16 + i) * SS + lane * 2));
            const float r = sigmoidf_(HL[i * 64 + lane] + ba), ig = sigmoidf_(CP[i * 64 + lane] + bi), la = c8 * r;
            const float a = __expf(la), bb = sqrtf(-expm1f(2.0f * la)) * (ig * uo);
            h = a * h + bb; Pp *= a;
            HL[i * 64 + lane] = h; CP[i * 64 + lane] = Pp;
        }
        AGG[(wid * 2 + 0) * 64 + lane] = Pp; AGG[(wid * 2 + 1) * 64 + lane] = h;
        __syncthreads();
        float cin = hc, call = hc;
#pragma unroll
        for (int w = 0; w < 8; ++w) { const float pw = AGG[(w * 2 + 0) * 64 + lane], hw = AGG[(w * 2 + 1) * 64 + lane]; call = pw * call + hw; if (w < wid) cin = call; }
        hc = call;
        for (int i = 0; i < 16; ++i) {
            const float hf = HL[i * 64 + lane] + CP[i * 64 + lane] * cin;
            const int sp = cc * 128 + wid * 16 + i; const int tk = P.d ? Ls - 1 - sp : sp;
            P.Hout[(size_t)(rseg + tk) * 512 + chn] = (bf16)f2bf(hf);
        }
        __syncthreads();
    }
}
}

struct Args { const float* in[35]; float* out; unsigned char* ws; int ph_lo, ph_hi; };
constexpr int CTX_OFF = MISC_OFF + 128;
struct Ctx {
    static __device__ __forceinline__ unsigned long long ldp(int i) { int off_ = CTX_OFF + 8 * i; asm volatile("" : "+v"(off_)); const volatile LAS unsigned* p = (const volatile LAS unsigned*)((LAS unsigned char*)lds_raw + off_);
        const unsigned lo = __builtin_amdgcn_readfirstlane(p[0]), hi = __builtin_amdgcn_readfirstlane(p[1]); return ((unsigned long long)hi << 32) | lo; }
    __device__ __forceinline__ const float* in(int i) const { return (const float*)ldp(i); }
    __device__ __forceinline__ float* out() const { return (float*)ldp(35); }
    __device__ __forceinline__ unsigned char* ws() const { return (unsigned char*)ldp(36); }
};
enum { I_X = 0, I_C, I_CTX, I_CCTX, I_WMOD, I_BMOD, I_WIN, I_LAMQ, I_LAMK, I_ATTNG, I_LCW, I_LCB, I_LWA, I_LBA, I_LWI, I_LBI, I_LLAM, I_SCW, I_SCB, I_SDTB, I_SALOG, I_SD, I_SNG,
       I_WBR, I_WOUT, I_LN1G, I_LN1B, I_WRT, I_RBIAS, I_WUP, I_WDN, I_WSU, I_WSD, I_LN2G, I_LN2B };

__device__ __forceinline__ int map_win(int n) {
    if (n < 1024) { const int o = n & 63; return (n & ~63) + 2 * (o & 31) + (o >> 5); }
    if (n < 4096) return n;
    if (n < 4112) return ZC_DT + (n - 4096);
    return ZC_GATE + (n - 4112);
}
__device__ __forceinline__ int map_up(int n) { const int j = n & 255, isu = n >> 8; return (j >> 7) * 256 + isu * 128 + (j & 127); }
template <int MODE> __device__ __forceinline__ void cvt_tile(const float* __restrict__ src, int lds_, int K, int N, bf16* __restrict__ dst, int ldd, int item, LAS float* scr) {
    const int tid = otid(); const int nblk = (N + 63) >> 6; const int kb = item / nblk, nb = item % nblk, k0 = kb * 64, n0 = nb * 64;
    { const int nn = tid & 63, n = n0 + nn;
#pragma unroll
      for (int i = 0; i < 8; ++i) { const int kk = (tid >> 6) + 8 * i; scr[kk * 65 + nn] = (n < N) ? src[(size_t)(k0 + kk) * lds_ + n] : 0.f; } }
    __syncthreads();
    { const int nn = tid >> 3, kc = (tid & 7) * 8, n = n0 + nn;
      if (n < N) {
          const LAS float* s = scr + kc * 65 + nn;
          u32x4 o; o.x = cvt_pk_bf16(s[0], s[65]); o.y = cvt_pk_bf16(s[2 * 65], s[3 * 65]); o.z = cvt_pk_bf16(s[4 * 65], s[5 * 65]); o.w = cvt_pk_bf16(s[6 * 65], s[7 * 65]);
          const int r = MODE == 1 ? map_win(n) : (MODE == 2 ? map_up(n) : n);
          bf16* d = dst + (size_t)r * ldd + k0 + kc;
          *(u32x4*)d = o;
          if (MODE == 3) { *(u32x4*)(d + 1024) = o; *(u32x4*)(d + 2048) = o; }
      } }
    __syncthreads();
}
__device__ __forceinline__ void convert_layer_weights(const Ctx a, int l, LAS float* scr) {
    unsigned char* W = a.ws() + WS_W;
    constexpr int N0 = 16 * 113, N1 = 3 * 8 * 16, N2 = 256, N3 = 16, N4 = 128, N5 = 64, N6 = 64 * 128, N7 = 64 * 64;
    constexpr int NIT = N0 + N1 + N2 + N3 + N4 + N5 + N6 + N7;
    for (int it = blockIdx.x; it < NIT; it += gridDim.x) {
        int r = it;
        if (r < N0) { cvt_tile<1>(a.in(I_WIN) + (size_t)l * 1024 * IN_TOTAL, IN_TOTAL, 1024, IN_TOTAL, (bf16*)(W + W_IN), 1024, r, scr); continue; } r -= N0;
        if (r < N1) { const int br = r / 128; cvt_tile<0>(a.in(I_WBR) + (size_t)(l * 3 + br) * 512 * 1024, 1024, 512, 1024, (bf16*)(W + W_BR) + (size_t)br * 1024 * 512, 512, r % 128, scr); continue; } r -= N1;
        if (r < N2) { cvt_tile<0>(a.in(I_WOUT) + (size_t)l * 1024 * 1024, 1024, 1024, 1024, (bf16*)(W + W_OUT), 1024, r, scr); continue; } r -= N2;
        if (r < N3) { const float* wr = a.in(I_WRT) + (size_t)l * 1024 * 64; bf16* o = (bf16*)(W + W_RT);
            for (int i = r * 4096 + otid(); i < (r + 1) * 4096; i += 512) { const int k = i >> 6, n = i & 63; const float v = wr[i]; const unsigned hi = f2bf(v); const unsigned lo = f2bf(v - bf2f(hi));
                o[(size_t)n * 2048 + k] = (bf16)hi; o[(size_t)n * 2048 + 1024 + k] = (bf16)hi; o[(size_t)(128 + n) * 2048 + k] = (bf16)lo; o[(size_t)(128 + n) * 2048 + 1024 + k] = (bf16)0; }
            continue; } r -= N3;
        if (r < N4) { cvt_tile<2>(a.in(I_WSU) + (size_t)l * 1024 * 512, 512, 1024, 512, (bf16*)(W + W_SU), 1024, r, scr); continue; } r -= N4;
        if (r < N5) { cvt_tile<0>(a.in(I_WSD) + (size_t)l * 256 * 1024, 1024, 256, 1024, (bf16*)(W + W_SD), 256, r, scr); continue; } r -= N5;
        if (r < N6) { const int e = r / 128; cvt_tile<2>(a.in(I_WUP) + (size_t)(l * 64 + e) * 1024 * 512, 512, 1024, 512, (bf16*)(W + W_UP) + (size_t)e * 512 * 1024, 1024, r % 128, scr); continue; } r -= N6;
        { const int e = r / 64; cvt_tile<0>(a.in(I_WDN) + (size_t)(l * 64 + e) * 256 * 1024, 1024, 256, 1024, (bf16*)(W + W_DN) + (size_t)e * 1024 * 256, 256, r % 64, scr); }
    }
}

__device__ __forceinline__ void phase_mod_rope(const Ctx a, LAS float* lds) {
    const int tid = otid();
    float* mod = (float*)(a.ws() + WS_MOD); float* cosT = (float*)(a.ws() + WS_ROPE); float* sinT = cosT + 4096 * 32;
    LAS float* S = lds; LAS float* RED = lds + 9 * 1024;
    for (int i = tid; i < 9 * 1024; i += 512) { const float v = i < 8192 ? a.in(I_C)[i] : a.in(I_CCTX)[i - 8192]; S[i] = siluf_(v); }
    __syncthreads();
    for (int un = blockIdx.x; un < 2 * 96; un += gridDim.x) {
        const int l = un / 96, cb = un % 96, kg = tid >> 6, j = tid & 63, col = cb * 64 + j;
        const float* w = a.in(I_WMOD) + (size_t)l * 1024 * 6144 + col;
        float acc[9];
#pragma unroll
        for (int r = 0; r < 9; ++r) acc[r] = 0.f;
        for (int k = kg * 128; k < kg * 128 + 128; ++k) { const float wv = w[(size_t)k * 6144];
#pragma unroll
            for (int r = 0; r < 9; ++r) acc[r] += S[r * 1024 + k] * wv; }
#pragma unroll
        for (int r = 0; r < 9; ++r) RED[(kg * 9 + r) * 64 + j] = acc[r];
        __syncthreads();
        for (int o = tid; o < 9 * 64; o += 512) { const int r = o >> 6, jj = o & 63; float s = a.in(I_BMOD)[l * 6144 + cb * 64 + jj];
#pragma unroll
            for (int g = 0; g < 8; ++g) s += RED[(g * 9 + r) * 64 + jj];
            mod[((size_t)l * 9 + r) * 6144 + cb * 64 + jj] = s; }
        __syncthreads();
    }
    for (int i = blockIdx.x * 512 + tid; i < 4096 * 32; i += gridDim.x * 512) {
        const int t = i >> 5, f = i & 31; const float pos = (float)(f < 16 ? (t >> 6) : (t & 63));
        const float inv = powf(10000.0f, -(float)(f & 15) / 16.0f); const float ang = pos * inv;
        cosT[i] = cosf(ang); sinT[i] = sinf(ang);
    }
}

__device__ __forceinline__ const float* xrow_in(const Ctx a, int l, int row) {
    if (l == 0) return row < NLAT ? a.in(I_X) + (size_t)row * 1024 : a.in(I_CTX) + (size_t)(row - NLAT) * 1024;
    return (const float*)(a.ws() + WS_X) + (size_t)row * 1024;
}
__device__ __forceinline__ void store_h_row(bf16* hrow, const f32x4 (&v)[4], const float* m0, const float* m1, int lane) {
#pragma unroll
    for (int j = 0; j < 4; ++j) { const int c = 4 * lane + 256 * j; const f32x4 s = *(const f32x4*)(m1 + c), t = *(const f32x4*)(m0 + c);
        u32x2 w; w.x = cvt_pk_bf16(v[j][0] * (1.f + s[0]) + t[0], v[j][1] * (1.f + s[1]) + t[1]); w.y = cvt_pk_bf16(v[j][2] * (1.f + s[2]) + t[2], v[j][3] * (1.f + s[3]) + t[3]);
        *(u32x2*)(hrow + c) = w; }
}
__device__ __forceinline__ void layer_norm_row(f32x4 (&v)[4], const float* g, const float* b, int lane) {
    float s = 0.f;
#pragma unroll
    for (int j = 0; j < 4; ++j) s += (v[j][0] + v[j][1]) + (v[j][2] + v[j][3]);
    const float mean = wave_sum(s) * (1.f / 1024.f); float q = 0.f;
#pragma unroll
    for (int j = 0; j < 4; ++j) { v[j] = v[j] - mean; q += (v[j][0] * v[j][0] + v[j][1] * v[j][1]) + (v[j][2] * v[j][2] + v[j][3] * v[j][3]); }
    const float rstd = __builtin_amdgcn_rsqf(wave_sum(q) * (1.f / 1024.f) + LN_EPS);
#pragma unroll
    for (int j = 0; j < 4; ++j) { const int c = 4 * lane + 256 * j; const f32x4 gg = *(const f32x4*)(g + c), bb = *(const f32x4*)(b + c); v[j] = v[j] * rstd * gg + bb; }
}
__device__ __forceinline__ void phase_modulate0(const Ctx a) {
    const int tid_ = otid(); const int lane = tid_ & 63, gw = blockIdx.x * 8 + (tid_ >> 6), NGW = gridDim.x * 8;
    const float* mod = (const float*)(a.ws() + WS_MOD); bf16* H = (bf16*)(a.ws() + WS_H);
    for (int row = gw; row < MTOK; row += NGW) {
        const float* xr = xrow_in(a, 0, row); const int mr = row < NLAT ? (row >> 12) : 8; const float* mm = mod + (size_t)mr * 6144;
        f32x4 v[4];
#pragma unroll
        for (int j = 0; j < 4; ++j) v[j] = *(const f32x4*)(xr + 4 * lane + 256 * j);
        store_h_row(H + (size_t)row * 1024, v, mm, mm + 1024, lane);
    }
}
__device__ __forceinline__ void phase_scan_prep(const Ctx a, int l) {
    const int tid = otid(), lane = tid & 63;
    const bf16* ZZ = (const bf16*)(a.ws() + WS_ZZ); bf16* XA = (bf16*)(a.ws() + WS_H); float* DT = (float*)(a.ws() + WS_LOGIT); float* ACS = DT + (size_t)MTOK * 16;
    const float* cw = a.in(I_SCW) + (size_t)l * 4 * 1024; const float* cb = a.in(I_SCB) + l * 1024;
    for (int it = blockIdx.x * 512 + tid; it < (MTOK / 4) * 128; it += gridDim.x * 512) {
        const int oc = it & 127, row0 = (it >> 7) * 4, c0 = oc * 8;
        int segbase, Ls; if (row0 < NLAT) { segbase = row0 & ~(SEQ - 1); Ls = SEQ; } else { segbase = NLAT + ((row0 - NLAT) & ~(CTXL - 1)); Ls = CTXL; }
        const int t0 = row0 - segbase;
        float w[4][8], acc[4][8];
#pragma unroll
        for (int j = 0; j < 4; ++j) { const f32x4 w0 = *(const f32x4*)(cw + j * 1024 + c0), w1 = *(const f32x4*)(cw + j * 1024 + c0 + 4);
            w[j][0] = w0[0]; w[j][1] = w0[1]; w[j][2] = w0[2]; w[j][3] = w0[3]; w[j][4] = w1[0]; w[j][5] = w1[1]; w[j][6] = w1[2]; w[j][7] = w1[3]; }
        { const f32x4 b0 = *(const f32x4*)(cb + c0), b1 = *(const f32x4*)(cb + c0 + 4);
#pragma unroll
          for (int o = 0; o < 4; ++o) { acc[o][0] = b0[0]; acc[o][1] = b0[1]; acc[o][2] = b0[2]; acc[o][3] = b0[3]; acc[o][4] = b1[0]; acc[o][5] = b1[1]; acc[o][6] = b1[2]; acc[o][7] = b1[3]; } }
#pragma unroll
        for (int jr = 0; jr < 7; ++jr) { const int t = t0 - 2 + jr;
            if (t >= 0 && t < Ls) { const u32x4 xv = *(const u32x4*)(ZZ + (size_t)(segbase + t) * ZLD + ZC_XBC + c0);
                float x[8]; x[0] = bflo(xv.x); x[1] = bfhi(xv.x); x[2] = bflo(xv.y); x[3] = bfhi(xv.y); x[4] = bflo(xv.z); x[5] = bfhi(xv.z); x[6] = bflo(xv.w); x[7] = bfhi(xv.w);
#pragma unroll
                for (int o = 0; o < 4; ++o) { const int j = jr - o; if (j >= 0 && j < 4) {
#pragma unroll
                    for (int e = 0; e < 8; ++e) acc[o][e] += x[e] * w[j][e]; } } } }
#pragma unroll
        for (int o = 0; o < 4; ++o) { u32x4 ov; ov.x = cvt_pk_bf16(siluf_(acc[o][0]), siluf_(acc[o][1])); ov.y = cvt_pk_bf16(siluf_(acc[o][2]), siluf_(acc[o][3])); ov.z = cvt_pk_bf16(siluf_(acc[o][4]), siluf_(acc[o][5])); ov.w = cvt_pk_bf16(siluf_(acc[o][6]), siluf_(acc[o][7]));
            *(u32x4*)(XA + (size_t)(row0 + o) * 1024 + c0) = ov; }
    }
    for (int blk = blockIdx.x * 8 + (tid >> 6); blk < MTOK / 64; blk += gridDim.x * 8) {
        const int row = blk * 64 + lane;
        const u32x4 r0 = *(const u32x4*)(ZZ + (size_t)row * ZLD + ZC_DT), r1 = *(const u32x4*)(ZZ + (size_t)row * ZLD + ZC_DT + 8);
        float raw[16];
        raw[0] = bflo(r0.x); raw[1] = bfhi(r0.x); raw[2] = bflo(r0.y); raw[3] = bfhi(r0.y); raw[4] = bflo(r0.z); raw[5] = bfhi(r0.z); raw[6] = bflo(r0.w); raw[7] = bfhi(r0.w);
        raw[8] = bflo(r1.x); raw[9] = bfhi(r1.x); raw[10] = bflo(r1.y); raw[11] = bfhi(r1.y); raw[12] = bflo(r1.z); raw[13] = bfhi(r1.z); raw[14] = bflo(r1.w); raw[15] = bfhi(r1.w);
        float dtv[16], acv[16];
#pragma unroll
        for (int c = 0; c < 16; ++c) {
            const float dt = softplusf_(raw[c] + a.in(I_SDTB)[l * 16 + c]); float v = dt * -__expf(a.in(I_SALOG)[l * 16 + c]);
            if (c < 8) {
#pragma unroll
                for (int off = 1; off < 64; off <<= 1) { const float t = __shfl_up(v, off); if (lane >= off) v += t; }
            } else {
#pragma unroll
                for (int off = 1; off < 64; off <<= 1) { const float t = __shfl_down(v, off); if (lane + off < 64) v += t; }
            }
            dtv[c] = dt; acv[c] = v;
        }
#pragma unroll
        for (int c4 = 0; c4 < 4; ++c4) { *(f32x4*)(DT + (size_t)row * 16 + c4 * 4) = (f32x4){dtv[c4 * 4], dtv[c4 * 4 + 1], dtv[c4 * 4 + 2], dtv[c4 * 4 + 3]};
            *(f32x4*)(ACS + (size_t)row * 16 + c4 * 4) = (f32x4){acv[c4 * 4], acv[c4 * 4 + 1], acv[c4 * 4 + 2], acv[c4 * 4 + 3]}; }
    }
}
__device__ __forceinline__ void phase_mixer_finalize(const Ctx a, int l, int nrows, bool dry = false) {
    const int tid_ = otid(); const int lane = tid_ & 63, gw = blockIdx.x * 8 + (tid_ >> 6), NGW = gridDim.x * 8;
    bf16* ZZ = (bf16*)(a.ws() + WS_ZZ); const bf16* SCR = (const bf16*)(a.ws() + WS_ACT); const size_t SS_ = (size_t)MTOK * 512;
    const float* ng = a.in(I_SNG) + l * 512 + 8 * lane;
    const f32x4 g0 = *(const f32x4*)ng, g1 = *(const f32x4*)(ng + 4);
    for (int row = gw; row < nrows; row += NGW) {
        const size_t so = (size_t)row * 512 + 8 * lane;
        const u32x4 h0 = *(const u32x4*)(SCR + so), h1 = *(const u32x4*)(SCR + SS_ + so), y0 = *(const u32x4*)(SCR + 2 * SS_ + so), y1 = *(const u32x4*)(SCR + 3 * SS_ + so);
        bf16* zr = ZZ + (size_t)row * ZLD;
        const u32x4 lg = *(const u32x4*)(zr + ZC_LG + 8 * lane), zz = *(const u32x4*)(zr + ZC_Z + 8 * lane);
        float hb[8], t[8], lgv[8], zv[8];
        hb[0] = bflo(h0.x) + bflo(h1.x); hb[1] = bfhi(h0.x) + bfhi(h1.x); hb[2] = bflo(h0.y) + bflo(h1.y); hb[3] = bfhi(h0.y) + bfhi(h1.y);
        hb[4] = bflo(h0.z) + bflo(h1.z); hb[5] = bfhi(h0.z) + bfhi(h1.z); hb[6] = bflo(h0.w) + bflo(h1.w); hb[7] = bfhi(h0.w) + bfhi(h1.w);
        t[0] = bflo(y0.x) + bflo(y1.x); t[1] = bfhi(y0.x) + bfhi(y1.x); t[2] = bflo(y0.y) + bflo(y1.y); t[3] = bfhi(y0.y) + bfhi(y1.y);
        t[4] = bflo(y0.z) + bflo(y1.z); t[5] = bfhi(y0.z) + bfhi(y1.z); t[6] = bflo(y0.w) + bflo(y1.w); t[7] = bfhi(y0.w) + bfhi(y1.w);
        lgv[0] = bflo(lg.x); lgv[1] = bfhi(lg.x); lgv[2] = bflo(lg.y); lgv[3] = bfhi(lg.y); lgv[4] = bflo(lg.z); lgv[5] = bfhi(lg.z); lgv[6] = bflo(lg.w); lgv[7] = bfhi(lg.w);
        zv[0] = bflo(zz.x); zv[1] = bfhi(zz.x); zv[2] = bflo(zz.y); zv[3] = bfhi(zz.y); zv[4] = bflo(zz.z); zv[5] = bfhi(zz.z); zv[6] = bflo(zz.w); zv[7] = bfhi(zz.w);
        float ss = 0.f;
#pragma unroll
        for (int e = 0; e < 8; ++e) { hb[e] *= gelu_tanh(lgv[e]); t[e] *= siluf_(zv[e]); ss += t[e] * t[e]; }
#pragma unroll
        for (int off = 1; off < 32; off <<= 1) ss += __shfl_xor(ss, off);
        const float ri = __builtin_amdgcn_rsqf(ss * (1.f / 256.f) + RMS_EPS);
        u32x4 wb, wc;
        wb.x = cvt_pk_bf16(hb[0], hb[1]); wb.y = cvt_pk_bf16(hb[2], hb[3]); wb.z = cvt_pk_bf16(hb[4], hb[5]); wb.w = cvt_pk_bf16(hb[6], hb[7]);
        wc.x = cvt_pk_bf16(t[0] * ri * g0[0], t[1] * ri * g0[1]); wc.y = cvt_pk_bf16(t[2] * ri * g0[2], t[3] * ri * g0[3]);
        wc.z = cvt_pk_bf16(t[4] * ri * g1[0], t[5] * ri * g1[1]); wc.w = cvt_pk_bf16(t[6] * ri * g1[2], t[7] * ri * g1[3]);
        if (!dry) { *(u32x4*)(zr + ZC_LG + 8 * lane) = wb; *(u32x4*)(zr + ZC_Z + 8 * lane) = wc; } else asm volatile("" :: "v"(wb), "v"(wc));
    }
}
__device__ __forceinline__ void phase_ln1(const Ctx a, int l, int nrows, bool dry = false) {
    const int tid_ = otid(); const int lane = tid_ & 63, gw = blockIdx.x * 8 + (tid_ >> 6), NGW = gridDim.x * 8;
    const float* mod = (const float*)(a.ws() + WS_MOD) + (size_t)l * 9 * 6144; bf16* H = (bf16*)(a.ws() + WS_H); float* X = (float*)(a.ws() + WS_X); const bf16* ZZ = (const bf16*)(a.ws() + WS_ZZ);
    const float* g = a.in(I_LN1G) + l * 1024; const float* b = a.in(I_LN1B) + l * 1024;
    for (int row = gw; row < nrows; row += NGW) {
        const float* xr = xrow_in(a, l, row); const int mr = row < NLAT ? (row >> 12) : 8; const float* mm = mod + (size_t)mr * 6144;
        const bf16* mx = ZZ + (size_t)row * ZLD + ZC_MIX;
        f32x4 v[4];
#pragma unroll
        for (int j = 0; j < 4; ++j) { const int c = 4 * lane + 256 * j; const f32x4 xv = *(const f32x4*)(xr + c), gt = *(const f32x4*)(mm + 2 * 1024 + c); const u32x2 mw = *(const u32x2*)(mx + c);
            v[j][0] = DN_ALPHA * xv[0] + gt[0] * bflo(mw.x); v[j][1] = DN_ALPHA * xv[1] + gt[1] * bfhi(mw.x); v[j][2] = DN_ALPHA * xv[2] + gt[2] * bflo(mw.y); v[j][3] = DN_ALPHA * xv[3] + gt[3] * bfhi(mw.y); }
        layer_norm_row(v, g, b, lane);
        float* xo = X + (size_t)row * 1024;
#pragma unroll
        for (int j = 0; j < 4; ++j) { if (!dry) *(f32x4*)(xo + 4 * lane + 256 * j) = v[j]; else asm volatile("" :: "v"(v[j])); }
        if (!dry) { bf16* hrow = (bf16*)(a.ws() + WS_ZZ) + (size_t)row * ZLD + ZC_H2; const float* m3 = mm + 3 * 1024; const float* m4 = mm + 4 * 1024;
#pragma unroll
          for (int j = 0; j < 4; ++j) { const int c = 4 * lane + 256 * j; const f32x4 sc = *(const f32x4*)(m4 + c), sh = *(const f32x4*)(m3 + c);
              float hv[4]; unsigned hh[4], hl[4];
#pragma unroll
              for (int e = 0; e < 4; ++e) { hv[e] = v[j][e] * (1.f + sc[e]) + sh[e]; hh[e] = f2bf(hv[e]); hl[e] = f2bf(hv[e] - bf2f(hh[e])); }
              u32x2 w; w.x = hh[0] | (hh[1] << 16); w.y = hh[2] | (hh[3] << 16); *(u32x2*)(hrow + c) = w;
              u32x2 wl; wl.x = hl[0] | (hl[1] << 16); wl.y = hl[2] | (hl[3] << 16); *(u32x2*)(hrow + 1024 + c) = wl; } }
    }
}
__device__ __forceinline__ void phase_ln2(const Ctx a, int l, int nrows, bool dry = false) {
    const int tid_ = otid(); const int lane = tid_ & 63, gw = blockIdx.x * 8 + (tid_ >> 6), NGW = gridDim.x * 8;
    const float* mod = (const float*)(a.ws() + WS_MOD) + (size_t)l * 9 * 6144; const float* modn = (const float*)(a.ws() + WS_MOD) + (size_t)(l + 1) * 9 * 6144;
    bf16* H = (bf16*)(a.ws() + WS_ACT); float* X = (float*)(a.ws() + WS_X); const bf16* YE = (const bf16*)(a.ws() + WS_YE); const int* tslot = (const int*)(a.ws() + WS_TSLOT);
    const float* g = a.in(I_LN2G) + l * 1024; const float* b = a.in(I_LN2B) + l * 1024;
    const bool last = (l == DEPTH - 1);
    for (int row = gw; row < nrows; row += NGW) {
        const int mr = row < NLAT ? (row >> 12) : 8; const float* mm = mod + (size_t)mr * 6144;
        float* xo = X + (size_t)row * 1024;
        f32x4 f[4];
#pragma unroll
        for (int j = 0; j < 4; ++j) f[j] = (f32x4){0.f, 0.f, 0.f, 0.f};
#pragma unroll
        for (int k = 0; k < 8; ++k) { const int slot = tslot[row * 8 + k]; const bf16* yr = YE + (size_t)slot * 1024;
#pragma unroll
            for (int j = 0; j < 4; ++j) { const u32x2 w = *(const u32x2*)(yr + 4 * lane + 256 * j); f[j][0] += bflo(w.x); f[j][1] += bfhi(w.x); f[j][2] += bflo(w.y); f[j][3] += bfhi(w.y); } }
        f32x4 v[4];
#pragma unroll
        for (int j = 0; j < 4; ++j) { const int c = 4 * lane + 256 * j; v[j] = *(const f32x4*)(xo + c) + *(const f32x4*)(mm + 5 * 1024 + c) * f[j]; }
        layer_norm_row(v, g, b, lane);
        if (dry) { asm volatile("" :: "v"(v[0]), "v"(v[1]), "v"(v[2]), "v"(v[3])); continue; }
        if (last) { float* o = a.out() + (size_t)row * 1024;
#pragma unroll
            for (int j = 0; j < 4; ++j) *(f32x4*)(o + 4 * lane + 256 * j) = v[j];
        } else {
#pragma unroll
            for (int j = 0; j < 4; ++j) *(f32x4*)(xo + 4 * lane + 256 * j) = v[j];
            const float* mn = modn + (size_t)mr * 6144;
            store_h_row(H + (size_t)row * 1024, v, mn, mn + 1024, lane);
        }
    }
}

__device__ __forceinline__ void phase_route_a(const Ctx a, int l, int ntok, LAS unsigned* hist) {
    const int tid = otid(), lane = tid & 63, wid = tid >> 6;
    const float* L = (const float*)(a.ws() + WS_LOGIT); int* selE = (int*)(a.ws() + WS_SELE); float* selW = (float*)(a.ws() + WS_SELW); int* selR = (int*)(a.ws() + WS_SELR); int* wgh = (int*)(a.ws() + WS_WGHIST);
    if (tid < 64) hist[tid] = 0u;
    __syncthreads();
    const float bias = a.in(I_RBIAS)[l * 64 + lane];
    const int tpw = (ntok + gridDim.x - 1) / gridDim.x; const int t0 = blockIdx.x * tpw, t1 = min(ntok, t0 + tpw);
    for (int row = t0 + wid; row < t1; row += 8) {
        const float s = sigmoidf_(L[(size_t)row * 64 + lane]); const float sel = s + bias;
        float m1 = sel;
        m1 = fmaxf(m1, __shfl_xor(m1, 1)); m1 = fmaxf(m1, __shfl_xor(m1, 2)); m1 = fmaxf(m1, __shfl_xor(m1, 4));
        const unsigned long long bm = __ballot(sel == m1); const unsigned gbits = (unsigned)((bm >> (lane & ~7)) & 0xffull);
        const int first = (lane & ~7) + (__ffs(gbits) - 1);
        float m2 = (lane == first) ? -INFINITY : sel;
        m2 = fmaxf(m2, __shfl_xor(m2, 1)); m2 = fmaxf(m2, __shfl_xor(m2, 2)); m2 = fmaxf(m2, __shfl_xor(m2, 4));
        const float gs = m1 + m2; const int myg = lane >> 3;
        int grank = 0;
#pragma unroll
        for (int gq = 0; gq < 8; ++gq) { const float o = __builtin_bit_cast(float, __builtin_amdgcn_readlane(__builtin_bit_cast(int, gs), gq * 8)); grank += (o > gs || (o == gs && gq < myg)) ? 1 : 0; }
        const float sel2 = grank < 4 ? sel : -INFINITY;
        int erank = 0;
#pragma unroll 4
        for (int e = 0; e < 64; ++e) { const float o = __builtin_bit_cast(float, __builtin_amdgcn_readlane(__builtin_bit_cast(int, sel2), e)); erank += (o > sel2 || (o == sel2 && e < lane)) ? 1 : 0; }
        const bool chosen = (erank < 8) && (grank < 4);
        const unsigned long long cm = __ballot(chosen);
        const float wsum = wave_sum(chosen ? s : 0.f);
        if (chosen) {
            const int kidx = __popcll(cm & ((1ull << lane) - 1ull));
            const unsigned rk = __hip_atomic_fetch_add(&hist[lane], 1u, __ATOMIC_RELAXED, __HIP_MEMORY_SCOPE_WORKGROUP);
            selE[row * 8 + kidx] = lane; selW[row * 8 + kidx] = s / wsum * 2.5f; selR[row * 8 + kidx] = (int)rk;
        }
    }
    __syncthreads();
    if (tid < 64) wgh[blockIdx.x * 64 + tid] = (int)hist[tid];
}
__device__ __forceinline__ void phase_route_b(const Ctx a, int ntok, LAS int* sm) {
    const int tid = otid(), lane = tid & 63, wid = tid >> 6;
    const int* selE = (const int*)(a.ws() + WS_SELE); const float* selW = (const float*)(a.ws() + WS_SELW); const int* selR = (const int*)(a.ws() + WS_SELR); const int* wgh = (const int*)(a.ws() + WS_WGHIST);
    int* tslot = (int*)(a.ws() + WS_TSLOT); int* rowtok = (int*)(a.ws() + WS_ROWTOK); float* roww = (float*)(a.ws() + WS_ROWW); int* tileE = (int*)(a.ws() + WS_TILEE); int* ntiles = (int*)(a.ws() + WS_NTILES);
    LAS int* OFF = sm; LAS int* CNT = sm + 64; LAS int* PST = sm + 128; LAS int* PEN = sm + 192;
    if (wid == 0) {
        int cnt = 0, base = 0;
        for (int w = 0; w < (int)gridDim.x; ++w) { const int v = wgh[w * 64 + lane]; cnt += v; if (w < (int)blockIdx.x) base += v; }
        const int padded = (cnt + 255) & ~255; int inc = padded;
#pragma unroll
        for (int off = 1; off < 64; off <<= 1) { const int t = __shfl_up(inc, off); if (lane >= off) inc += t; }
        OFF[lane] = inc - padded + base; CNT[lane] = cnt; PST[lane] = inc - padded; PEN[lane] = inc;
    }
    __syncthreads();
    const int tpw = (ntok + gridDim.x - 1) / gridDim.x; const int t0 = blockIdx.x * tpw, t1 = min(ntok, t0 + tpw);
    for (int i = t0 * 8 + tid; i < t1 * 8; i += 512) { const int e = selE[i]; const int slot = OFF[e] + selR[i]; tslot[i] = slot; rowtok[slot] = i >> 3; roww[slot] = selW[i]; }
    for (int e = blockIdx.x; e < 64; e += gridDim.x) {
        const int ps = PST[e], pe = PEN[e], cn = CNT[e];
        for (int i = ps + cn + tid; i < pe; i += 512) { rowtok[i] = 0; roww[i] = 0.f; }
        for (int t = (ps >> 8) + tid; t < (pe >> 8); t += 512) tileE[t] = e;
    }
    if (blockIdx.x == 0 && tid == 0) *ntiles = PEN[63] >> 8;
}

#ifndef MK_PER_PHASE
#define MK_PER_PHASE 0
#endif
constexpr int NPHASE = 2 + 13 * DEPTH;

__global__ void __launch_bounds__(512, 2) mega_fwd(Args ka) {
    LAS unsigned char* lds = (LAS unsigned char*)lds_raw;
    volatile LAS unsigned* MISC = (volatile LAS unsigned*)(lds + MISC_OFF);
    { const int t0_ = threadIdx.x; const unsigned key_ = (unsigned)__builtin_amdgcn_s_getreg(((6 - 1) << 11) | 4) & 63u;
      if ((t0_ & 63) == 0) *(volatile LAS unsigned*)(lds + WVTAB_OFF + key_ * 4) = (unsigned)(t0_ >> 6);
      if (t0_ < 74) ((LAS unsigned*)(lds + CTX_OFF))[t0_] = ((const unsigned*)&ka)[t0_];
      if (t0_ < 32) ((volatile LAS unsigned*)(lds + MISC_OFF))[t0_] = 0u; }
    __syncthreads();
    const int G = gridDim.x;
    unsigned* ctl = (unsigned*)(ka.ws + WS_CTL);
    const Ctx a;
    const int lo = ka.ph_lo, hi = ka.ph_hi;
    XcdBarrier bar; bar.bar = ctl + CW_BAR; bar.x = 0; bar.st = nullptr;
    if (hi - lo > 1) bar = xcd_barrier_post(ctl + CW_BAR, MISC + 8);
#ifndef MK_ONLY
#define MK_ONLY -1
#endif
#define SELP(k) ((MK_ONLY) < 0 || (MK_ONLY) == (k))
#ifndef MK_DUP
#define MK_DUP -1
#endif
#define REP(k) for (int rep_ = 0; rep_ < ((MK_DUP) == (k) ? 2 : 1); ++rep_)
#define IN(k) (lo <= (k) && (k) < hi)
#define SEAM(k) do { if (IN(k) && IN((k) + 1)) { xcd_barrier(bar); if ((MK_DUP) == 200) xcd_barrier(bar); } } while (0)
#define WSP (a.ws())
#define ZZP ((bf16*)(a.ws() + WS_ZZ))
#define HP ((bf16*)(a.ws() + WS_H))
#define XP ((float*)(a.ws() + WS_X))
#define WP (a.ws() + WS_W)

    if (SELP(0) && IN(0)) { phase_mod_rope(a, (LAS float*)lds); }
    SEAM(0);
    if (SELP(1) && IN(1)) { REP(1) convert_layer_weights(a, 0, (LAS float*)lds); REP(100) phase_modulate0(a); }
    SEAM(1);

    for (int l = 0; l < DEPTH; ++l) {
        const int pb = 2 + 13 * l;
        const bool last = (l == DEPTH - 1);
        const int nrows = last ? NLAT : MTOK;
        const int ntile = nrows / 256;
        const float* modl = (const float*)(WSP + WS_MOD) + (size_t)l * 9 * 6144;

        if (SELP(2) && IN(pb + 0)) REP(2) {
            const bf16* Hin = (l == 0) ? HP : (const bf16*)(WSP + WS_ACT);
            GeoPlain g{Hin, (const bf16*)(WP + W_IN), 1024, 1024, 1024};
            pg8::StaticOrder S; S.init(MTOK / 256, ZLD / 256, G, (int)blockIdx.x);
            EpiInProj E{ZZP, (const float*)(WSP + WS_ROPE), (const float*)(WSP + WS_ROPE) + 4096 * 32};
            pg8::gemm_phase(lds, g, S, E);
        }
        SEAM(pb + 0);

        if (SELP(14) && IN(pb + 1)) REP(14) { phase_scan_prep(a, l); }
        SEAM(pb + 1);

        if (SELP(3) && IN(pb + 2)) {
            unsigned* qhead = ctl + CW_QUEUE + 64 * l;
            const int nunits = 256 + 1024 + (last ? 0 : 64);
            const float lam_init = 0.8f - 0.6f * __expf(-0.3f * (float)l);
            bf16* SCR = (bf16*)(WSP + WS_ACT);
#ifndef MK_UNIT
#define MK_UNIT 7
#endif
#define NEXT_UNIT() do { __syncthreads(); if (otid() == 0) MISC[0] = atomicAdd(qhead, 1u); __syncthreads(); uid = (int)MISC[0]; } while (0)
            int uid; NEXT_UNIT();
            while ((MK_UNIT & 1) && uid < 128) {
                const int b = uid >> 4, h = (uid >> 1) & 7, d = uid & 1;
                ssd::Par P; P.XA = (const bf16*)(WSP + WS_H); P.DT = (const float*)(WSP + WS_LOGIT); P.ACS = (const float*)(WSP + WS_LOGIT) + (size_t)MTOK * 16; P.Y = SCR + (size_t)(2 + d) * MTOK * 512;
                P.Dskip = a.in(I_SD)[l * 8 + h]; P.b = b; P.h = h; P.d = d;
                REP(30) ssd::unit(P);
                NEXT_UNIT();
            }
            while ((MK_UNIT & 2) && uid < 256) {
                const int u = uid - 128; const int b = u >> 4, n = (u >> 1) & 7, d = u & 1;
                lru::Par P; P.ZZ = ZZP; P.Hout = SCR + (size_t)d * MTOK * 512; P.conv_w = a.in(I_LCW) + (size_t)l * 4 * 512; P.conv_b = a.in(I_LCB) + l * 512;
                P.wa = a.in(I_LWA) + (size_t)((l * 2 + d) * 8 + n) * 4096; P.wi = a.in(I_LWI) + (size_t)((l * 2 + d) * 8 + n) * 4096;
                P.ba = a.in(I_LBA) + (l * 2 + d) * 512; P.bi = a.in(I_LBI) + (l * 2 + d) * 512; P.lam = a.in(I_LLAM) + (l * 2 + d) * 512; P.b = b; P.n = n; P.d = d;
                REP(31) lru::unit(P);
                NEXT_UNIT();
            }
            if (MK_UNIT & 4) {
                float d0 = 0.f, d1 = 0.f;
                for (int i = 0; i < 64; ++i) { d0 += a.in(I_LAMQ)[(l * 2 + 0) * 64 + i] * a.in(I_LAMK)[(l * 2 + 0) * 64 + i]; d1 += a.in(I_LAMQ)[(l * 2 + 1) * 64 + i] * a.in(I_LAMK)[(l * 2 + 1) * 64 + i]; }
                const float lam = __expf(d0) - __expf(d1) + lam_init;
                while (uid < nunits) {
                    int qrow0, h, krowA, ntA, krowB, NT;
                    if (uid < 1280) { const int u = uid - 256; const int b = u >> 7; h = (u >> 5) & 3; const int qb = u & 31; qrow0 = b * SEQ + qb * 128; krowA = b * SEQ; ntA = 64; krowB = NLAT + b * CTXL; NT = 68; }
                    else { const int u = uid - 1280; const int b = u >> 3; h = (u >> 1) & 3; const int cq = u & 1; qrow0 = NLAT + b * CTXL + cq * 128; krowA = NLAT + b * CTXL; ntA = 4; krowB = krowA; NT = 4; }
                    if ((MK_DUP) == 32) { att::attn_unit(ZZP, qrow0, h, krowA, ntA, krowB, NT, lam, a.in(I_ATTNG) + (size_t)(l * 4 + h) * 128, 1.0f - lam_init, false); __syncthreads(); }
                    att::attn_unit(ZZP, qrow0, h, krowA, ntA, krowB, NT, lam, a.in(I_ATTNG) + (size_t)(l * 4 + h) * 128, 1.0f - lam_init, true);
                    NEXT_UNIT();
                }
            }
#undef NEXT_UNIT
        }
        SEAM(pb + 2);

        if (SELP(4) && IN(pb + 3)) { if ((MK_DUP) == 4) phase_mixer_finalize(a, l, nrows, true); phase_mixer_finalize(a, l, nrows); }
        SEAM(pb + 3);

        if (SELP(5) && IN(pb + 4)) {
            GeoMergeA g{ZZP, (const bf16*)(WP + W_BR), 512, ZLD, 512};
            MergeOrder S; S.init(ntile, G, (int)blockIdx.x);
            if ((MK_DUP) == 5) { EpiMergeDiv E0{ZZP, true}; pg8::gemm_phase(lds, g, S, E0); }
            EpiMergeDiv E{ZZP, false};
            pg8::gemm_phase(lds, g, S, E);
        }
        SEAM(pb + 4);

        if (SELP(6) && IN(pb + 5)) REP(6) {
            GeoPlain g{ZZP + ZC_MRG, (const bf16*)(WP + W_OUT), 1024, ZLD, 1024};
            pg8::StaticOrder S; S.init(ntile, 4, G, (int)blockIdx.x);
            EpiBf16Plain E{ZZP + ZC_MIX, ZLD};
            pg8::gemm_phase(lds, g, S, E);
        }
        SEAM(pb + 5);

        if (SELP(7) && IN(pb + 6)) { if ((MK_DUP) == 7) phase_ln1(a, l, nrows, true); phase_ln1(a, l, nrows); }
        SEAM(pb + 6);

        if (SELP(8) && IN(pb + 7)) {
            REP(80) { GeoPlain g{ZZP + ZC_H2, (const bf16*)(WP + W_SU), 1024, ZLD, 1024};
              pg8::StaticOrder S; S.init(ntile, 2, G, (int)blockIdx.x);
              EpiSwiGLU<false> E{(bf16*)(WSP + WS_ACTS), nullptr};
              pg8::gemm_phase(lds, g, S, E); }
            REP(81) { GeoPlain g{ZZP + ZC_H2, (const bf16*)(WP + W_RT), 2048, ZLD, 2048};
              pg8::StaticOrder S; S.init(ntile, 1, G, (int)((blockIdx.x + 128) % G));
              EpiRouter E{(float*)(WSP + WS_LOGIT)};
              pg8::gemm_phase(lds, g, S, E); }
        }
        SEAM(pb + 7);

        if (SELP(9) && IN(pb + 8)) REP(9) { phase_route_a(a, l, nrows, (LAS unsigned*)lds); __syncthreads(); }
        SEAM(pb + 8);
        if (SELP(10) && IN(pb + 9)) REP(10) { phase_route_b(a, nrows, (LAS int*)lds); __syncthreads(); }
        SEAM(pb + 9);

        if (SELP(11) && IN(pb + 10)) REP(11) {
            const int nt_ = __builtin_amdgcn_readfirstlane(*(const int*)(WSP + WS_NTILES));
            GeoMoeUp g{ZZP + ZC_H2, (const bf16*)(WP + W_UP), (const int*)(WSP + WS_ROWTOK), (const int*)(WSP + WS_TILEE), 1024, ZLD, 1024};
            pg8::StaticOrder S; S.init(nt_, 2, G, (int)blockIdx.x);
            EpiSwiGLU<true> E{(bf16*)(WSP + WS_ACT), (const float*)(WSP + WS_ROWW)};
            pg8::gemm_phase(lds, g, S, E);
        }
        SEAM(pb + 10);

        if (SELP(12) && IN(pb + 11)) {
            REP(12) { const int nt_ = __builtin_amdgcn_readfirstlane(*(const int*)(WSP + WS_NTILES));
              GeoMoeDown g{(const bf16*)(WSP + WS_ACT), (const bf16*)(WP + W_DN), (const int*)(WSP + WS_TILEE), 256, 256, 256};
              pg8::StaticOrder S; S.init(nt_, 4, G, (int)blockIdx.x);
              EpiBf16Plain E{(bf16*)(WSP + WS_YE), 1024};
              pg8::gemm_phase(lds, g, S, E); }
            { GeoPlain g{(const bf16*)(WSP + WS_ACTS), (const bf16*)(WP + W_SD), 256, 256, 256};
              pg8::StaticOrder S; S.init(ntile, 4, G, (int)blockIdx.x);
              if ((MK_DUP) == 120) { EpiSharedDown E0{XP, modl, true}; pg8::gemm_phase(lds, g, S, E0); }
              EpiSharedDown E{XP, modl, false};
              pg8::gemm_phase(lds, g, S, E); }
        }
        SEAM(pb + 11);

        if (SELP(13) && IN(pb + 12)) {
            if ((MK_DUP) == 13) phase_ln2(a, l, nrows, true);
            phase_ln2(a, l, nrows);
            if (!last) { __syncthreads(); convert_layer_weights(a, l + 1, (LAS float*)lds); }
        }
        SEAM(pb + 12);
    }
#undef IN
#undef SEAM
#undef WSP
#undef ZZP
#undef HP
#undef XP
#undef WP
}

extern "C" void kernel_launch(void* const* d_in, const int* in_sizes, int n_in, void* d_out, int out_size, void* d_ws, size_t ws_size, hipStream_t stream) {
    static int grid = 0;
    if (grid == 0) {
        if (n_in != 35 || in_sizes[0] != NLAT * DM || out_size != NLAT * DM || ws_size < WS_END) {
            fprintf(stderr, "kernel_launch: shape/workspace mismatch: n_in %d in0 %d out %d ws %zu (need %zu)\n", n_in, n_in > 0 ? in_sizes[0] : -1, out_size, ws_size, (size_t)WS_END); grid = -1; return; }
        int dev = 0, cus = 0, per_cu = 0;
        if (hipGetDevice(&dev) != hipSuccess || hipDeviceGetAttribute(&cus, hipDeviceAttributeMultiprocessorCount, dev) != hipSuccess) { fprintf(stderr, "kernel_launch: device query failed\n"); grid = -1; return; }
        if (hipFuncSetAttribute((const void*)mega_fwd, hipFuncAttributeMaxDynamicSharedMemorySize, LDS_BYTES) != hipSuccess) { fprintf(stderr, "kernel_launch: hipFuncSetAttribute failed\n"); grid = -1; return; }
        if (hipOccupancyMaxActiveBlocksPerMultiprocessor(&per_cu, (const void*)mega_fwd, 512, LDS_BYTES) != hipSuccess || per_cu < 1) fprintf(stderr, "kernel_launch: occupancy query reports %d\n", per_cu);
        (void)hipGetLastError();
        grid = cus;
    }
    if (grid < 0) return;
    if (hipMemsetAsync((char*)d_ws + WS_CTL, 0, CTL_ZERO_BYTES, stream) != hipSuccess) { fprintf(stderr, "kernel_launch: memset failed\n"); return; }
    Args a{};
    for (int i = 0; i < 35; ++i) a.in[i] = (const float*)d_in[i];
    a.out = (float*)d_out; a.ws = (unsigned char*)d_ws;
#if MK_PER_PHASE
    for (int p = 0; p < NPHASE; ++p) { a.ph_lo = p; a.ph_hi = p + 1; hipLaunchKernelGGL(mega_fwd, dim3(grid), dim3(512), LDS_BYTES, stream, a); }
#else
    a.ph_lo = 0; a.ph_hi = NPHASE;
    hipLaunchKernelGGL(mega_fwd, dim3(grid), dim3(512), LDS_BYTES, stream, a);
#endif
    const hipError_t le = hipPeekAtLastError();
    if (le != hipSuccess) fprintf(stderr, "kernel_launch: launch failed: %s\n", hipGetErrorName(le));
}
```

```cpp
#include <hip/hip_runtime.h>
#include <cstdio>
#include <cstdint>

#define GAS __attribute__((address_space(1)))
#define LAS __attribute__((address_space(3)))
typedef unsigned short bf16;
typedef short bf16x8 __attribute__((ext_vector_type(8)));
typedef short s16x4 __attribute__((ext_vector_type(4)));
typedef float f32x2 __attribute__((ext_vector_type(2)));
typedef float f32x4 __attribute__((ext_vector_type(4)));
typedef float f32x16 __attribute__((ext_vector_type(16)));
typedef unsigned u32x2 __attribute__((ext_vector_type(2)));
typedef unsigned u32x4 __attribute__((ext_vector_type(4)));

constexpr int DM = 1024, NBATCH = 8, SEQ = 4096, CTXL = 256, DEPTH = 2;
constexpr int NLAT = NBATCH * SEQ, NCTX = NBATCH * CTXL, MTOK = NLAT + NCTX;
constexpr int IN_TOTAL = 7184, ZLD = 7424;
constexpr int ZC_Q = 0, ZC_K = 512, ZC_V = 1024, ZC_LX = 1536, ZC_LG = 2048, ZC_Z = 2560, ZC_XBC = 3072, ZC_GATE = 4096, ZC_DT = 7168;
constexpr int ZC_MRG = 512;
constexpr int ZC_MIX = 1536;
constexpr int NEXP = 64, TOPK = 8, EXPF = 256;
constexpr int PMAX_TILES = 1152, PMAX = PMAX_TILES * 256;
constexpr float DN_ALPHA = 1.41421356237309515f;
constexpr float LN_EPS = 1e-5f, RMS_EPS = 1e-6f;

constexpr size_t MiB = 1u << 20;
constexpr size_t WS_CTL = 0, CTL_ZERO_BYTES = 1 * MiB;
constexpr size_t WS_MOD = 1 * MiB;
constexpr size_t WS_ROPE = 2 * MiB;
constexpr size_t WS_LOGIT = 4 * MiB;
constexpr size_t WS_ACTS = 13 * MiB;
constexpr size_t WS_SELE = 30 * MiB;
constexpr size_t WS_SELW = 32 * MiB;
constexpr size_t WS_SELR = 34 * MiB;
constexpr size_t WS_TSLOT = 36 * MiB;
constexpr size_t WS_ROWTOK = 38 * MiB;
constexpr size_t WS_ROWW = 40 * MiB;
constexpr size_t WS_WGHIST = 42 * MiB;
constexpr size_t WS_TILEE = 42 * MiB + 65536;
constexpr size_t WS_NTILES = 42 * MiB + 131072;
constexpr size_t WS_W = 44 * MiB;
constexpr size_t W_IN = 0;
constexpr size_t W_BR = W_IN + (size_t)ZLD * 1024 * 2;
constexpr size_t W_OUT = W_BR + (size_t)3072 * 512 * 2;
constexpr size_t W_RT = W_OUT + (size_t)1024 * 1024 * 2;
constexpr size_t W_SU = W_RT + (size_t)256 * 2048 * 2;
constexpr size_t W_SD = W_SU + (size_t)512 * 1024 * 2;
constexpr size_t W_UP = W_SD + (size_t)1024 * 256 * 2;
constexpr size_t W_DN = W_UP + (size_t)64 * 512 * 1024 * 2;
constexpr size_t W_END = W_DN + (size_t)64 * 1024 * 256 * 2;
static_assert(W_END <= 122 * MiB, "weights");
constexpr int ZC_H2 = 4096;
constexpr size_t WS_X = 166 * MiB;
constexpr size_t WS_ACT = 302 * MiB;
constexpr size_t WS_H = 446 * MiB;
constexpr size_t WS_ZZ = 514 * MiB;
constexpr size_t WS_YE = WS_H;
constexpr size_t WS_END = 1022 * MiB;
static_assert(WS_X + (size_t)MTOK * 1024 * 4 <= WS_ACT && WS_ACT + (size_t)PMAX * 256 * 2 <= WS_H && WS_H + (size_t)MTOK * 1024 * 2 <= WS_ZZ, "ws map 1");
static_assert(WS_ZZ + (size_t)MTOK * ZLD * 2 <= WS_END && WS_YE + (size_t)PMAX * 1024 * 2 <= WS_END, "ws map 2");
constexpr size_t SCR_STRIDE = (size_t)MTOK * 512 * 2;
static_assert(4 * SCR_STRIDE <= (size_t)PMAX * 256 * 2, "scan scratch fits the act region");
constexpr int CW_BAR = 4096;
constexpr int CW_QUEUE = 16384;

constexpr int LDS_BYTES = 147456;
constexpr int MISC_OFF = 131072 + 320;

#define LDS_WAIT() asm volatile("s_waitcnt lgkmcnt(0)" ::: "memory")
#define VM_WAIT() asm volatile("s_waitcnt vmcnt(0)" ::: "memory")
__device__ __forceinline__ unsigned f2bf(float f) { unsigned u = __builtin_bit_cast(unsigned, f); return (u + 0x7fffu + ((u >> 16) & 1u)) >> 16; }
__device__ __forceinline__ float bf2f(unsigned h) { return __builtin_bit_cast(float, h << 16); }
__device__ __forceinline__ unsigned cvt_pk_bf16(float lo, float hi) { unsigned r; asm volatile("v_cvt_pk_bf16_f32 %0, %1, %2" : "=v"(r) : "v"(lo), "v"(hi)); return r; }
__device__ __forceinline__ float bflo(unsigned w) { return __builtin_bit_cast(float, w << 16); }
__device__ __forceinline__ float bfhi(unsigned w) { return __builtin_bit_cast(float, w & 0xffff0000u); }
__device__ __forceinline__ float fexp(float x) { return __builtin_amdgcn_exp2f(x * 1.4426950408889634f); }
__device__ __forceinline__ float sigmoidf_(float x) { return __builtin_amdgcn_rcpf(1.0f + fexp(-x)); }
__device__ __forceinline__ float siluf_(float x) { return x * sigmoidf_(x); }
__device__ __forceinline__ float softplusf_(float x) { const float e = fexp(-fabsf(x)); const float lp = e < 1e-3f ? e * (1.f - 0.5f * e + 0.33333333f * e * e) : __builtin_amdgcn_logf(1.f + e) * 0.6931471805599453f; return fmaxf(x, 0.f) + lp; }
__device__ __forceinline__ float gelu_tanh(float x) { const float u = 0.7978845608028654f * (x + 0.044715f * x * x * x); const float e = fexp(2.f * u); const float th = 1.f - 2.f * __builtin_amdgcn_rcpf(e + 1.f); return 0.5f * x * (1.f + th); }
__device__ __forceinline__ float wave_sum(float v) {
#pragma unroll
    for (int o = 1; o < 64; o <<= 1) v += __shfl_xor(v, o);
    return v;
}

template <class T> __device__ __forceinline__ T* uni(T* p) { const unsigned long long v = (unsigned long long)p; const unsigned lo = __builtin_amdgcn_readfirstlane((unsigned)v), hi = __builtin_amdgcn_readfirstlane((unsigned)(v >> 32)); return (T*)(GAS T*)(((unsigned long long)hi << 32) | lo); }
__device__ __forceinline__ int uni(int v) { return __builtin_amdgcn_readfirstlane(v); }
__device__ __forceinline__ float uni(float v) { return __builtin_bit_cast(float, __builtin_amdgcn_readfirstlane(__builtin_bit_cast(int, v))); }
extern __shared__ __attribute__((aligned(16))) unsigned char lds_raw[];
constexpr int WVTAB_OFF = 131072 + 320 + 128 + 320;
__device__ __forceinline__ int otid() {
    const unsigned key = (unsigned)__builtin_amdgcn_s_getreg(((6 - 1) << 11) | 4) & 63u;
    int off_ = WVTAB_OFF + (int)key * 4; asm volatile("" : "+v"(off_));
    const unsigned wv = (unsigned)__builtin_amdgcn_readfirstlane((int)*(const volatile LAS unsigned*)((LAS unsigned char*)lds_raw + off_));
    unsigned z = 0u; asm volatile("" : "+v"(z));
    const unsigned ln = __builtin_amdgcn_mbcnt_hi(~0u, __builtin_amdgcn_mbcnt_lo(~0u, z));
    int t = (int)(wv * 64u + ln); asm volatile("" : "+v"(t)); return t;
}
__device__ __forceinline__ LAS unsigned char* olds() { unsigned b = 0u; asm volatile("" : "+s"(b)); return (LAS unsigned char*)lds_raw + b; }
__device__ __forceinline__ int osg(int v) { asm volatile("" : "+s"(v)); return v; }

#define XB_TMO      128
#define XB_XCNT(j)  (256  + 64 * (j))
#define XB_XSUB(j)  (1280 + 64 * (j))
#define XB_XGEN(j)  (2304 + 64 * (j))
#define XB_TOP      3328
#define XB_TOPGEN   3392
#define XCD_BAR_WORDS 3456
#define XB_SPIN_CAP (1u << 20)
__device__ __forceinline__ unsigned xb_ld(unsigned* p)              { return __hip_atomic_load(p, __ATOMIC_RELAXED, __HIP_MEMORY_SCOPE_AGENT); }
__device__ __forceinline__ unsigned xb_add(unsigned* p, unsigned v) { return __hip_atomic_fetch_add(p, v, __ATOMIC_RELAXED, __HIP_MEMORY_SCOPE_AGENT); }
__device__ __forceinline__ unsigned xb_xcc_id() { return (unsigned)__builtin_amdgcn_s_getreg((3 << 11) | 20) & 0xFu; }
#define XB_SPIN(cond, bar) do { unsigned _sp = 0; while (cond) { __builtin_amdgcn_s_sleep(1); \
    if ((++_sp & 255u) == 0u) { if (xb_ld(&(bar)[XB_TMO])) break; if (_sp > XB_SPIN_CAP) { atomicAdd(&(bar)[XB_TMO], 1u); break; } } } } while (0)
struct XcdBarrier { unsigned* bar; unsigned x; volatile LAS unsigned* st; };
__device__ __forceinline__ XcdBarrier xcd_barrier_post(unsigned* bar, volatile LAS unsigned* st) {
    XcdBarrier b; b.bar = bar; b.x = xb_xcc_id(); b.st = st;
    if (otid() == 0) (void)xb_add(&bar[XB_XCNT(b.x)], 1u);
    return b;
}
__device__ __forceinline__ void xcd_barrier_complete(unsigned* bar, unsigned x, unsigned& nloc, unsigned& nx) {
    const unsigned G = gridDim.x * gridDim.y * gridDim.z;
    unsigned sum, cnt, mine, sp = 0u;
    for (;;) {
        sum = 0u; cnt = 0u; mine = 0u;
#pragma unroll
        for (unsigned j = 0; j < 16; ++j) { const unsigned c = xb_ld(&bar[XB_XCNT(j)]); sum += c; cnt += (c > 0u) ? 1u : 0u; mine = (j == x) ? c : mine; }
        if (sum == G) break;
        __builtin_amdgcn_s_sleep(1);
        if ((++sp & 255u) == 0u) { if (xb_ld(&bar[XB_TMO])) break; if (sp > XB_SPIN_CAP) { atomicAdd(&bar[XB_TMO], 1u); break; } }
    }
    nloc = mine > 0u ? mine : 1u; nx = cnt > 0u ? cnt : 1u;
}
__device__ __forceinline__ void xcd_barrier(const XcdBarrier& b) {
    asm volatile("s_waitcnt vmcnt(0)" ::: "memory");
    __syncthreads();
    if (otid() == 0) {
        unsigned* bar = b.bar;
        __builtin_amdgcn_s_waitcnt(0);
        unsigned nloc = b.st[0], nx = b.st[1];
        if (nloc == 0u) { xcd_barrier_complete(bar, b.x, nloc, nx); b.st[0] = nloc; b.st[1] = nx; }
        const unsigned old = xb_add(&bar[XB_XSUB(b.x)], 1u);
        const unsigned gen = old / nloc;
        if (old + 1u == (gen + 1u) * nloc) {
            __builtin_amdgcn_fence(__ATOMIC_RELEASE, "agent");
            asm volatile("s_waitcnt vmcnt(0)" ::: "memory");
            const unsigned og = xb_add(&bar[XB_TOP], 1u);
            const unsigned tg = og / nx;
            if (og + 1u == (tg + 1u) * nx) xb_add(&bar[XB_TOPGEN], 1u);
            else XB_SPIN(xb_ld(&bar[XB_TOPGEN]) == tg, bar);
            __builtin_amdgcn_fence(__ATOMIC_ACQUIRE, "agent");
            xb_add(&bar[XB_XGEN(b.x)], 1u);
            asm volatile("s_waitcnt vmcnt(0)" ::: "memory");
        } else {
            XB_SPIN(xb_ld(&bar[XB_XGEN(b.x)]) == gen, bar);
            __builtin_amdgcn_fence(__ATOMIC_ACQUIRE, "agent");
            asm volatile("s_waitcnt vmcnt(0)" ::: "memory");
        }
    }
    __syncthreads();
}

namespace pg8 {
constexpr int BM = 256, BK = 64, HALF = 128, HTB = HALF * BK * 2, STAGE_BYTES = 8 * HTB, NXCD = 8, WGM = 8;
__host__ __device__ __forceinline__ int lds_byte(int r, int c) { const int st = (r >> 4) * 2 + (c >> 5), rr = r & 15, cc = c & 31, ob = rr * 64 + cc * 2; return st * 1024 + (ob ^ (((ob >> 9) & 1) << 5)); }
__host__ __device__ __forceinline__ void stage_rc(int b, int& R, int& C) { const int st = b / 1024, sb = b % 1024, swz = sb ^ (((sb >> 9) & 1) << 5); R = (st >> 1) * 16 + swz / 64; C = (st & 1) * 32 + (swz % 64) / 2; }
__host__ __device__ __forceinline__ int perm32(int rho) { const int n = rho >> 4, i = rho & 15; return 8 * (i >> 2) + 4 * n + (i & 3); }
struct Unit { int pm, pn; };
struct StaticOrder {
    int nM, nN, nwg, G, c;
    __device__ void init(int nM_, int nN_, int G_, int c_) { nM = nM_; nN = nN_; nwg = nM * nN; G = G_; c = c_; }
    __device__ bool next(int i, Unit& u) const {
        const long L = (long)i * G + c; if (L >= nwg) return false;
        int wgid = (int)L; { const int q = nwg / NXCD, r = nwg % NXCD, xcd = wgid % NXCD, off = wgid / NXCD; wgid = (xcd < r ? xcd * (q + 1) : r * (q + 1) + (xcd - r) * q) + off; }
        const int nig = WGM * nN, gid = wgid / nig, fm = gid * WGM, gsz = (nM - fm) < WGM ? (nM - fm) : WGM;
        u.pm = __builtin_amdgcn_readfirstlane(fm + ((wgid % nig) % gsz)); u.pn = __builtin_amdgcn_readfirstlane((wgid % nig) / gsz); return true;
    }
};
struct RowOrder {
    int nM, nN, G, c;
    __device__ void init(int nM_, int nN_, int G_, int c_) { nM = nM_; nN = nN_; G = G_; c = c_; }
    __device__ bool next(int i, Unit& u) const { const int j = i / nN; const long L = (long)j * G + c; if (L >= nM) return false; u.pm = __builtin_amdgcn_readfirstlane((int)L); u.pn = __builtin_amdgcn_readfirstlane(i - j * nN); return true; }
};
template <class Geo, class Epi, class Sched>
__device__ __forceinline__ void gemm_phase(LAS unsigned char* lds, const Geo& g, const Sched& S, const Epi& E) {
    const int tid = otid(), wid = __builtin_amdgcn_readfirstlane(tid >> 6), lane = tid & 63, wr = wid >> 2, wc = wid & 3, fr = lane & 15, fq = lane >> 4;
    const int K = g.K, nt = K / BK;
    constexpr int NE = Epi::SEAM_VM;
    int Rs[2], Cs[2];
    unsigned voffB[2], vC[2][2];
#pragma unroll
    for (int i = 0; i < 2; ++i) { stage_rc(tid * 16 + i * 8192, Rs[i], Cs[i]); const int Rb = Epi::PERM ? ((Rs[i] & ~31) + perm32(Rs[i] & 31)) : Rs[i];
        voffB[i] = (unsigned)(Rb * g.ldb + Cs[i]) * 2u; }
    const size_t kstep = (size_t)(BK * 2);
    const size_t hstepB = (size_t)HALF * g.ldb * 2;
    const unsigned ldsw = (unsigned)wid * 1024u;
    const int aoff = lds_byte(wr * 64 + fr, fq * 8), boff = lds_byte(wc * 32 + fr, fq * 8);
#define PG8_SA(b, h) (((b) * 2 + (h)) * HTB)
#define PG8_SB(b, h) ((4 + (b) * 2 + (h)) * HTB)
#define PG8_STAGE(bufoff, gbase, voff) do { _Pragma("unroll") for (int _i = 0; _i < 2; ++_i) \
        __builtin_amdgcn_global_load_lds((const unsigned*)((const char*)(gbase) + (voff)[_i]), (LAS unsigned*)(lds + (bufoff) + ldsw + _i * 8192), 16, 0, 0); } while (0)
#define PG8_LDA(dst, b, h) do { _Pragma("unroll") for (int m = 0; m < 4; ++m) _Pragma("unroll") for (int k = 0; k < 2; ++k) dst[m][k] = *(const LAS bf16x8*)(lds + PG8_SA(b, h) + aoff + m * 2048 + k * 1024); } while (0)
#define PG8_LDB(dst, b, h) do { _Pragma("unroll") for (int n = 0; n < 2; ++n) _Pragma("unroll") for (int k = 0; k < 2; ++k) dst[n][k] = *(const LAS bf16x8*)(lds + PG8_SB(b, h) + boff + n * 2048 + k * 1024); } while (0)
#define PG8_MMA(ai, bj, At, Bt) do { __builtin_amdgcn_s_setprio(1); _Pragma("unroll") for (int m = 0; m < 4; ++m) _Pragma("unroll") for (int n = 0; n < 2; ++n) _Pragma("unroll") for (int k = 0; k < 2; ++k) \
        acc[ai][bj][m][n] = __builtin_amdgcn_mfma_f32_16x16x32_bf16(Bt[n][k], At[m][k], acc[ai][bj][m][n], 0, 0, 0); __builtin_amdgcn_s_setprio(0); } while (0)
#define PG8_WAIT_V(n) asm volatile("s_waitcnt vmcnt(" #n ")" ::: "memory")
#define PG8_WAIT_L(n) asm volatile("s_waitcnt lgkmcnt(" #n ")" ::: "memory")
#define PG8_WAIT_R() do { if (NE > 0) { int _scc; asm volatile("s_cselect_b32 %0, 1, 0\n\ts_waitcnt vmcnt(%1)\n\ts_cmp_eq_u32 %2, 0\n\ts_cbranch_scc0 2f\n\ts_cmp_lg_u32 %3, 0\n\ts_cbranch_scc1 1f\n2:\ts_waitcnt vmcnt(8)\n1:\ts_cmp_lg_u32 %0, 0" : "=&s"(_scc) : "n"(10 + NE), "s"(t), "s"(ui) : "memory"); } else PG8_WAIT_V(8); } while (0)
#define PG8_BAR __builtin_amdgcn_s_barrier()
#define PG8_SCHED __builtin_amdgcn_sched_barrier(0)
#define PG8_SETV(v, u) do { _Pragma("unroll") for (int _h = 0; _h < 2; ++_h) _Pragma("unroll") for (int _i = 0; _i < 2; ++_i) { \
        const unsigned _row = Geo::GATHER ? g.a_row((u), _h * HALF + Rs[_i]) : (unsigned)(_h * HALF + Rs[_i]); v[_h][_i] = (_row * (unsigned)g.lda + (unsigned)Cs[_i]) * 2u; } } while (0)
    Unit cur, nxt; int ui = 0;
    if (!S.next(0, cur)) return;
    f32x4 acc[2][2][4][2];
#pragma unroll
    for (int a = 0; a < 2; ++a)
#pragma unroll
        for (int b = 0; b < 2; ++b)
#pragma unroll
            for (int m = 0; m < 4; ++m)
#pragma unroll
                for (int n = 0; n < 2; ++n) acc[a][b][m][n] = (f32x4){0.f, 0.f, 0.f, 0.f};
    bf16x8 At[4][2], B0[2][2], B1[2][2];
    const char* cA = g.a_tile(cur); const char* cB = g.b_tile(cur);
    PG8_SETV(vC, cur);
    if (Geo::GATHER) { PG8_WAIT_V(0); }
    PG8_STAGE(PG8_SB(0, 0), cB, voffB); PG8_STAGE(PG8_SB(0, 1), cB + hstepB, voffB); PG8_STAGE(PG8_SA(0, 0), cA, vC[0]); PG8_STAGE(PG8_SA(0, 1), cA, vC[1]);
    if (wr == 1) PG8_BAR;
    PG8_WAIT_V(2); PG8_BAR;
    PG8_STAGE(PG8_SB(1, 0), cB + kstep, voffB); PG8_STAGE(PG8_SA(1, 0), cA + kstep, vC[0]); PG8_STAGE(PG8_SB(1, 1), cB + hstepB + kstep, voffB);
    PG8_WAIT_V(6); PG8_BAR;
    for (;;) {
        const bool has_next = S.next(ui + 1, nxt);
        const char* nA = has_next ? g.a_tile(nxt) : cA; const char* nB = has_next ? g.b_tile(nxt) : cB;
        for (int t = 0; t < nt; t += 2) {
            const bool last = (t == nt - 2);
            const char* a1 = cA + (size_t)(t + 1) * kstep;
            const char* a2 = last ? nA : cA + (size_t)(t + 2) * kstep; const char* b2 = last ? nB : cB + (size_t)(t + 2) * kstep;
            const char* a3 = a2 + kstep; const char* b3 = b2 + kstep;
            unsigned t1[2] = {0u, 0u};
            if (Geo::GATHER && last && has_next) {
#pragma unroll
                for (int _i = 0; _i < 2; ++_i) { vC[0][_i] = (g.a_row(nxt, Rs[_i]) * (unsigned)g.lda + (unsigned)Cs[_i]) * 2u; t1[_i] = (g.a_row(nxt, HALF + Rs[_i]) * (unsigned)g.lda + (unsigned)Cs[_i]) * 2u; }
            }
            PG8_LDB(B0, 0, 0); PG8_LDB(B1, 0, 1); PG8_SCHED; PG8_LDA(At, 0, 0); PG8_STAGE(PG8_SA(1, 1), a1, vC[1]);
            if (Geo::GATHER && last && has_next) { vC[1][0] = t1[0]; vC[1][1] = t1[1]; }
            PG8_WAIT_R(); PG8_WAIT_L(0); PG8_BAR; PG8_MMA(0, 0, At, B0); PG8_MMA(0, 1, At, B1); PG8_BAR; PG8_SCHED;
            PG8_LDA(At, 0, 1); PG8_STAGE(PG8_SB(0, 0), b2, voffB); PG8_STAGE(PG8_SB(0, 1), b2 + hstepB, voffB); PG8_STAGE(PG8_SA(0, 0), a2, vC[0]);
            PG8_WAIT_R(); PG8_WAIT_L(0); PG8_BAR; PG8_MMA(1, 0, At, B0); PG8_MMA(1, 1, At, B1); PG8_BAR; PG8_SCHED;
            PG8_LDB(B0, 1, 0); PG8_LDB(B1, 1, 1); PG8_SCHED; PG8_LDA(At, 1, 0); PG8_STAGE(PG8_SA(0, 1), a2, vC[1]);
            PG8_WAIT_R(); PG8_WAIT_L(0); PG8_BAR; PG8_MMA(0, 0, At, B0); PG8_MMA(0, 1, At, B1); PG8_BAR; PG8_SCHED;
            PG8_LDA(At, 1, 1); PG8_STAGE(PG8_SB(1, 0), b3, voffB); PG8_STAGE(PG8_SB(1, 1), b3 + hstepB, voffB); PG8_STAGE(PG8_SA(1, 0), a3, vC[0]);
            PG8_WAIT_V(8); PG8_WAIT_L(0); PG8_BAR; PG8_MMA(1, 0, At, B0); PG8_MMA(1, 1, At, B1); PG8_BAR; PG8_SCHED;
        }
        if (NE > 0) PG8_STAGE(PG8_SA(1, 1), nA + kstep, vC[1]);
        if (wr == 0) PG8_BAR;
        E(acc, cur, wr, wc, fr, fq);
        if (!has_next) break;
        if (!E.keep(cur)) {
#pragma unroll
        for (int a = 0; a < 2; ++a)
#pragma unroll
            for (int b = 0; b < 2; ++b)
#pragma unroll
                for (int m = 0; m < 4; ++m)
#pragma unroll
                    for (int n = 0; n < 2; ++n) acc[a][b][m][n] = (f32x4){0.f, 0.f, 0.f, 0.f};
        }
        cur = nxt; cA = nA; cB = nB; ++ui;
        if (wr == 1) PG8_BAR;
    }
    PG8_WAIT_V(0);
    PG8_BAR;
#undef PG8_SA
#undef PG8_SB
#undef PG8_STAGE
#undef PG8_LDA
#undef PG8_LDB
#undef PG8_MMA
#undef PG8_WAIT_V
#undef PG8_WAIT_L
#undef PG8_WAIT_R
#undef PG8_BAR
#undef PG8_SCHED
#undef PG8_SETV
}
}

struct GeoPlain {
    static constexpr bool GATHER = false;
    const bf16* A; const bf16* Bt; int K, lda, ldb;
    __device__ __forceinline__ const char* a_tile(const pg8::Unit& u) const { return (const char*)(A + (size_t)u.pm * 256 * lda); }
    __device__ __forceinline__ const char* b_tile(const pg8::Unit& u) const { return (const char*)(Bt + (size_t)u.pn * 256 * ldb); }
    __device__ __forceinline__ unsigned a_row(const pg8::Unit&, int R) const { return (unsigned)R; }
};
struct GeoMergeA {
    static constexpr bool GATHER = false;
    const bf16* ZZ; const bf16* Bt; int K, lda, ldb;
    __device__ __forceinline__ const char* a_tile(const pg8::Unit& u) const { const int br = u.pn >> 2; const int co = br == 0 ? ZC_Q : (br == 1 ? ZC_LG : ZC_Z); return (const char*)(ZZ + (size_t)u.pm * 256 * ZLD + co); }
    __device__ __forceinline__ const char* b_tile(const pg8::Unit& u) const { return (const char*)(Bt + (size_t)u.pn * 256 * 512); }
    __device__ __forceinline__ unsigned a_row(const pg8::Unit&, int R) const { return (unsigned)R; }
};
struct GeoMoeUp {
    static constexpr bool GATHER = true;
    const bf16* A; const bf16* Bt; const int* row_tok; const int* tile_e; int K, lda, ldb;
    __device__ __forceinline__ const char* a_tile(const pg8::Unit&) const { return (const char*)A; }
    __device__ __forceinline__ const char* b_tile(const pg8::Unit& u) const { const int e = __builtin_amdgcn_readfirstlane(tile_e[u.pm]); return (const char*)(Bt + ((size_t)e * 512 + (size_t)u.pn * 256) * 1024); }
    __device__ __forceinline__ unsigned a_row(const pg8::Unit& u, int R) const { return (unsigned)row_tok[u.pm * 256 + R]; }
};
struct GeoMoeDown {
    static constexpr bool GATHER = false;
    const bf16* A; const bf16* Bt; const int* tile_e; int K, lda, ldb;
    __device__ __forceinline__ const char* a_tile(const pg8::Unit& u) const { return (const char*)(A + (size_t)u.pm * 256 * 256); }
    __device__ __forceinline__ const char* b_tile(const pg8::Unit& u) const { const int e = __builtin_amdgcn_readfirstlane(tile_e[u.pm]); return (const char*)(Bt + ((size_t)e * 1024 + (size_t)u.pn * 256) * 256); }
    __device__ __forceinline__ unsigned a_row(const pg8::Unit&, int R) const { return (unsigned)R; }
};

struct EpiInProj {
    static constexpr bool PERM = true; static constexpr int SEAM_VM = 0;
    __device__ __forceinline__ bool keep(const pg8::Unit&) const { return false; }
    bf16* ZZ; const float* cosT; const float* sinT;
    __device__ __forceinline__ void operator()(const f32x4 (&acc)[2][2][4][2], const pg8::Unit& u, int wr, int wc, int fr, int fq) const {
        const int row0 = u.pm * 256 + wr * 64 + fr, colt = u.pn * 256 + wc * 32 + 8 * fq;
        const int kind = u.pn < 4 ? 0 : ((u.pn >= 16 && u.pn < 28) ? 2 : 1);
#pragma unroll
        for (int ai = 0; ai < 2; ++ai)
#pragma unroll
            for (int m = 0; m < 4; ++m) {
                const int row = row0 + ai * 128 + m * 16;
                bf16* rowp = ZZ + (size_t)row * ZLD + colt;
#pragma unroll
                for (int bj = 0; bj < 2; ++bj) {
                    f32x4 v0 = acc[ai][bj][m][0], v1 = acc[ai][bj][m][1];
                    if (kind == 0) {
                        if (row < NLAT) {
                            const int t = row & 4095, i0 = ((colt + bj * 128) & 63) >> 1;
                            const f32x4 c = *(const f32x4*)(cosT + t * 32 + i0), s = *(const f32x4*)(sinT + t * 32 + i0);
                            f32x4 a, b;
                            a[0] = v0[0] * c[0] - v0[1] * s[0]; a[1] = v0[1] * c[0] + v0[0] * s[0];
                            a[2] = v0[2] * c[1] - v0[3] * s[1]; a[3] = v0[3] * c[1] + v0[2] * s[1];
                            b[0] = v1[0] * c[2] - v1[1] * s[2]; b[1] = v1[1] * c[2] + v1[0] * s[2];
                            b[2] = v1[2] * c[3] - v1[3] * s[3]; b[3] = v1[3] * c[3] + v1[2] * s[3];
                            v0 = a; v1 = b;
                        }
                    } else if (kind == 2) {
#pragma unroll
                        for (int j = 0; j < 4; ++j) { v0[j] = sigmoidf_(v0[j]); v1[j] = sigmoidf_(v1[j]); }
                    }
                    u32x4 w; w.x = cvt_pk_bf16(v0[0], v0[1]); w.y = cvt_pk_bf16(v0[2], v0[3]); w.z = cvt_pk_bf16(v1[0], v1[1]); w.w = cvt_pk_bf16(v1[2], v1[3]);
                    *(u32x4*)(rowp + bj * 128) = w;
                }
                asm volatile("" ::: "memory");
            }
    }
};
struct EpiMergeDiv {
    static constexpr bool PERM = true; static constexpr int SEAM_VM = 0;
    __device__ __forceinline__ bool keep(const pg8::Unit& u) const { return (u.pn >> 2) < 2; }
    bf16* ZZ; bool dry;
    __device__ __forceinline__ void operator()(f32x4 (&acc)[2][2][4][2], const pg8::Unit& u, int wr, int wc, int fr, int fq) const {
        const int n = u.pn >> 2, pn4 = u.pn & 3;
        const int row0 = u.pm * 256 + wr * 64 + fr, colg = ZC_GATE + n * 1024 + pn4 * 256 + wc * 32 + 8 * fq, colo = ZC_MRG + pn4 * 256 + wc * 32 + 8 * fq;
        const int hofs = n < 2 ? 1024 : 0;
#pragma unroll
        for (int ai = 0; ai < 2; ++ai) {
            u32x4 gq[4][2], hq[4][2];
#pragma unroll
            for (int m = 0; m < 4; ++m) { const bf16* rowp = ZZ + (size_t)(row0 + ai * 128 + m * 16) * ZLD;
#pragma unroll
                for (int bj = 0; bj < 2; ++bj) { gq[m][bj] = *(const u32x4*)(rowp + colg + bj * 128); hq[m][bj] = *(const u32x4*)(rowp + colg + hofs + bj * 128); } }
#pragma unroll
            for (int m = 0; m < 4; ++m) {
                bf16* rowp = ZZ + (size_t)(row0 + ai * 128 + m * 16) * ZLD;
#pragma unroll
                for (int bj = 0; bj < 2; ++bj) {
                    const u32x4 g_ = gq[m][bj];
                    f32x4 s0, s1;
                    s0[0] = bflo(g_.x); s0[1] = bfhi(g_.x); s0[2] = bflo(g_.y); s0[3] = bfhi(g_.y); s1[0] = bflo(g_.z); s1[1] = bfhi(g_.z); s1[2] = bflo(g_.w); s1[3] = bfhi(g_.w);
                    { const u32x4 h_ = hq[m][bj];
                        f32x4 d0, d1;
                        d0[0] = bflo(h_.x); d0[1] = bfhi(h_.x); d0[2] = bflo(h_.y); d0[3] = bfhi(h_.y); d1[0] = bflo(h_.z); d1[1] = bfhi(h_.z); d1[2] = bflo(h_.w); d1[3] = bfhi(h_.w);
#pragma unroll
                        for (int j = 0; j < 4; ++j) { const float e0 = n < 2 ? fmaxf(d0[j], 1e-20f) : 1.0f, e1 = n < 2 ? fmaxf(d1[j], 1e-20f) : 1.0f;
                            acc[ai][bj][m][0][j] *= fmaxf(s0[j], 1e-20f) * __builtin_amdgcn_rcpf(e0); acc[ai][bj][m][1][j] *= fmaxf(s1[j], 1e-20f) * __builtin_amdgcn_rcpf(e1); } }
                    if (n == 2) {
                        const f32x4 v0 = acc[ai][bj][m][0], v1 = acc[ai][bj][m][1];
                        u32x4 w; w.x = cvt_pk_bf16(v0[0], v0[1]); w.y = cvt_pk_bf16(v0[2], v0[3]); w.z = cvt_pk_bf16(v1[0], v1[1]); w.w = cvt_pk_bf16(v1[2], v1[3]);
                        if (!dry) *(u32x4*)(rowp + colo + bj * 128) = w; else asm volatile("" :: "v"(w));
                    }
                }
            }
            asm volatile("" ::: "memory");
        }
    }
};
struct MergeOrder {
    pg8::StaticOrder base;
    __device__ void init(int nM, int G, int c) { base.init(nM, 4, G, c); }
    __device__ bool next(int i, pg8::Unit& u) const { const int j = i / 3, n = i - 3 * j; if (!base.next(j, u)) return false; u.pn += 4 * n; return true; }
};
struct EpiBf16Plain {
    static constexpr bool PERM = true; static constexpr int SEAM_VM = 16;
    __device__ __forceinline__ bool keep(const pg8::Unit&) const { return false; }
    bf16* O; int ldc;
    __device__ __forceinline__ void operator()(const f32x4 (&acc)[2][2][4][2], const pg8::Unit& u, int wr, int wc, int fr, int fq) const {
        const int row0 = u.pm * 256 + wr * 64 + fr, colt = u.pn * 256 + wc * 32 + 8 * fq;
#pragma unroll
        for (int ai = 0; ai < 2; ++ai)
#pragma unroll
            for (int m = 0; m < 4; ++m) {
                bf16* rowp = O + (size_t)(row0 + ai * 128 + m * 16) * ldc + colt;
#pragma unroll
                for (int bj = 0; bj < 2; ++bj) {
                    const f32x4 v0 = acc[ai][bj][m][0], v1 = acc[ai][bj][m][1];
                    u32x4 w; w.x = cvt_pk_bf16(v0[0], v0[1]); w.y = cvt_pk_bf16(v0[2], v0[3]); w.z = cvt_pk_bf16(v1[0], v1[1]); w.w = cvt_pk_bf16(v1[2], v1[3]);
                    *(u32x4*)(rowp + bj * 128) = w;
                }
            }
    }
};
template <bool ROUTED> struct EpiSwiGLU {
    static constexpr bool PERM = true; static constexpr int SEAM_VM = 0;
    __device__ __forceinline__ bool keep(const pg8::Unit&) const { return false; }
    bf16* O; const float* roww;
    __device__ __forceinline__ void operator()(const f32x4 (&acc)[2][2][4][2], const pg8::Unit& u, int wr, int wc, int fr, int fq) const {
        const int row0 = u.pm * 256 + wr * 64 + fr, colt = u.pn * 128 + wc * 32 + 8 * fq;
#pragma unroll
        for (int ai = 0; ai < 2; ++ai)
#pragma unroll
            for (int m = 0; m < 4; ++m) {
                const int row = row0 + ai * 128 + m * 16;
                const float rw = ROUTED ? roww[row] : 1.0f;
                const f32x4 g0 = acc[ai][0][m][0], g1 = acc[ai][0][m][1], u0 = acc[ai][1][m][0], u1 = acc[ai][1][m][1];
                f32x4 a, b;
#pragma unroll
                for (int j = 0; j < 4; ++j) { a[j] = siluf_(g0[j]) * u0[j] * rw; b[j] = siluf_(g1[j]) * u1[j] * rw; }
                u32x4 w; w.x = cvt_pk_bf16(a[0], a[1]); w.y = cvt_pk_bf16(a[2], a[3]); w.z = cvt_pk_bf16(b[0], b[1]); w.w = cvt_pk_bf16(b[2], b[3]);
                *(u32x4*)(O + (size_t)row * 256 + colt) = w;
                asm volatile("" ::: "memory");
            }
    }
};
struct EpiRouter {
    static constexpr bool PERM = false; static constexpr int SEAM_VM = 0;
    __device__ __forceinline__ bool keep(const pg8::Unit&) const { return false; }
    float* L;
    __device__ __forceinline__ void operator()(const f32x4 (&acc)[2][2][4][2], const pg8::Unit& u, int wr, int wc, int fr, int fq) const {
        if (wc >= 2) return;
        const int row0 = u.pm * 256 + wr * 64 + fr, col0 = wc * 32 + 4 * fq;
#pragma unroll
        for (int ai = 0; ai < 2; ++ai)
#pragma unroll
            for (int m = 0; m < 4; ++m) {
                float* rowp = L + (size_t)(row0 + ai * 128 + m * 16) * 64 + col0;
#pragma unroll
                for (int n = 0; n < 2; ++n) *(f32x4*)(rowp + n * 16) = acc[ai][0][m][n] + acc[ai][1][m][n];
            }
    }
};
struct EpiSharedDown {
    static constexpr bool PERM = true; static constexpr int SEAM_VM = 16; static constexpr bool SEAM_PRE = true;
    __device__ __forceinline__ bool keep(const pg8::Unit&) const { return false; }
    bf16* X; const float* modl; bool dry;
    __device__ __forceinline__ void operator()(const f32x4 (&acc)[2][2][4][2], const pg8::Unit& u, int wr, int wc, int fr, int fq) const {
        const int row0 = u.pm * 256 + wr * 64 + fr, colt = u.pn * 256 + wc * 32 + 8 * fq;
#pragma unroll
        for (int ai = 0; ai < 2; ++ai)
#pragma unroll
            for (int m = 0; m < 4; ++m) {
                const int row = row0 + ai * 128 + m * 16;
                const int mr = row < NLAT ? (row >> 12) : 8;
                bf16* rowp = X + (size_t)row * 1024 + colt;
                const float* m5 = modl + (size_t)mr * 6144 + 5 * 1024 + colt;
#pragma unroll
                for (int bj = 0; bj < 2; ++bj) {
                    const u32x4 xr = *(const u32x4*)(rowp + bj * 128); const f32x4 g0 = *(const f32x4*)(m5 + bj * 128), g1 = *(const f32x4*)(m5 + bj * 128 + 4);
                    const f32x4 a0 = acc[ai][bj][m][0], a1 = acc[ai][bj][m][1];
                    u32x4 w;
                    w.x = cvt_pk_bf16(bflo(xr.x) * DN_ALPHA + g0[0] * a0[0], bfhi(xr.x) * DN_ALPHA + g0[1] * a0[1]); w.y = cvt_pk_bf16(bflo(xr.y) * DN_ALPHA + g0[2] * a0[2], bfhi(xr.y) * DN_ALPHA + g0[3] * a0[3]);
                    w.z = cvt_pk_bf16(bflo(xr.z) * DN_ALPHA + g1[0] * a1[0], bfhi(xr.z) * DN_ALPHA + g1[1] * a1[1]); w.w = cvt_pk_bf16(bflo(xr.w) * DN_ALPHA + g1[2] * a1[2], bfhi(xr.w) * DN_ALPHA + g1[3] * a1[3]);
                    if (!dry) *(u32x4*)(rowp + bj * 128) = w; else asm volatile("" :: "v"(w));
                }
                asm volatile("" ::: "memory");
            }
    }
};

namespace att {
constexpr int KVBLK = 64;
constexpr float SCALE = 0.125f, THR = 8.f;
constexpr size_t SHM_V = KVBLK * 128 * 2, SHM_K = KVBLK * 128 * 2;
constexpr size_t SHM_ATTN = 2 * SHM_V + 2 * SHM_K + 8 * 64 * 4;
#define KSWZ(row, colB) ((row) * 256 + ((colB) ^ (((row) & 7) << 4)))
#define SBAR() __builtin_amdgcn_sched_barrier(0)
__device__ __forceinline__ int crow(int r, int hi) { return (r & 3) + 8 * (r >> 2) + 4 * hi; }
__device__ __forceinline__ void partialSM(f32x16& p0, f32x16& p1, float& m_reg, float& mn, float& alpha) {
  constexpr float C = SCALE * 1.4426950408889634f;
  float pmax = p0[0];
#pragma unroll
  for (int r = 1; r < 16; ++r) pmax = fmaxf(pmax, p0[r]);
#pragma unroll
  for (int r = 0; r < 16; ++r) pmax = fmaxf(pmax, p1[r]);
  { auto rr = __builtin_amdgcn_permlane32_swap(__float_as_uint(pmax), __float_as_uint(pmax), false, false);
    pmax = fmaxf(__uint_as_float(rr[0]), __uint_as_float(rr[1])); }
  if (__builtin_expect(__all(pmax - m_reg <= THR / SCALE), 1)) { mn = m_reg; alpha = 1.f; }
  else { mn = fmaxf(m_reg, pmax); alpha = __builtin_amdgcn_exp2f((m_reg - mn) * C); m_reg = mn; }
  float mnC = -mn * C;
#pragma unroll
  for (int r = 0; r < 16; ++r) p0[r] = fmaf(p0[r], C, mnC);
#pragma unroll
  for (int r = 0; r < 16; ++r) p1[r] = fmaf(p1[r], C, mnC);
#pragma unroll
  for (int r = 0; r < 16; ++r) p0[r] = __builtin_amdgcn_exp2f(p0[r]);
}
__device__ __forceinline__ void finishSM(f32x16& p0, f32x16& p1, float alpha, float& l_reg, bf16x8& pa0, bf16x8& pa1, bf16x8& pa2, bf16x8& pa3) {
#pragma unroll
  for (int r = 0; r < 16; ++r) p1[r] = __builtin_amdgcn_exp2f(p1[r]);
  f32x2 ps2 = (f32x2){0.f, 0.f};
#pragma unroll
  for (int r = 0; r < 16; r += 2) ps2 += (f32x2){p0[r], p0[r + 1]};
#pragma unroll
  for (int r = 0; r < 16; r += 2) ps2 += (f32x2){p1[r], p1[r + 1]};
  float ps = ps2[0] + ps2[1];
  { auto rr = __builtin_amdgcn_permlane32_swap(__float_as_uint(ps), __float_as_uint(ps), false, false);
    ps = __uint_as_float(rr[0]) + __uint_as_float(rr[1]); }
  l_reg = l_reg * alpha + ps;
#define PK4(P, BASE, OUT) do { unsigned a0 = cvt_pk_bf16(P[BASE + 0], P[BASE + 1]), a1 = cvt_pk_bf16(P[BASE + 2], P[BASE + 3]);   \
    unsigned b0 = cvt_pk_bf16(P[BASE + 4], P[BASE + 5]), b1 = cvt_pk_bf16(P[BASE + 6], P[BASE + 7]);                              \
    auto r0 = __builtin_amdgcn_permlane32_swap(a0, b0, false, false); auto r1 = __builtin_amdgcn_permlane32_swap(a1, b1, false, false); \
    u32x4 w = {r0[0], r1[0], r0[1], r1[1]}; OUT = *reinterpret_cast<bf16x8*>(&w); } while (0)
  PK4(p0, 0, pa0); PK4(p0, 8, pa1); PK4(p1, 0, pa2); PK4(p1, 8, pa3);
#undef PK4
}
__device__ __forceinline__ void qkt(f32x16& p0, f32x16& p1, const char* Ks, const bf16x8 (&qr)[4], int r32, int hi, int mcol) {
  p0 = f32x16{}; p1 = f32x16{};
#pragma unroll
  for (int d0 = 0; d0 < 4; ++d0) { int cb = (mcol + d0 * 16 + hi * 8) * 2;
    bf16x8 b0 = *reinterpret_cast<const bf16x8*>(Ks + KSWZ(r32, cb));
    bf16x8 b1 = *reinterpret_cast<const bf16x8*>(Ks + KSWZ(32 + r32, cb));
    p0 = __builtin_amdgcn_mfma_f32_32x32x16_bf16(b0, qr[d0], p0, 0, 0, 0);
    p1 = __builtin_amdgcn_mfma_f32_32x32x16_bf16(b1, qr[d0], p1, 0, 0, 0); }
}
__device__ __forceinline__ int v_st(int k, int c) { const int kk = (k & ~0xC) | ((k & 4) << 1) | ((k & 8) >> 1); return ((kk >> 3) * 4 + (c >> 5)) * 512 + ((kk & 7) * 32 + (c & 31)) * 2; }
__device__ __forceinline__ int v_rd_base(int lane) { return ((lane & 3) << 3) | (((lane >> 2) & 3) << 6) | (((lane >> 4) & 1) << 5) | (((lane >> 5) & 1) << 8); }
constexpr int v_rd_off(int d0, int ks, int half) { return d0 * 512 + ks * 4096 + half * 2048; }
template <int OFF> __device__ __forceinline__ s16x4 tr_read(int vb) {
  s16x4 r; asm volatile("ds_read_b64_tr_b16 %0, %1 offset:%2" : "=&v"(r) : "v"(vb), "i"(OFF) : "memory"); return r;
}
template <int D0> __device__ __forceinline__ void pv_one(f32x16& od, int vb, bf16x8 pa0, bf16x8 pa1, bf16x8 pa2, bf16x8 pa3) {
  const s16x4 l0 = tr_read<v_rd_off(D0, 0, 0)>(vb), h0 = tr_read<v_rd_off(D0, 0, 1)>(vb), l1 = tr_read<v_rd_off(D0, 1, 0)>(vb), h1 = tr_read<v_rd_off(D0, 1, 1)>(vb);
  const s16x4 l2 = tr_read<v_rd_off(D0, 2, 0)>(vb), h2 = tr_read<v_rd_off(D0, 2, 1)>(vb), l3 = tr_read<v_rd_off(D0, 3, 0)>(vb), h3 = tr_read<v_rd_off(D0, 3, 1)>(vb);
  asm volatile("s_waitcnt lgkmcnt(0)" ::: "memory"); SBAR();
#define PK(L, H) (bf16x8){L[0], L[1], L[2], L[3], H[0], H[1], H[2], H[3]}
  od = __builtin_amdgcn_mfma_f32_32x32x16_bf16(pa0, PK(l0, h0), od, 0, 0, 0);
  od = __builtin_amdgcn_mfma_f32_32x32x16_bf16(pa1, PK(l1, h1), od, 0, 0, 0);
  od = __builtin_amdgcn_mfma_f32_32x32x16_bf16(pa2, PK(l2, h2), od, 0, 0, 0);
  od = __builtin_amdgcn_mfma_f32_32x32x16_bf16(pa3, PK(l3, h3), od, 0, 0, 0);
#undef PK
}
__device__ __forceinline__ void pv_d0(f32x16* o, int vb, bf16x8 pa0, bf16x8 pa1, bf16x8 pa2, bf16x8 pa3) {
  pv_one<0>(o[0], vb, pa0, pa1, pa2, pa3); pv_one<1>(o[1], vb, pa0, pa1, pa2, pa3); pv_one<2>(o[2], vb, pa0, pa1, pa2, pa3); pv_one<3>(o[3], vb, pa0, pa1, pa2, pa3);
}
static __device__ __forceinline__ void attn_unit(bf16* __restrict__ ZZ_, int qrow0_, int h_, int krowA_, int ntA_, int krowB_, int NT_, float lam_, const float* __restrict__ gn_, float oscale_, bool dostore) {
  bf16* __restrict__ ZZ = uni(ZZ_); const int qrow0 = uni(qrow0_), h = uni(h_), krowA = uni(krowA_), ntA = uni(ntA_), krowB = uni(krowB_), NT = uni(NT_); const float lam = uni(lam_), oscale = uni(oscale_); const float* __restrict__ gn = uni(gn_);
  char* lds = (char*)olds();
  const int tid = otid(), wid = tid >> 6, lane = tid & 63, r32 = lane & 31, hi = lane >> 5;
  const int map = wid >> 2, wq = wid & 3, mcol = map * 64;
  char* V_lds = lds; char* K_lds = lds + 2 * SHM_V;
  float* ws = (float*)(lds + 2 * SHM_V + 2 * SHM_K) + wid * 64; float* li_l = ws; float* al_l = ws + 32;
  float m_reg = -1e30f, l_reg = 0; f32x16 o[4] = {}; bf16x8 qr[4];
  const bf16* Qw = ZZ + (size_t)(qrow0 + wq * 32 + r32) * ZLD + ZC_Q + h * 128 + mcol + hi * 8;
#pragma unroll
  for (int d0 = 0; d0 < 4; ++d0) qr[d0] = *reinterpret_cast<const bf16x8*>(Qw + d0 * 16);
  const int sr = tid >> 4, sc = (tid & 15) * 8, vst0 = v_st(sr, sc), vst1 = v_st(32 + sr, sc);
  const int vb0 = (int)(uintptr_t)(LAS char*)V_lds + v_rd_base(lane);
  const bf16* Kcol = ZZ + ZC_K + h * 128 + sc; const bf16* Vcol = ZZ + ZC_V + h * 128 + sc;
  struct { bf16x8 vs0, vs1, ks0, ks1; } sr_[2];
#define KROW(j) ((j) < ntA ? krowA + (j) * KVBLK : krowB + ((j) - ntA) * KVBLK)
#define SLOAD(i, j) do { const size_t _r0 = (size_t)(KROW(j) + sr) * ZLD, _r1 = _r0 + (size_t)32 * ZLD; \
    sr_[i].vs0 = *reinterpret_cast<const bf16x8*>(Vcol + _r0); sr_[i].vs1 = *reinterpret_cast<const bf16x8*>(Vcol + _r1); \
    sr_[i].ks0 = *reinterpret_cast<const bf16x8*>(Kcol + _r0); sr_[i].ks1 = *reinterpret_cast<const bf16x8*>(Kcol + _r1); } while (0)
#define SWRITE(b, i) do { *(bf16x8*)(V_lds + (b) * SHM_V + vst0) = sr_[i].vs0;          \
    *(bf16x8*)(V_lds + (b) * SHM_V + vst1) = sr_[i].vs1; int kc = sc * 2;               \
    *(bf16x8*)(K_lds + (b) * SHM_K + KSWZ(sr, kc)) = sr_[i].ks0;                       \
    *(bf16x8*)(K_lds + (b) * SHM_K + KSWZ(32 + sr, kc)) = sr_[i].ks1; } while (0)
#define SWAIT() asm volatile("s_waitcnt vmcnt(4)" ::: "memory")
#define RESC(a) do { if (__any((a) < 1.f)) { if (hi == 0) al_l[r32] = (a); asm volatile("s_waitcnt lgkmcnt(0)" ::: "memory"); \
    _Pragma("unroll") for (int d = 0; d < 4; ++d) _Pragma("unroll") for (int r = 0; r < 16; ++r) o[d][r] *= al_l[crow(r, hi)]; } } while (0)
  f32x16 pA0, pA1, pB0, pB1; float mnA, mnB, alA, alB; bf16x8 pa0, pa1, pa2, pa3;
  constexpr int SE = 0, SO = 1;
  if (__builtin_amdgcn_readfirstlane(wid) >= 4) __builtin_amdgcn_s_setprio(1);
  SLOAD(SE, 0); asm volatile("s_waitcnt vmcnt(0)" ::: "memory"); SWRITE(0, SE); __syncthreads();
  qkt(pA0, pA1, K_lds, qr, r32, hi, mcol); partialSM(pA0, pA1, m_reg, mnA, alA);
  SLOAD(SO, 1); if (2 < NT) SLOAD(SE, 2);
  SWAIT(); SWRITE(1, SO); __syncthreads();
  for (int j = 1; j + 1 < NT; j += 2) {
    SBAR(); qkt(pB0, pB1, K_lds + SHM_K, qr, r32, hi, mcol);
    finishSM(pA0, pA1, alA, l_reg, pa0, pa1, pa2, pa3); SBAR();
    SLOAD(SO, j + 2); SBAR();
    pv_d0(o, vb0, pa0, pa1, pa2, pa3); partialSM(pB0, pB1, m_reg, mnB, alB);
    __syncthreads(); SWAIT(); SWRITE(0, SE);
    RESC(alB); __syncthreads();
    SBAR(); qkt(pA0, pA1, K_lds, qr, r32, hi, mcol);
    finishSM(pB0, pB1, alB, l_reg, pa0, pa1, pa2, pa3); SBAR();
    if (j + 3 < NT) SLOAD(SE, j + 3); SBAR();
    pv_d0(o, vb0 + (int)SHM_V, pa0, pa1, pa2, pa3); partialSM(pA0, pA1, m_reg, mnA, alA);
    __syncthreads(); SWAIT(); SWRITE(1, SO);
    RESC(alA); __syncthreads();
  }
  SBAR(); qkt(pB0, pB1, K_lds + SHM_K, qr, r32, hi, mcol);
  finishSM(pA0, pA1, alA, l_reg, pa0, pa1, pa2, pa3); SBAR();
  pv_d0(o, vb0, pa0, pa1, pa2, pa3); partialSM(pB0, pB1, m_reg, mnB, alB);
  __syncthreads(); RESC(alB);
  finishSM(pB0, pB1, alB, l_reg, pa0, pa1, pa2, pa3); SBAR();
  pv_d0(o, vb0 + (int)SHM_V, pa0, pa1, pa2, pa3);
  __builtin_amdgcn_s_setprio(0);
  if (hi == 0) li_l[r32] = l_reg; asm volatile("s_waitcnt lgkmcnt(0)" ::: "memory");
  float rli[16];
#pragma unroll
  for (int r = 0; r < 16; ++r) rli[r] = __builtin_amdgcn_rcpf(li_l[crow(r, hi)]);
  __syncthreads();
  float* xch = (float*)lds + (size_t)wq * 4096;
  if (map == 1) {
#pragma unroll
    for (int d0 = 0; d0 < 4; ++d0)
#pragma unroll
      for (int r = 0; r < 16; ++r) xch[(d0 * 16 + r) * 64 + lane] = o[d0][r] * rli[r];
  }
  __syncthreads();
  if (map == 0) {
    float ss[16];
#pragma unroll
    for (int r = 0; r < 16; ++r) ss[r] = 0.f;
#pragma unroll
    for (int d0 = 0; d0 < 4; ++d0)
#pragma unroll
      for (int r = 0; r < 16; ++r) { const float v = o[d0][r] * rli[r] - lam * xch[(d0 * 16 + r) * 64 + lane]; o[d0][r] = v; ss[r] += v * v; }
#pragma unroll
    for (int r = 0; r < 16; ++r) {
#pragma unroll
      for (int off = 1; off < 32; off <<= 1) ss[r] += __shfl_xor(ss[r], off);
      ss[r] = __builtin_amdgcn_rsqf(ss[r] * (1.0f / 128.0f) + RMS_EPS) * oscale;
    }
    float gv[4];
#pragma unroll
    for (int d0 = 0; d0 < 4; ++d0) gv[d0] = gn[d0 * 32 + r32];
    bf16* Ow = ZZ + (size_t)(qrow0 + wq * 32) * ZLD + ZC_Q + h * 128 + r32;
#pragma unroll
    for (int r = 0; r < 16; ++r) { const int orow = crow(r, hi);
#pragma unroll
      for (int d0 = 0; d0 < 4; ++d0) if (dostore) Ow[(size_t)orow * ZLD + d0 * 32] = (bf16)f2bf(o[d0][r] * ss[r] * gv[d0]); }
  }
#undef KROW
#undef SLOAD
#undef SWRITE
#undef SWAIT
#undef RESC
}
#undef KSWZ
#undef SBAR
}

__device__ __forceinline__ f32x4 mma_tile(const LAS char* A, int sa, const LAS char* B, int sb, int ksteps, int lane, f32x4 acc) {
    const int r = lane & 15, q = lane >> 4;
    for (int k = 0; k < ksteps; ++k) {
        const bf16x8 a = *(const LAS bf16x8*)(A + r * sa + (k * 32 + q * 8) * 2);
        const bf16x8 b = *(const LAS bf16x8*)(B + r * sb + (k * 32 + q * 8) * 2);
        acc = __builtin_amdgcn_mfma_f32_16x16x32_bf16(a, b, acc, 0, 0, 0);
    }
    return acc;
}

namespace ssd {
constexpr int PC = 272, PX = 144;
constexpr int BUFB = 64 * PC * 2 + 64 * PX;
constexpr int O_C = 0, O_B = 64 * PC, O_X = 2 * 64 * PC, O_XW = 2 * BUFB, O_MM = O_XW + 64 * PX, O_SB = O_MM + 64 * PX, O_ACS = O_SB + 64 * PC, O_END = O_ACS + 2 * 128 * 4;
static_assert(O_END <= 131072, "ssd lds");
struct Par { const bf16* XA; const float* DT; const float* ACS; bf16* Y; float Dskip; int b, h, d; };
__device__ __forceinline__ bf16x8 tr_frag(const LAS char* T, int pitch, int kbase, int idx0, int lane) {
    const int gq = lane >> 4, j = lane & 15;
    const LAS char* p0 = T + (kbase + 8 * gq + (j >> 2)) * pitch + (idx0 + 4 * (j & 3)) * 2;
    const s16x4 lo = __builtin_amdgcn_ds_read_tr16_b64_v4i16((LAS s16x4*)p0), hi = __builtin_amdgcn_ds_read_tr16_b64_v4i16((LAS s16x4*)(p0 + 4 * pitch));
    return (bf16x8){lo[0], lo[1], lo[2], lo[3], hi[0], hi[1], hi[2], hi[3]};
}
static __device__ __forceinline__ void unit(Par P_) {
    Par P; P.XA = uni(P_.XA); P.DT = uni(P_.DT); P.ACS = uni(P_.ACS); P.Y = uni(P_.Y); P.Dskip = uni(P_.Dskip); P.b = uni(P_.b); P.h = uni(P_.h); P.d = uni(P_.d);
    LAS char* lds = (LAS char*)olds();
    const int tid = otid(), wid = __builtin_amdgcn_readfirstlane(tid >> 6), lane = tid & 63, fr = lane & 15, fq = lane >> 4;
    const int g = P.h >> 2, dh = P.d * 8 + P.h;
    for (int i = tid; i < 64 * PC / 4; i += 512) ((LAS unsigned*)(lds + O_SB))[i] = 0u;
    f32x4 Sacc[4];
#pragma unroll
    for (int i = 0; i < 4; ++i) Sacc[i] = (f32x4){0.f, 0.f, 0.f, 0.f};
    u32x4 st[5]; float sa = 0.f;
#define CH_ROW(ch, pos) (((ch) < 4 ? NLAT + P.b * CTXL : P.b * SEQ) + (P.d ? ((ch) < 4 ? CTXL : SEQ) - 1 - ((((ch) < 4) ? (ch) : (ch) - 4) * 64 + (pos)) : (((ch) < 4) ? (ch) : (ch) - 4) * 64 + (pos)))
#define SSD_LOAD(ch) do { \
        _Pragma("unroll") for (int i_ = 0; i_ < 5; ++i_) { const int q_ = tid + 512 * i_; \
            const int row_ = i_ < 4 ? ((q_ & 1023) >> 4) : ((q_ - 2048) >> 3); const int pc_ = i_ < 4 ? (q_ & 15) : (q_ & 7); \
            const int col_ = i_ < 2 ? 768 + g * 128 + pc_ * 8 : (i_ < 4 ? 512 + g * 128 + pc_ * 8 : P.h * 64 + pc_ * 8); \
            st[i_] = *(const u32x4*)(P.XA + (size_t)CH_ROW(ch, row_) * 1024 + col_); } \
        if (tid < 128) { const int r_ = CH_ROW(ch, tid & 63); sa = tid < 64 ? P.ACS[(size_t)r_ * 16 + dh] : P.DT[(size_t)r_ * 16 + dh]; } } while (0)
#define SSD_WRITE(bf) do { \
        _Pragma("unroll") for (int i_ = 0; i_ < 5; ++i_) { const int q_ = tid + 512 * i_; \
            const int row_ = i_ < 4 ? ((q_ & 1023) >> 4) : ((q_ - 2048) >> 3); const int pc_ = i_ < 4 ? (q_ & 15) : (q_ & 7); \
            const int off_ = i_ < 2 ? O_C + row_ * PC + pc_ * 16 : (i_ < 4 ? O_B + row_ * PC + pc_ * 16 : O_X + row_ * PX + pc_ * 16); \
            *(LAS u32x4*)(lds + (bf) * BUFB + off_) = st[i_]; } \
        if (tid < 128) *(LAS float*)(lds + O_ACS + (bf) * 512 + tid * 4) = sa; } while (0)
    SSD_LOAD(0); SSD_WRITE(0); SSD_LOAD(1);
    __syncthreads();
    for (int ch = 0; ch < 68; ++ch) {
        const int bf = ch & 1;
        if (ch + 1 < 68) SSD_WRITE(bf ^ 1);
        if (ch + 2 < 68) SSD_LOAD(ch + 2);
        const LAS char* Cb = lds + bf * BUFB + O_C; const LAS char* Bb = lds + bf * BUFB + O_B; const LAS char* Xb = lds + bf * BUFB + O_X;
        const LAS float* ACSb = (const LAS float*)(lds + O_ACS + bf * 512); const LAS float* DTb = ACSb + 64;
        const float acs_end = ACSb[63];
        { const int s_ = tid >> 3, pc = tid & 7; const float sc = DTb[s_] * fexp(acs_end - ACSb[s_]);
          const u32x4 xv = *(const LAS u32x4*)(Xb + s_ * PX + pc * 16); u32x4 w;
          w.x = cvt_pk_bf16(bflo(xv.x) * sc, bfhi(xv.x) * sc); w.y = cvt_pk_bf16(bflo(xv.y) * sc, bfhi(xv.y) * sc); w.z = cvt_pk_bf16(bflo(xv.z) * sc, bfhi(xv.z) * sc); w.w = cvt_pk_bf16(bflo(xv.w) * sc, bfhi(xv.w) * sc);
          *(LAS u32x4*)(lds + O_XW + s_ * PX + pc * 16) = w; }
        const int lt = wid >> 1, h2 = wid & 1;
        f32x4 yo[2];
#pragma unroll
        for (int i = 0; i < 2; ++i) {
            const int st_ = h2 * 2 + i;
            f32x4 gacc = (f32x4){0.f, 0.f, 0.f, 0.f};
            if (st_ <= lt) gacc = mma_tile(Cb + lt * 16 * PC, PC, Bb + st_ * 16 * PC, PC, 4, lane, gacc);
            const int s = st_ * 16 + fr; const float as = ACSb[s], ds = DTb[s];
            float mv[4];
#pragma unroll
            for (int jj = 0; jj < 4; ++jj) { const int l = lt * 16 + fq * 4 + jj; mv[jj] = (s <= l) ? gacc[jj] * fexp(ACSb[l] - as) * ds : 0.f; }
            u32x2 mw; mw.x = cvt_pk_bf16(mv[0], mv[1]); mw.y = cvt_pk_bf16(mv[2], mv[3]);
            *(LAS u32x2*)(lds + O_MM + s * PX + (lt * 16 + fq * 4) * 2) = mw;
            f32x4 ya = (f32x4){0.f, 0.f, 0.f, 0.f};
#pragma unroll
            for (int ks = 0; ks < 4; ++ks) { const bf16x8 af = *(const LAS bf16x8*)(lds + O_SB + (st_ * 16 + fr) * PC + (ks * 32 + fq * 8) * 2); const bf16x8 bfr = *(const LAS bf16x8*)(Cb + (lt * 16 + fr) * PC + (ks * 32 + fq * 8) * 2);
                ya = __builtin_amdgcn_mfma_f32_16x16x32_bf16(af, bfr, ya, 0, 0, 0); }
            yo[i] = ya;
        }
        __syncthreads();
#pragma unroll
        for (int i = 0; i < 2; ++i) {
            const int pt = h2 * 2 + i;
            f32x4 yd = (f32x4){0.f, 0.f, 0.f, 0.f};
#pragma unroll
            for (int ks = 0; ks < 2; ++ks) { const bf16x8 af = tr_frag(Xb, PX, ks * 32, pt * 16, lane); const bf16x8 bfr = tr_frag(lds + O_MM, PX, ks * 32, lt * 16, lane);
                yd = __builtin_amdgcn_mfma_f32_16x16x32_bf16(af, bfr, yd, 0, 0, 0); }
            const int l = lt * 16 + fr, p0 = pt * 16 + fq * 4; const float el = fexp(ACSb[l]);
            float y[4];
#pragma unroll
            for (int jj = 0; jj < 4; ++jj) y[jj] = yd[jj] + el * yo[i][jj];
            if (P.d == 0) { const u32x2 xw = *(const LAS u32x2*)(Xb + l * PX + p0 * 2); y[0] += P.Dskip * bflo(xw.x); y[1] += P.Dskip * bfhi(xw.x); y[2] += P.Dskip * bflo(xw.y); y[3] += P.Dskip * bfhi(xw.y); }
            u32x2 ow; ow.x = cvt_pk_bf16(y[0], y[1]); ow.y = cvt_pk_bf16(y[2], y[3]);
            *(u32x2*)(P.Y + (size_t)CH_ROW(ch, l) * 512 + P.h * 64 + p0) = ow;
        }
        { const float dec = fexp(acs_end); const int pt = lt;
          bf16x8 af[2];
#pragma unroll
          for (int ks = 0; ks < 2; ++ks) af[ks] = tr_frag(lds + O_XW, PX, ks * 32, pt * 16, lane);
#pragma unroll
          for (int i = 0; i < 4; ++i) { const int nt = h2 * 4 + i;
              f32x4 acc = Sacc[i] * dec;
#pragma unroll
              for (int ks = 0; ks < 2; ++ks) { const bf16x8 bfr = tr_frag(Bb, PC, ks * 32, nt * 16, lane); acc = __builtin_amdgcn_mfma_f32_16x16x32_bf16(af[ks], bfr, acc, 0, 0, 0); }
              Sacc[i] = acc;
              const int n = nt * 16 + fr;
#pragma unroll
              for (int jj = 0; jj < 4; ++jj) { const int p = pt * 16 + fq * 4 + jj; *(LAS bf16*)(lds + O_SB + p * PC + n * 2) = (bf16)f2bf(acc[jj]); } } }
        __syncthreads();
    }
#undef CH_ROW
#undef SSD_LOAD
#undef SSD_WRITE
}
}

namespace lru {
constexpr int SS = 72 * 2;
constexpr int O_U = 0, O_WA = O_U + 2 * 128 * SS, O_WI = O_WA + 64 * SS, O_HL = O_WI + 64 * SS, O_CP = O_HL + 32768, O_AGG = O_CP + 32768, O_CW = O_AGG + 2 * 8 * 2 * 64 * 4, O_END = O_CW + 64 * 5 * 4;
static_assert(O_END <= 131072, "lru lds");
struct Par { const bf16* ZZ; bf16* Hout; const float* conv_w; const float* conv_b; const float* wa; const float* wi; const float* ba; const float* bi; const float* lam; int b, n, d; };
static __device__ __forceinline__ void unit(Par P_) {
    Par P; P.ZZ = uni(P_.ZZ); P.Hout = uni(P_.Hout); P.conv_w = uni(P_.conv_w); P.conv_b = uni(P_.conv_b); P.wa = uni(P_.wa); P.wi = uni(P_.wi); P.ba = uni(P_.ba); P.bi = uni(P_.bi); P.lam = uni(P_.lam); P.b = uni(P_.b); P.n = uni(P_.n); P.d = uni(P_.d);
    LAS char* lds = (LAS char*)olds();
    const int tid = otid(), wid = __builtin_amdgcn_readfirstlane(tid >> 6), lane = tid & 63, fr = lane & 15, fq = lane >> 4;
    LAS float* HL = (LAS float*)(lds + O_HL) + wid * 1024; LAS float* CP = (LAS float*)(lds + O_CP) + wid * 1024;
    LAS float* AGG = (LAS float*)(lds + O_AGG); LAS float* CW = (LAS float*)(lds + O_CW);
    for (int i = tid; i < 64 * 5; i += 512) { const int lc = i / 5, j = i % 5; const int c = P.n * 64 + lc; CW[i] = j < 4 ? P.conv_w[j * 512 + c] : P.conv_b[c]; }
    for (int i = tid; i < 4096; i += 512) { const int k = i >> 6, j = i & 63;
        *(LAS bf16*)(lds + O_WA + j * SS + k * 2) = (bf16)f2bf(P.wa[i]); *(LAS bf16*)(lds + O_WI + j * SS + k * 2) = (bf16)f2bf(P.wi[i]); }
    const int chn = P.n * 64 + lane;
    const float ba = P.ba[chn], bi = P.bi[chn], c8 = -8.0f * softplusf_(-P.lam[chn]);
    float hc = 0.f;
    u32x4 xr[2][4];
#define LRU_LOAD(chn_) do { const bool ic_ = (chn_) < 2; const int cc_ = ic_ ? (chn_) : (chn_) - 2; const int Ls_ = ic_ ? CTXL : SEQ; const int rs_ = ic_ ? NLAT + P.b * CTXL : P.b * SEQ; \
        _Pragma("unroll") for (int q_ = 0; q_ < 2; ++q_) { const int it_ = tid + 512 * q_; const int pos_ = it_ >> 3, lc_ = (it_ & 7) * 8; const int sp_ = cc_ * 128 + pos_; const int tk_ = P.d ? Ls_ - 1 - sp_ : sp_; \
            _Pragma("unroll") for (int j_ = 0; j_ < 4; ++j_) { const int t2_ = tk_ + j_ - 2; const int tc_ = t2_ < 0 ? 0 : (t2_ >= Ls_ ? Ls_ - 1 : t2_); \
                xr[q_][j_] = *(const u32x4*)(P.ZZ + (size_t)(rs_ + tc_) * ZLD + ZC_LX + P.n * 64 + lc_); } } } while (0)
    LRU_LOAD(0);
    __syncthreads();
    for (int ch = 0; ch < 34; ++ch) {
        const bool isctx = ch < 2; const int cc = isctx ? ch : ch - 2; const int Ls = isctx ? CTXL : SEQ; const int rseg = isctx ? NLAT + P.b * CTXL : P.b * SEQ;
        const int ub = O_U + (ch & 1) * 128 * SS; LAS float* AGGc = AGG + (ch & 1) * 1024;
#pragma unroll
        for (int q = 0; q < 2; ++q) {
            const int it = tid + 512 * q; const int pos = it >> 3, lc0 = (it & 7) * 8;
            const int sp = cc * 128 + pos; const int tk = P.d ? Ls - 1 - sp : sp;
            float u[8];
#pragma unroll
            for (int e = 0; e < 8; ++e) u[e] = CW[(lc0 + e) * 5 + 4];
#pragma unroll
            for (int j = 0; j < 4; ++j) { const int t2 = tk + j - 2;
                if (t2 >= 0 && t2 < Ls) { const u32x4 xv = xr[q][j];
                    u[0] += bflo(xv.x) * CW[(lc0 + 0) * 5 + j]; u[1] += bfhi(xv.x) * CW[(lc0 + 1) * 5 + j]; u[2] += bflo(xv.y) * CW[(lc0 + 2) * 5 + j]; u[3] += bfhi(xv.y) * CW[(lc0 + 3) * 5 + j];
                    u[4] += bflo(xv.z) * CW[(lc0 + 4) * 5 + j]; u[5] += bfhi(xv.z) * CW[(lc0 + 5) * 5 + j]; u[6] += bflo(xv.w) * CW[(lc0 + 6) * 5 + j]; u[7] += bfhi(xv.w) * CW[(lc0 + 7) * 5 + j]; } }
            u32x4 w; w.x = cvt_pk_bf16(u[0], u[1]); w.y = cvt_pk_bf16(u[2], u[3]); w.z = cvt_pk_bf16(u[4], u[5]); w.w = cvt_pk_bf16(u[6], u[7]);
            *(LAS u32x4*)(lds + ub + pos * SS + lc0 * 2) = w;
        }
        if (ch + 1 < 34) LRU_LOAD(ch + 1);
        __syncthreads();
#pragma unroll
        for (int jt = 0; jt < 4; ++jt) {
            const f32x4 ga = mma_tile(lds + ub + wid * 16 * SS, SS, lds + O_WA + jt * 16 * SS, SS, 2, lane, (f32x4){0.f, 0.f, 0.f, 0.f});
            const f32x4 gi = mma_tile(lds + ub + wid * 16 * SS, SS, lds + O_WI + jt * 16 * SS, SS, 2, lane, (f32x4){0.f, 0.f, 0.f, 0.f});
#pragma unroll
            for (int jj = 0; jj < 4; ++jj) { HL[(fq * 4 + jj) * 64 + jt * 16 + fr] = ga[jj]; CP[(fq * 4 + jj) * 64 + jt * 16 + fr] = gi[jj]; }
        }
        LDS_WAIT();
        float h = 0.f, Pp = 1.f;
        {
            float av[16], bv[16];
#pragma unroll
            for (int i = 0; i < 16; ++i) {
                const float uo = bf2f(*(const LAS bf16*)(lds + ub + (wid * 16 + i) * SS + lane * 2));
                const float r = sigmoidf_(HL[i * 64 + lane] + ba), ig = sigmoidf_(CP[i * 64 + lane] + bi), la = c8 * r;
                const float l2 = 2.0f * la;
                const float aa = fexp(la);
                const float om = l2 > -0.02f ? -l2 * (1.0f + l2 * (0.5f + l2 * (0.16666667f + l2 * 0.041666668f))) : fmaf(-aa, aa, 1.0f);
                av[i] = aa; bv[i] = __builtin_amdgcn_sqrtf(om) * (ig * uo);
            }
#pragma unroll
            for (int i = 0; i < 16; ++i) { h = av[i] * h + bv[i]; Pp *= av[i]; HL[i * 64 + lane] = h; CP[i * 64 + lane] = Pp; }
        }
        AGGc[(wid * 2 + 0) * 64 + lane] = Pp; AGGc[(wid * 2 + 1) * 64 + lane] = h;
        __syncthreads();
        float cin = hc, call = hc;
#pragma unroll
        for (int w = 0; w < 8; ++w) { const float pw = AGGc[(w * 2 + 0) * 64 + lane], hw = AGGc[(w * 2 + 1) * 64 + lane]; call = pw * call + hw; if (w < wid) cin = call; }
        hc = call;
        for (int i = 0; i < 16; ++i) {
            const float hf = HL[i * 64 + lane] + CP[i * 64 + lane] * cin;
            const int sp = cc * 128 + wid * 16 + i; const int tk = P.d ? Ls - 1 - sp : sp;
            P.Hout[(size_t)(rseg + tk) * 512 + chn] = (bf16)f2bf(hf);
        }
    }
    __syncthreads();
#undef LRU_LOAD
}
}

struct Args { const float* in[35]; float* out; unsigned char* ws; int ph_lo, ph_hi; };
constexpr int CTX_OFF = MISC_OFF + 128;
struct Ctx {
    static __device__ __forceinline__ unsigned long long ldp(int i) { int off_ = CTX_OFF + 8 * i; asm volatile("" : "+v"(off_)); const volatile LAS unsigned* p = (const volatile LAS unsigned*)((LAS unsigned char*)lds_raw + off_);
        const unsigned lo = __builtin_amdgcn_readfirstlane(p[0]), hi = __builtin_amdgcn_readfirstlane(p[1]); return ((unsigned long long)hi << 32) | lo; }
    __device__ __forceinline__ const float* in(int i) const { return (const float*)(const GAS float*)ldp(i); }
    __device__ __forceinline__ float* out() const { return (float*)(GAS float*)ldp(35); }
    __device__ __forceinline__ unsigned char* ws() const { return (unsigned char*)(GAS unsigned char*)ldp(36); }
};
enum { I_X = 0, I_C, I_CTX, I_CCTX, I_WMOD, I_BMOD, I_WIN, I_LAMQ, I_LAMK, I_ATTNG, I_LCW, I_LCB, I_LWA, I_LBA, I_LWI, I_LBI, I_LLAM, I_SCW, I_SCB, I_SDTB, I_SALOG, I_SD, I_SNG,
       I_WBR, I_WOUT, I_LN1G, I_LN1B, I_WRT, I_RBIAS, I_WUP, I_WDN, I_WSU, I_WSD, I_LN2G, I_LN2B };

__device__ __forceinline__ int map_win(int n) {
    if (n < 1024) { const int o = n & 63; return (n & ~63) + 2 * (o & 31) + (o >> 5); }
    if (n < 4096) return n;
    if (n < 4112) return ZC_DT + (n - 4096);
    return ZC_GATE + (n - 4112);
}
__device__ __forceinline__ int map_up(int n) { const int j = n & 255, isu = n >> 8; return (j >> 7) * 256 + isu * 128 + (j & 127); }
struct CvtMat { const float* src; bf16* dst; int ld, K, N, ldd, mode, ntile; };
__device__ __forceinline__ CvtMat cvt_mat(const Ctx a, int l, int m) {
    unsigned char* W = a.ws() + WS_W; CvtMat c;
    if (m == 0) { c.src = a.in(I_WIN) + (size_t)l * 1024 * IN_TOTAL; c.dst = (bf16*)(W + W_IN); c.ld = IN_TOTAL; c.K = 1024; c.N = IN_TOTAL; c.ldd = 1024; c.mode = 1; }
    else if (m < 4) { const int br = m - 1; c.src = a.in(I_WBR) + (size_t)(l * 3 + br) * 512 * 1024; c.dst = (bf16*)(W + W_BR) + (size_t)br * 1024 * 512; c.ld = 1024; c.K = 512; c.N = 1024; c.ldd = 512; c.mode = 0; }
    else if (m == 4) { c.src = a.in(I_WOUT) + (size_t)l * 1024 * 1024; c.dst = (bf16*)(W + W_OUT); c.ld = 1024; c.K = 1024; c.N = 1024; c.ldd = 1024; c.mode = 0; }
    else if (m == 5) { c.src = a.in(I_WSU) + (size_t)l * 1024 * 512; c.dst = (bf16*)(W + W_SU); c.ld = 512; c.K = 1024; c.N = 512; c.ldd = 1024; c.mode = 2; }
    else if (m == 6) { c.src = a.in(I_WSD) + (size_t)l * 256 * 1024; c.dst = (bf16*)(W + W_SD); c.ld = 1024; c.K = 256; c.N = 1024; c.ldd = 256; c.mode = 0; }
    else if (m < 71) { const int e = m - 7; c.src = a.in(I_WUP) + (size_t)(l * 64 + e) * 1024 * 512; c.dst = (bf16*)(W + W_UP) + (size_t)e * 512 * 1024; c.ld = 512; c.K = 1024; c.N = 512; c.ldd = 1024; c.mode = 2; }
    else { const int e = m - 71; c.src = a.in(I_WDN) + (size_t)(l * 64 + e) * 256 * 1024; c.dst = (bf16*)(W + W_DN) + (size_t)e * 1024 * 256; c.ld = 1024; c.K = 256; c.N = 1024; c.ldd = 256; c.mode = 0; }
    c.ntile = (c.K / 64) * ((c.N + 255) / 256); return c;
}
constexpr int CVT_T0 = 16 * 29, CVT_T1 = CVT_T0 + 96, CVT_T2 = CVT_T1 + 64, CVT_T3 = CVT_T2 + 32, CVT_T4 = CVT_T3 + 16, CVT_T5 = CVT_T4 + 2048, CVT_NT = CVT_T5 + 1024;
__device__ __forceinline__ void cvt_locate(int it, int& m, int& r) {
    if (it < CVT_T0) { m = 0; r = it; } else if (it < CVT_T1) { const int q = it - CVT_T0; m = 1 + q / 32; r = q % 32; } else if (it < CVT_T2) { m = 4; r = it - CVT_T1; }
    else if (it < CVT_T3) { m = 5; r = it - CVT_T2; } else if (it < CVT_T4) { m = 6; r = it - CVT_T3; } else if (it < CVT_T5) { const int q = it - CVT_T4; m = 7 + q / 32; r = q % 32; }
    else { const int q = it - CVT_T5; m = 71 + q / 16; r = q % 16; }
}
__device__ __forceinline__ void convert_layer_weights(const Ctx a, int l, LAS float* scr) {
    const int tid = otid();
    for (int r = blockIdx.x; r < 16; r += gridDim.x) { const float* wr = a.in(I_WRT) + (size_t)l * 1024 * 64; bf16* o = (bf16*)(a.ws() + WS_W + W_RT);
        for (int i = r * 4096 + tid; i < (r + 1) * 4096; i += 512) { const int k = i >> 6, n = i & 63; const float v = wr[i]; const unsigned hi = f2bf(v); const unsigned lo = f2bf(v - bf2f(hi));
            o[(size_t)n * 2048 + k] = (bf16)hi; o[(size_t)n * 2048 + 1024 + k] = (bf16)hi; o[(size_t)(128 + n) * 2048 + k] = (bf16)lo; o[(size_t)(128 + n) * 2048 + 1024 + k] = (bf16)0; } }
    f32x4 st[8];
    int it = osg((int)blockIdx.x); int m = 0, r = 0; CvtMat c; bool have = it < CVT_NT;
#define CVT_LOAD() do { cvt_locate(it, m, r); c = cvt_mat(a, l, m); const int nblk_ = (c.N + 255) >> 8; const int kb_ = r / nblk_, nb_ = r - kb_ * nblk_; const int n_ = nb_ * 256 + 4 * (tid & 63); \
        _Pragma("unroll") for (int i_ = 0; i_ < 8; ++i_) { const int kk_ = kb_ * 64 + (tid >> 6) + 8 * i_; st[i_] = (n_ < c.N) ? *(const f32x4*)(c.src + (size_t)kk_ * c.ld + n_) : (f32x4){0.f, 0.f, 0.f, 0.f}; } } while (0)
    if (have) CVT_LOAD();
    while (have) {
        const int nblk = (c.N + 255) >> 8; const int kb = r / nblk, nb = r - kb * nblk; const int k0 = kb * 64, n0 = nb * 256;
        const int mode = c.mode, N = c.N, ldd = c.ldd; bf16* dst = c.dst;
#pragma unroll
        for (int i = 0; i < 8; ++i) { const int kk_ = (tid >> 6) + 8 * i; *(LAS f32x4*)(scr + kk_ * 260 + (((tid & 63) ^ ((kk_ >> 3) & 7)) << 2)) = st[i]; }
        it += gridDim.x; have = it < CVT_NT;
        if (have) CVT_LOAD();
        __syncthreads();
#pragma unroll
        for (int j = 0; j < 4; ++j) { const int q = tid + 512 * j; const int nn = q >> 3, kc = (q & 7) * 8, n = n0 + nn;
            if (n < N) { const LAS float* sp = scr + kc * 260 + ((((nn >> 2) ^ ((kc >> 3) & 7)) << 2) | (nn & 3));
                u32x4 o; o.x = cvt_pk_bf16(sp[0], sp[260]); o.y = cvt_pk_bf16(sp[2 * 260], sp[3 * 260]); o.z = cvt_pk_bf16(sp[4 * 260], sp[5 * 260]); o.w = cvt_pk_bf16(sp[6 * 260], sp[7 * 260]);
                const int rr = mode == 1 ? map_win(n) : (mode == 2 ? map_up(n) : n);
                *(u32x4*)(dst + (size_t)rr * ldd + k0 + kc) = o; } }
        __syncthreads();
    }
#undef CVT_LOAD
}

__device__ __forceinline__ void phase_mod_rope(const Ctx a, LAS float* lds) {
    const int tid = otid();
    float* mod = (float*)(a.ws() + WS_MOD); float* cosT = (float*)(a.ws() + WS_ROPE); float* sinT = cosT + 4096 * 32;
    LAS float* S = lds; LAS float* RED = lds + 9 * 1024;
    for (int i = tid; i < 9 * 1024; i += 512) { const float v = i < 8192 ? a.in(I_C)[i] : a.in(I_CCTX)[i - 8192]; S[i] = siluf_(v); }
    __syncthreads();
    for (int un = blockIdx.x; un < 2 * 96; un += gridDim.x) {
        const int l = un / 96, cb = un % 96, kg = tid >> 6, j = tid & 63, col = cb * 64 + j;
        const float* w = a.in(I_WMOD) + (size_t)l * 1024 * 6144 + col;
        float acc[9];
#pragma unroll
        for (int r = 0; r < 9; ++r) acc[r] = 0.f;
        for (int k = kg * 128; k < kg * 128 + 128; ++k) { const float wv = w[(size_t)k * 6144];
#pragma unroll
            for (int r = 0; r < 9; ++r) acc[r] += S[r * 1024 + k] * wv; }
#pragma unroll
        for (int r = 0; r < 9; ++r) RED[(kg * 9 + r) * 64 + j] = acc[r];
        __syncthreads();
        for (int o = tid; o < 9 * 64; o += 512) { const int r = o >> 6, jj = o & 63; float s = a.in(I_BMOD)[l * 6144 + cb * 64 + jj];
#pragma unroll
            for (int g = 0; g < 8; ++g) s += RED[(g * 9 + r) * 64 + jj];
            mod[((size_t)l * 9 + r) * 6144 + cb * 64 + jj] = s; }
        __syncthreads();
    }
    for (int i = blockIdx.x * 512 + tid; i < 4096 * 32; i += gridDim.x * 512) {
        const int t = i >> 5, f = i & 31; const float pos = (float)(f < 16 ? (t >> 6) : (t & 63));
        const float inv = powf(10000.0f, -(float)(f & 15) / 16.0f); const float ang = pos * inv;
        cosT[i] = cosf(ang); sinT[i] = sinf(ang);
    }
}

__device__ __forceinline__ const float* xrow_in(const Ctx a, int l, int row) {
    if (l == 0) return row < NLAT ? a.in(I_X) + (size_t)row * 1024 : a.in(I_CTX) + (size_t)(row - NLAT) * 1024;
    return (const float*)(a.ws() + WS_X) + (size_t)row * 1024;
}
template <bool M8 = false> __device__ __forceinline__ int lncol(int lane, int j) { return M8 ? ((j >> 1) * 512 + 8 * lane + (j & 1) * 4) : (4 * lane + 256 * j); }
template <bool M8 = false>
__device__ __forceinline__ void store_h_row(bf16* hrow, const f32x4 (&v)[4], const float* m0, const float* m1, int lane) {
    u32x2 w[4];
#pragma unroll
    for (int j = 0; j < 4; ++j) { const int c = lncol<M8>(lane, j); const f32x4 s = *(const f32x4*)(m1 + c), t = *(const f32x4*)(m0 + c);
        w[j].x = cvt_pk_bf16(v[j][0] * (1.f + s[0]) + t[0], v[j][1] * (1.f + s[1]) + t[1]); w[j].y = cvt_pk_bf16(v[j][2] * (1.f + s[2]) + t[2], v[j][3] * (1.f + s[3]) + t[3]); }
    if (M8) {
#pragma unroll
        for (int jj = 0; jj < 2; ++jj) *(u32x4*)(hrow + 8 * lane + 512 * jj) = (u32x4){w[2 * jj].x, w[2 * jj].y, w[2 * jj + 1].x, w[2 * jj + 1].y};
    } else {
#pragma unroll
        for (int j = 0; j < 4; ++j) *(u32x2*)(hrow + lncol<false>(lane, j)) = w[j];
    }
}
template <bool M8 = false>
__device__ __forceinline__ void layer_norm_row(f32x4 (&v)[4], const float* g, const float* b, int lane) {
    float s = 0.f;
#pragma unroll
    for (int j = 0; j < 4; ++j) s += (v[j][0] + v[j][1]) + (v[j][2] + v[j][3]);
    const float mean = wave_sum(s) * (1.f / 1024.f); float q = 0.f;
#pragma unroll
    for (int j = 0; j < 4; ++j) { v[j] = v[j] - mean; q += (v[j][0] * v[j][0] + v[j][1] * v[j][1]) + (v[j][2] * v[j][2] + v[j][3] * v[j][3]); }
    const float rstd = __builtin_amdgcn_rsqf(wave_sum(q) * (1.f / 1024.f) + LN_EPS);
#pragma unroll
    for (int j = 0; j < 4; ++j) { const int c = lncol<M8>(lane, j); const f32x4 gg = *(const f32x4*)(g + c), bb = *(const f32x4*)(b + c); v[j] = v[j] * rstd * gg + bb; }
}
__device__ __forceinline__ void phase_modulate0(const Ctx a) {
    const int tid_ = otid(); const int lane = tid_ & 63, gw = blockIdx.x * 8 + (tid_ >> 6), NGW = gridDim.x * 8;
    const float* mod = (const float*)(a.ws() + WS_MOD); bf16* H = (bf16*)(a.ws() + WS_H);
    for (int row = gw; row < MTOK; row += NGW) {
        const float* xr = xrow_in(a, 0, row); const int mr = row < NLAT ? (row >> 12) : 8; const float* mm = mod + (size_t)mr * 6144;
        f32x4 v[4];
#pragma unroll
        for (int j = 0; j < 4; ++j) v[j] = *(const f32x4*)(xr + lncol<true>(lane, j));
        store_h_row<true>(H + (size_t)row * 1024, v, mm, mm + 1024, lane);
    }
}
__device__ __forceinline__ void phase_scan_prep(const Ctx a, int l) {
    const int tid = otid(), lane = tid & 63;
    const bf16* ZZ = (const bf16*)(a.ws() + WS_ZZ); bf16* XA = (bf16*)(a.ws() + WS_H); float* DT = (float*)(a.ws() + WS_LOGIT); float* ACS = DT + (size_t)MTOK * 16;
    const float* cw = a.in(I_SCW) + (size_t)l * 4 * 1024; const float* cb = a.in(I_SCB) + l * 1024;
    for (int it = blockIdx.x * 512 + tid; it < (MTOK / 4) * 128; it += gridDim.x * 512) {
        const int oc = it & 127, row0 = (it >> 7) * 4, c0 = oc * 8;
        int segbase, Ls; if (row0 < NLAT) { segbase = row0 & ~(SEQ - 1); Ls = SEQ; } else { segbase = NLAT + ((row0 - NLAT) & ~(CTXL - 1)); Ls = CTXL; }
        const int t0 = row0 - segbase;
        float w[4][8], acc[4][8];
#pragma unroll
        for (int j = 0; j < 4; ++j) { const f32x4 w0 = *(const f32x4*)(cw + j * 1024 + c0), w1 = *(const f32x4*)(cw + j * 1024 + c0 + 4);
            w[j][0] = w0[0]; w[j][1] = w0[1]; w[j][2] = w0[2]; w[j][3] = w0[3]; w[j][4] = w1[0]; w[j][5] = w1[1]; w[j][6] = w1[2]; w[j][7] = w1[3]; }
        { const f32x4 b0 = *(const f32x4*)(cb + c0), b1 = *(const f32x4*)(cb + c0 + 4);
#pragma unroll
          for (int o = 0; o < 4; ++o) { acc[o][0] = b0[0]; acc[o][1] = b0[1]; acc[o][2] = b0[2]; acc[o][3] = b0[3]; acc[o][4] = b1[0]; acc[o][5] = b1[1]; acc[o][6] = b1[2]; acc[o][7] = b1[3]; } }
        u32x4 xr[7];
#pragma unroll
        for (int jr = 0; jr < 7; ++jr) { const int t = t0 - 2 + jr; const int tc = t < 0 ? 0 : (t >= Ls ? Ls - 1 : t); xr[jr] = *(const u32x4*)(ZZ + (size_t)(segbase + tc) * ZLD + ZC_XBC + c0); }
#pragma unroll
        for (int jr = 0; jr < 7; ++jr) { const int t = t0 - 2 + jr;
            if (t >= 0 && t < Ls) { const u32x4 xv = xr[jr];
                float x[8]; x[0] = bflo(xv.x); x[1] = bfhi(xv.x); x[2] = bflo(xv.y); x[3] = bfhi(xv.y); x[4] = bflo(xv.z); x[5] = bfhi(xv.z); x[6] = bflo(xv.w); x[7] = bfhi(xv.w);
#pragma unroll
                for (int o = 0; o < 4; ++o) { const int j = jr - o; if (j >= 0 && j < 4) {
#pragma unroll
                    for (int e = 0; e < 8; ++e) acc[o][e] += x[e] * w[j][e]; } } } }
#pragma unroll
        for (int o = 0; o < 4; ++o) { u32x4 ov; ov.x = cvt_pk_bf16(siluf_(acc[o][0]), siluf_(acc[o][1])); ov.y = cvt_pk_bf16(siluf_(acc[o][2]), siluf_(acc[o][3])); ov.z = cvt_pk_bf16(siluf_(acc[o][4]), siluf_(acc[o][5])); ov.w = cvt_pk_bf16(siluf_(acc[o][6]), siluf_(acc[o][7]));
            *(u32x4*)(XA + (size_t)(row0 + o) * 1024 + c0) = ov; }
    }
    for (int blk = blockIdx.x * 8 + (tid >> 6); blk < MTOK / 64; blk += gridDim.x * 8) {
        const int row = blk * 64 + lane;
        const u32x4 r0 = *(const u32x4*)(ZZ + (size_t)row * ZLD + ZC_DT), r1 = *(const u32x4*)(ZZ + (size_t)row * ZLD + ZC_DT + 8);
        float raw[16];
        raw[0] = bflo(r0.x); raw[1] = bfhi(r0.x); raw[2] = bflo(r0.y); raw[3] = bfhi(r0.y); raw[4] = bflo(r0.z); raw[5] = bfhi(r0.z); raw[6] = bflo(r0.w); raw[7] = bfhi(r0.w);
        raw[8] = bflo(r1.x); raw[9] = bfhi(r1.x); raw[10] = bflo(r1.y); raw[11] = bfhi(r1.y); raw[12] = bflo(r1.z); raw[13] = bfhi(r1.z); raw[14] = bflo(r1.w); raw[15] = bfhi(r1.w);
        float dtv[16], acv[16];
#pragma unroll
        for (int c = 0; c < 16; ++c) {
            const float dt = softplusf_(raw[c] + a.in(I_SDTB)[l * 16 + c]); float v = dt * -__expf(a.in(I_SALOG)[l * 16 + c]);
            if (c < 8) {
#pragma unroll
                for (int off = 1; off < 64; off <<= 1) { const float t = __shfl_up(v, off); if (lane >= off) v += t; }
            } else {
#pragma unroll
                for (int off = 1; off < 64; off <<= 1) { const float t = __shfl_down(v, off); if (lane + off < 64) v += t; }
            }
            dtv[c] = dt; acv[c] = v;
        }
#pragma unroll
        for (int c4 = 0; c4 < 4; ++c4) { *(f32x4*)(DT + (size_t)row * 16 + c4 * 4) = (f32x4){dtv[c4 * 4], dtv[c4 * 4 + 1], dtv[c4 * 4 + 2], dtv[c4 * 4 + 3]};
            *(f32x4*)(ACS + (size_t)row * 16 + c4 * 4) = (f32x4){acv[c4 * 4], acv[c4 * 4 + 1], acv[c4 * 4 + 2], acv[c4 * 4 + 3]}; }
    }
}
__device__ __forceinline__ void phase_mixer_finalize(const Ctx a, int l, int nrows, bool dry = false) {
    const int tid_ = otid(); const int lane = tid_ & 63, gw = blockIdx.x * 8 + (tid_ >> 6), NGW = gridDim.x * 8;
    bf16* ZZ = (bf16*)(a.ws() + WS_ZZ); const bf16* SCR = (const bf16*)(a.ws() + WS_ACT); const size_t SS_ = (size_t)MTOK * 512;
    const float* ng = a.in(I_SNG) + l * 512 + 8 * lane;
    const f32x4 g0 = *(const f32x4*)ng, g1 = *(const f32x4*)(ng + 4);
    for (int row = gw; row < nrows; row += NGW) {
        const size_t so = (size_t)row * 512 + 8 * lane;
        const u32x4 h0 = *(const u32x4*)(SCR + so), h1 = *(const u32x4*)(SCR + SS_ + so), y0 = *(const u32x4*)(SCR + 2 * SS_ + so), y1 = *(const u32x4*)(SCR + 3 * SS_ + so);
        bf16* zr = ZZ + (size_t)row * ZLD;
        const u32x4 lg = *(const u32x4*)(zr + ZC_LG + 8 * lane), zz = *(const u32x4*)(zr + ZC_Z + 8 * lane);
        float hb[8], t[8], lgv[8], zv[8];
        hb[0] = bflo(h0.x) + bflo(h1.x); hb[1] = bfhi(h0.x) + bfhi(h1.x); hb[2] = bflo(h0.y) + bflo(h1.y); hb[3] = bfhi(h0.y) + bfhi(h1.y);
        hb[4] = bflo(h0.z) + bflo(h1.z); hb[5] = bfhi(h0.z) + bfhi(h1.z); hb[6] = bflo(h0.w) + bflo(h1.w); hb[7] = bfhi(h0.w) + bfhi(h1.w);
        t[0] = bflo(y0.x) + bflo(y1.x); t[1] = bfhi(y0.x) + bfhi(y1.x); t[2] = bflo(y0.y) + bflo(y1.y); t[3] = bfhi(y0.y) + bfhi(y1.y);
        t[4] = bflo(y0.z) + bflo(y1.z); t[5] = bfhi(y0.z) + bfhi(y1.z); t[6] = bflo(y0.w) + bflo(y1.w); t[7] = bfhi(y0.w) + bfhi(y1.w);
        lgv[0] = bflo(lg.x); lgv[1] = bfhi(lg.x); lgv[2] = bflo(lg.y); lgv[3] = bfhi(lg.y); lgv[4] = bflo(lg.z); lgv[5] = bfhi(lg.z); lgv[6] = bflo(lg.w); lgv[7] = bfhi(lg.w);
        zv[0] = bflo(zz.x); zv[1] = bfhi(zz.x); zv[2] = bflo(zz.y); zv[3] = bfhi(zz.y); zv[4] = bflo(zz.z); zv[5] = bfhi(zz.z); zv[6] = bflo(zz.w); zv[7] = bfhi(zz.w);
        float ss = 0.f;
#pragma unroll
        for (int e = 0; e < 8; ++e) { hb[e] *= gelu_tanh(lgv[e]); t[e] *= siluf_(zv[e]); ss += t[e] * t[e]; }
#pragma unroll
        for (int off = 1; off < 32; off <<= 1) ss += __shfl_xor(ss, off);
        const float ri = __builtin_amdgcn_rsqf(ss * (1.f / 256.f) + RMS_EPS);
        u32x4 wb, wc;
        wb.x = cvt_pk_bf16(hb[0], hb[1]); wb.y = cvt_pk_bf16(hb[2], hb[3]); wb.z = cvt_pk_bf16(hb[4], hb[5]); wb.w = cvt_pk_bf16(hb[6], hb[7]);
        wc.x = cvt_pk_bf16(t[0] * ri * g0[0], t[1] * ri * g0[1]); wc.y = cvt_pk_bf16(t[2] * ri * g0[2], t[3] * ri * g0[3]);
        wc.z = cvt_pk_bf16(t[4] * ri * g1[0], t[5] * ri * g1[1]); wc.w = cvt_pk_bf16(t[6] * ri * g1[2], t[7] * ri * g1[3]);
        if (!dry) { *(u32x4*)(zr + ZC_LG + 8 * lane) = wb; *(u32x4*)(zr + ZC_Z + 8 * lane) = wc; } else asm volatile("" :: "v"(wb), "v"(wc));
    }
}
template <bool XBF>
__device__ __forceinline__ void phase_ln1(const Ctx a, int l, int nrows, bool dry = false) {
    const int tid_ = otid(); const int lane = tid_ & 63, gw = blockIdx.x * 8 + (tid_ >> 6), NGW = gridDim.x * 8;
    const float* mod = (const float*)(a.ws() + WS_MOD) + (size_t)l * 9 * 6144; bf16* X = (bf16*)(a.ws() + WS_X); const bf16* ZZ = (const bf16*)(a.ws() + WS_ZZ);
    const float* g = a.in(I_LN1G) + l * 1024; const float* b = a.in(I_LN1B) + l * 1024;
    constexpr int NXR = XBF ? 2 : 4;
    u32x4 xv[NXR], xn[NXR], xn2[NXR]; u32x4 mw[2], mn[2], mn2[2];
#define LN1_LOAD(row_, xr_, mr_) do { const bf16* mx_ = ZZ + (size_t)(row_) * ZLD + ZC_MIX; \
        if (XBF) { const bf16* xp_ = X + (size_t)(row_) * 1024; _Pragma("unroll") for (int j = 0; j < 2; ++j) xr_[j] = *(const u32x4*)(xp_ + 8 * lane + 512 * j); } \
        else { const float* xp_ = xrow_in(a, 0, (row_)); _Pragma("unroll") for (int j = 0; j < 4; ++j) xr_[j] = *(const u32x4*)(xp_ + lncol<true>(lane, j)); } \
        _Pragma("unroll") for (int j = 0; j < 2; ++j) mr_[j] = *(const u32x4*)(mx_ + 8 * lane + 512 * j); } while (0)
    if (gw < nrows) LN1_LOAD(gw, xv, mw);
    if (gw + NGW < nrows) LN1_LOAD(gw + NGW, xn, mn);
    for (int row = gw; row < nrows; row += NGW) {
        if (row + 2 * NGW < nrows) LN1_LOAD(row + 2 * NGW, xn2, mn2);
        const int mr = row < NLAT ? (row >> 12) : 8; const float* mm = mod + (size_t)mr * 6144;
        f32x4 v[4];
#pragma unroll
        for (int j = 0; j < 4; ++j) { const int c = lncol<true>(lane, j); const f32x4 gt = *(const f32x4*)(mm + 2 * 1024 + c);
            const unsigned m0_ = (j & 1) ? mw[j >> 1].z : mw[j >> 1].x, m1_ = (j & 1) ? mw[j >> 1].w : mw[j >> 1].y;
            f32x4 xf;
            if (XBF) { const unsigned x0_ = (j & 1) ? xv[j >> 1].z : xv[j >> 1].x, x1_ = (j & 1) ? xv[j >> 1].w : xv[j >> 1].y; xf[0] = bflo(x0_); xf[1] = bfhi(x0_); xf[2] = bflo(x1_); xf[3] = bfhi(x1_); }
            else { xf[0] = __uint_as_float(xv[j % NXR].x); xf[1] = __uint_as_float(xv[j % NXR].y); xf[2] = __uint_as_float(xv[j % NXR].z); xf[3] = __uint_as_float(xv[j % NXR].w); }
            v[j][0] = DN_ALPHA * xf[0] + gt[0] * bflo(m0_); v[j][1] = DN_ALPHA * xf[1] + gt[1] * bfhi(m0_); v[j][2] = DN_ALPHA * xf[2] + gt[2] * bflo(m1_); v[j][3] = DN_ALPHA * xf[3] + gt[3] * bfhi(m1_); }
        layer_norm_row<true>(v, g, b, lane);
        bf16* xo = X + (size_t)row * 1024;
#pragma unroll
        for (int jj = 0; jj < 2; ++jj) { u32x4 w; w.x = cvt_pk_bf16(v[2 * jj][0], v[2 * jj][1]); w.y = cvt_pk_bf16(v[2 * jj][2], v[2 * jj][3]); w.z = cvt_pk_bf16(v[2 * jj + 1][0], v[2 * jj + 1][1]); w.w = cvt_pk_bf16(v[2 * jj + 1][2], v[2 * jj + 1][3]);
            if (!dry) *(u32x4*)(xo + 8 * lane + 512 * jj) = w; else asm volatile("" :: "v"(w)); }
        if (!dry) { bf16* hrow = (bf16*)(a.ws() + WS_ZZ) + (size_t)row * ZLD + ZC_H2; const float* m3 = mm + 3 * 1024; const float* m4 = mm + 4 * 1024;
#pragma unroll
          for (int jj = 0; jj < 2; ++jj) { u32x4 w, wl;
#pragma unroll
              for (int q = 0; q < 2; ++q) { const int j = 2 * jj + q; const int c = lncol<true>(lane, j); const f32x4 sc = *(const f32x4*)(m4 + c), sh = *(const f32x4*)(m3 + c);
                  float hv[4]; unsigned hh[4], hl[4];
#pragma unroll
                  for (int e = 0; e < 4; ++e) { hv[e] = v[j][e] * (1.f + sc[e]) + sh[e]; hh[e] = f2bf(hv[e]); hl[e] = f2bf(hv[e] - bf2f(hh[e])); }
                  if (q == 0) { w.x = hh[0] | (hh[1] << 16); w.y = hh[2] | (hh[3] << 16); wl.x = hl[0] | (hl[1] << 16); wl.y = hl[2] | (hl[3] << 16); }
                  else        { w.z = hh[0] | (hh[1] << 16); w.w = hh[2] | (hh[3] << 16); wl.z = hl[0] | (hl[1] << 16); wl.w = hl[2] | (hl[3] << 16); } }
              *(u32x4*)(hrow + 8 * lane + 512 * jj) = w; *(u32x4*)(hrow + 1024 + 8 * lane + 512 * jj) = wl; } }
#pragma unroll
        for (int j = 0; j < NXR; ++j) { xv[j] = xn[j]; xn[j] = xn2[j]; }
#pragma unroll
        for (int j = 0; j < 2; ++j) { mw[j] = mn[j]; mn[j] = mn2[j]; }
    }
#undef LN1_LOAD
}
__device__ __forceinline__ void phase_ln2(const Ctx a, int l, int nrows, bool dry = false) {
    const int tid_ = otid(); const int lane = tid_ & 63, gw = blockIdx.x * 8 + (tid_ >> 6), NGW = gridDim.x * 8;
    const float* mod = (const float*)(a.ws() + WS_MOD) + (size_t)l * 9 * 6144; const float* modn = (const float*)(a.ws() + WS_MOD) + (size_t)(l + 1) * 9 * 6144;
    bf16* H = (bf16*)(a.ws() + WS_ACT); bf16* X = (bf16*)(a.ws() + WS_X); const bf16* YE = (const bf16*)(a.ws() + WS_YE); const int* tslot = (const int*)(a.ws() + WS_TSLOT);
    const float* g = a.in(I_LN2G) + l * 1024; const float* b = a.in(I_LN2B) + l * 1024;
    const bool last = (l == DEPTH - 1);
    int sl_c = 0, sl_n = 0;
    u32x4 yv[8][2], yn[8][2]; u32x4 xv[2], xn[2];
#define LN2_SLOT(row_, dst_) do { dst_ = (lane < 8) ? tslot[(row_) * 8 + lane] : 0; } while (0)
#define LN2_LOAD(row_, sl_, yr_, xr_) do { \
        _Pragma("unroll") for (int k = 0; k < 8; ++k) { const int slot_ = __builtin_amdgcn_readlane((sl_), k); const bf16* yp_ = YE + (size_t)slot_ * 1024; \
            _Pragma("unroll") for (int j = 0; j < 2; ++j) yr_[k][j] = *(const u32x4*)(yp_ + 8 * lane + 512 * j); } \
        _Pragma("unroll") for (int j = 0; j < 2; ++j) xr_[j] = *(const u32x4*)(X + (size_t)(row_) * 1024 + 8 * lane + 512 * j); } while (0)
    if (gw < nrows) { LN2_SLOT(gw, sl_c); LN2_LOAD(gw, sl_c, yv, xv); }
    if (gw + NGW < nrows) LN2_SLOT(gw + NGW, sl_n);
    for (int row = gw; row < nrows; row += NGW) {
        const bool hn = row + NGW < nrows;
        if (hn) LN2_LOAD(row + NGW, sl_n, yn, xn);
        int sl_nn = 0; if (row + 2 * NGW < nrows) LN2_SLOT(row + 2 * NGW, sl_nn);
        const int mr = row < NLAT ? (row >> 12) : 8; const float* mm = mod + (size_t)mr * 6144;
        bf16* xo = X + (size_t)row * 1024;
        f32x4 v[4];
#pragma unroll
        for (int j = 0; j < 4; ++j) { f32x4 f = (f32x4){0.f, 0.f, 0.f, 0.f};
#pragma unroll
            for (int k = 0; k < 8; ++k) { const unsigned y0 = (j & 1) ? yv[k][j >> 1].z : yv[k][j >> 1].x, y1 = (j & 1) ? yv[k][j >> 1].w : yv[k][j >> 1].y;
                f[0] += bflo(y0); f[1] += bfhi(y0); f[2] += bflo(y1); f[3] += bfhi(y1); }
            const unsigned x0_ = (j & 1) ? xv[j >> 1].z : xv[j >> 1].x, x1_ = (j & 1) ? xv[j >> 1].w : xv[j >> 1].y; const f32x4 xf = (f32x4){bflo(x0_), bfhi(x0_), bflo(x1_), bfhi(x1_)};
            const int c = lncol<true>(lane, j); v[j] = xf + *(const f32x4*)(mm + 5 * 1024 + c) * f; }
        layer_norm_row<true>(v, g, b, lane);
        if (dry) { asm volatile("" :: "v"(v[0]), "v"(v[1]), "v"(v[2]), "v"(v[3])); }
        else if (last) { float* o = a.out() + (size_t)row * 1024;
#pragma unroll
            for (int j = 0; j < 4; ++j) *(f32x4*)(o + lncol<true>(lane, j)) = v[j];
        } else {
#pragma unroll
            for (int jj = 0; jj < 2; ++jj) { u32x4 w; w.x = cvt_pk_bf16(v[2 * jj][0], v[2 * jj][1]); w.y = cvt_pk_bf16(v[2 * jj][2], v[2 * jj][3]); w.z = cvt_pk_bf16(v[2 * jj + 1][0], v[2 * jj + 1][1]); w.w = cvt_pk_bf16(v[2 * jj + 1][2], v[2 * jj + 1][3]);
                *(u32x4*)(xo + 8 * lane + 512 * jj) = w; }
            const float* mn = modn + (size_t)mr * 6144;
            store_h_row<true>(H + (size_t)row * 1024, v, mn, mn + 1024, lane);
        }
#pragma unroll
        for (int k = 0; k < 8; ++k)
#pragma unroll
            for (int j = 0; j < 2; ++j) yv[k][j] = yn[k][j];
#pragma unroll
        for (int j = 0; j < 2; ++j) xv[j] = xn[j];
        sl_n = sl_nn;
    }
#undef LN2_SLOT
#undef LN2_LOAD
}

__device__ __forceinline__ void phase_route_a(const Ctx a, int l, int ntok, LAS unsigned* hist) {
    const int tid = otid(), lane = tid & 63, wid = tid >> 6;
    const float* L = (const float*)(a.ws() + WS_LOGIT); int* selE = (int*)(a.ws() + WS_SELE); float* selW = (float*)(a.ws() + WS_SELW); int* selR = (int*)(a.ws() + WS_SELR); int* wgh = (int*)(a.ws() + WS_WGHIST);
    if (tid < 64) hist[tid] = 0u;
    __syncthreads();
    const float bias = a.in(I_RBIAS)[l * 64 + lane];
    const int tpw = (ntok + gridDim.x - 1) / gridDim.x; const int t0 = blockIdx.x * tpw, t1 = min(ntok, t0 + tpw);
    float lg_c = (t0 + wid < t1) ? L[(size_t)(t0 + wid) * 64 + lane] : 0.f;
    for (int row = t0 + wid; row < t1; row += 8) {
        const float lg_n = (row + 8 < t1) ? L[(size_t)(row + 8) * 64 + lane] : 0.f;
        const float s = sigmoidf_(lg_c); const float sel = s + bias; lg_c = lg_n;
        float m1 = sel;
        m1 = fmaxf(m1, __shfl_xor(m1, 1)); m1 = fmaxf(m1, __shfl_xor(m1, 2)); m1 = fmaxf(m1, __shfl_xor(m1, 4));
        const unsigned long long bm = __ballot(sel == m1); const unsigned gbits = (unsigned)((bm >> (lane & ~7)) & 0xffull);
        const int first = (lane & ~7) + (__ffs(gbits) - 1);
        float m2 = (lane == first) ? -INFINITY : sel;
        m2 = fmaxf(m2, __shfl_xor(m2, 1)); m2 = fmaxf(m2, __shfl_xor(m2, 2)); m2 = fmaxf(m2, __shfl_xor(m2, 4));
        const float gs = m1 + m2; const int myg = lane >> 3;
        int grank = 0;
#pragma unroll
        for (int gq = 0; gq < 8; ++gq) { const float o = __builtin_bit_cast(float, __builtin_amdgcn_readlane(__builtin_bit_cast(int, gs), gq * 8)); grank += (o > gs || (o == gs && gq < myg)) ? 1 : 0; }
        const float sel2 = grank < 4 ? sel : -INFINITY;
        int erank = 0;
#pragma unroll 4
        for (int e = 0; e < 64; ++e) { const float o = __builtin_bit_cast(float, __builtin_amdgcn_readlane(__builtin_bit_cast(int, sel2), e)); erank += (o > sel2 || (o == sel2 && e < lane)) ? 1 : 0; }
        const bool chosen = (erank < 8) && (grank < 4);
        const unsigned long long cm = __ballot(chosen);
        const float wsum = wave_sum(chosen ? s : 0.f);
        if (chosen) {
            const int kidx = __popcll(cm & ((1ull << lane) - 1ull));
            const unsigned rk = __hip_atomic_fetch_add(&hist[lane], 1u, __ATOMIC_RELAXED, __HIP_MEMORY_SCOPE_WORKGROUP);
            selE[row * 8 + kidx] = lane; selW[row * 8 + kidx] = s / wsum * 2.5f; selR[row * 8 + kidx] = (int)rk;
        }
    }
    __syncthreads();
    if (tid < 64) wgh[blockIdx.x * 64 + tid] = (int)hist[tid];
}
__device__ __forceinline__ void phase_route_b(const Ctx a, int ntok, LAS int* sm) {
    const int tid = otid(), lane = tid & 63, wid = tid >> 6;
    const int* selE = (const int*)(a.ws() + WS_SELE); const float* selW = (const float*)(a.ws() + WS_SELW); const int* selR = (const int*)(a.ws() + WS_SELR); const int* wgh = (const int*)(a.ws() + WS_WGHIST);
    int* tslot = (int*)(a.ws() + WS_TSLOT); int* rowtok = (int*)(a.ws() + WS_ROWTOK); float* roww = (float*)(a.ws() + WS_ROWW); int* tileE = (int*)(a.ws() + WS_TILEE); int* ntiles = (int*)(a.ws() + WS_NTILES);
    LAS int* OFF = sm; LAS int* CNT = sm + 64; LAS int* PST = sm + 128; LAS int* PEN = sm + 192;
    {
        int cnt = 0, base = 0; const int wbeg = wid * ((int)gridDim.x / 8), wend = wid == 7 ? (int)gridDim.x : wbeg + (int)gridDim.x / 8;
        for (int w = wbeg; w < wend; w += 8) { int v[8];
#pragma unroll
            for (int j = 0; j < 8; ++j) v[j] = (w + j < wend) ? wgh[(w + j) * 64 + lane] : 0;
#pragma unroll
            for (int j = 0; j < 8; ++j) { cnt += v[j]; if (w + j < (int)blockIdx.x) base += v[j]; } }
        sm[256 + wid * 64 + lane] = cnt; sm[256 + 512 + wid * 64 + lane] = base; }
    __syncthreads();
    if (wid == 0) {
        int cnt = 0, base = 0;
#pragma unroll
        for (int w = 0; w < 8; ++w) { cnt += sm[256 + w * 64 + lane]; base += sm[256 + 512 + w * 64 + lane]; }
        const int padded = (cnt + 255) & ~255; int inc = padded;
#pragma unroll
        for (int off = 1; off < 64; off <<= 1) { const int t = __shfl_up(inc, off); if (lane >= off) inc += t; }
        OFF[lane] = inc - padded + base; CNT[lane] = cnt; PST[lane] = inc - padded; PEN[lane] = inc;
    }
    __syncthreads();
    const int tpw = (ntok + gridDim.x - 1) / gridDim.x; const int t0 = blockIdx.x * tpw, t1 = min(ntok, t0 + tpw);
    for (int i = t0 * 8 + tid; i < t1 * 8; i += 512) { const int e = selE[i]; const int slot = OFF[e] + selR[i]; tslot[i] = slot; rowtok[slot] = i >> 3; roww[slot] = selW[i]; }
    for (int e = blockIdx.x; e < 64; e += gridDim.x) {
        const int ps = PST[e], pe = PEN[e], cn = CNT[e];
        for (int i = ps + cn + tid; i < pe; i += 512) { rowtok[i] = 0; roww[i] = 0.f; }
        for (int t = (ps >> 8) + tid; t < (pe >> 8); t += 512) tileE[t] = e;
    }
    if (blockIdx.x == 0 && tid == 0) *ntiles = PEN[63] >> 8;
}

#ifndef MK_PER_PHASE
#define MK_PER_PHASE 0
#endif
constexpr int NPHASE = 2 + 13 * DEPTH;

__global__ void __launch_bounds__(512, 2) mega_fwd(Args ka) {
    LAS unsigned char* lds0 = (LAS unsigned char*)lds_raw;
#define lds (olds())
    volatile LAS unsigned* MISC = (volatile LAS unsigned*)(lds0 + MISC_OFF);
    { const int t0_ = threadIdx.x; const unsigned key_ = (unsigned)__builtin_amdgcn_s_getreg(((6 - 1) << 11) | 4) & 63u;
      if ((t0_ & 63) == 0) *(volatile LAS unsigned*)(lds0 + WVTAB_OFF + key_ * 4) = (unsigned)(t0_ >> 6);
      if (t0_ < 74) ((LAS unsigned*)(lds0 + CTX_OFF))[t0_] = ((const unsigned*)&ka)[t0_];
      if (t0_ < 32) ((volatile LAS unsigned*)(lds0 + MISC_OFF))[t0_] = 0u; }
    __syncthreads();
#define G (osg((int)gridDim.x))
    unsigned* ctl = (unsigned*)(ka.ws + WS_CTL);
    const Ctx a;
    const int lo = ka.ph_lo, hi = ka.ph_hi;
    XcdBarrier bar; bar.bar = ctl + CW_BAR; bar.x = 0; bar.st = nullptr;
    if (hi - lo > 1) bar = xcd_barrier_post(ctl + CW_BAR, MISC + 8);
#ifndef MK_ONLY
#define MK_ONLY -1
#endif
#define SELP(k) ((MK_ONLY) < 0 || (MK_ONLY) == (k))
#ifndef MK_DUP
#define MK_DUP -1
#endif
#define REP(k) for (int rep_ = 0; rep_ < ((MK_DUP) == (k) ? 2 : 1); ++rep_)
#define IN(k) (lo <= (k) && (k) < hi)
#ifndef MK_TIME
#define MK_TIME -1
#endif
    unsigned long long tp0_ = 0ull, tp1_ = 0ull;
#define SEAM(k) do { if (IN(k) && IN((k) + 1)) { xcd_barrier(bar); if ((MK_DUP) == 200) xcd_barrier(bar); } \
    if ((MK_TIME) >= 0) { if ((k) == (MK_TIME) - 1) tp0_ = __builtin_amdgcn_s_memrealtime(); if ((k) == (MK_TIME)) tp1_ = __builtin_amdgcn_s_memrealtime(); } } while (0)
#define WSP (a.ws())
#define ZZP ((bf16*)(a.ws() + WS_ZZ))
#define HP ((bf16*)(a.ws() + WS_H))
#define XP ((bf16*)(a.ws() + WS_X))
#define WP (a.ws() + WS_W)

    if (SELP(0) && IN(0)) { phase_mod_rope(a, (LAS float*)lds); __syncthreads(); REP(1) convert_layer_weights(a, 0, (LAS float*)lds); }
    SEAM(0);
    if (SELP(1) && IN(1)) { REP(100) phase_modulate0(a); }
    SEAM(1);

    for (int l_ = 0; l_ < DEPTH; ++l_) {
#define l (osg(l_))
        const int pb = 2 + 13 * l_;
        const bool last = (l_ == DEPTH - 1);
        const int nrows = last ? NLAT : MTOK;
        const int ntile = nrows / 256;
        const float* modl = (const float*)(WSP + WS_MOD) + (size_t)l * 9 * 6144;

        if (SELP(2) && IN(pb + 0)) REP(2) {
            const bf16* Hin = (l == 0) ? HP : (const bf16*)(WSP + WS_ACT);
            GeoPlain g{Hin, (const bf16*)(WP + W_IN), 1024, 1024, 1024};
            pg8::StaticOrder S; S.init(MTOK / 256, ZLD / 256, G, osg((int)blockIdx.x));
            EpiInProj E{ZZP, (const float*)(WSP + WS_ROPE), (const float*)(WSP + WS_ROPE) + 4096 * 32};
            pg8::gemm_phase(lds, g, S, E);
        }
        SEAM(pb + 0);

        if (SELP(14) && IN(pb + 1)) REP(14) { phase_scan_prep(a, l); }
        SEAM(pb + 1);

        if (SELP(3) && IN(pb + 2)) {
            unsigned* qhead = ctl + CW_QUEUE + 64 * l;
            const int nunits = 256 + 1024 + (last ? 0 : 64);
            const float lam_init = 0.8f - 0.6f * __expf(-0.3f * (float)l);
            bf16* SCR = (bf16*)(WSP + WS_ACT);
#ifndef MK_UNIT
#define MK_UNIT 7
#endif
#define NEXT_UNIT() do { __syncthreads(); if (otid() == 0) MISC[0] = atomicAdd(qhead, 1u); __syncthreads(); uid = (int)MISC[0]; } while (0)
            int uid; NEXT_UNIT();
            while ((MK_UNIT & 1) && uid < 128) {
                const int b = uid >> 4, h = (uid >> 1) & 7, d = uid & 1;
                ssd::Par P; P.XA = (const bf16*)(WSP + WS_H); P.DT = (const float*)(WSP + WS_LOGIT); P.ACS = (const float*)(WSP + WS_LOGIT) + (size_t)MTOK * 16; P.Y = SCR + (size_t)(2 + d) * MTOK * 512;
                P.Dskip = a.in(I_SD)[l * 8 + h]; P.b = b; P.h = h; P.d = d;
                REP(30) ssd::unit(P);
                NEXT_UNIT();
            }
            while ((MK_UNIT & 2) && uid < 256) {
                const int u = uid - 128; const int b = u >> 4, n = (u >> 1) & 7, d = u & 1;
                lru::Par P; P.ZZ = ZZP; P.Hout = SCR + (size_t)d * MTOK * 512; P.conv_w = a.in(I_LCW) + (size_t)l * 4 * 512; P.conv_b = a.in(I_LCB) + l * 512;
                P.wa = a.in(I_LWA) + (size_t)((l * 2 + d) * 8 + n) * 4096; P.wi = a.in(I_LWI) + (size_t)((l * 2 + d) * 8 + n) * 4096;
                P.ba = a.in(I_LBA) + (l * 2 + d) * 512; P.bi = a.in(I_LBI) + (l * 2 + d) * 512; P.lam = a.in(I_LLAM) + (l * 2 + d) * 512; P.b = b; P.n = n; P.d = d;
                REP(31) lru::unit(P);
                NEXT_UNIT();
            }
            if (MK_UNIT & 4) {
                float d0 = 0.f, d1 = 0.f;
                for (int i = 0; i < 64; ++i) { d0 += a.in(I_LAMQ)[(l * 2 + 0) * 64 + i] * a.in(I_LAMK)[(l * 2 + 0) * 64 + i]; d1 += a.in(I_LAMQ)[(l * 2 + 1) * 64 + i] * a.in(I_LAMK)[(l * 2 + 1) * 64 + i]; }
                const float lam = __expf(d0) - __expf(d1) + lam_init;
                while (uid < nunits) {
                    int qrow0, h, krowA, ntA, krowB, NT;
                    if (uid < 1280) { const int u = uid - 256; const int b = u >> 7; h = (u >> 5) & 3; const int qb = u & 31; qrow0 = b * SEQ + qb * 128; krowA = b * SEQ; ntA = 64; krowB = NLAT + b * CTXL; NT = 68; }
                    else { const int u = uid - 1280; const int b = u >> 3; h = (u >> 1) & 3; const int cq = u & 1; qrow0 = NLAT + b * CTXL + cq * 128; krowA = NLAT + b * CTXL; ntA = 4; krowB = krowA; NT = 4; }
                    if ((MK_DUP) == 32) { att::attn_unit(ZZP, qrow0, h, krowA, ntA, krowB, NT, lam, a.in(I_ATTNG) + (size_t)(l * 4 + h) * 128, 1.0f - lam_init, false); __syncthreads(); }
                    att::attn_unit(ZZP, qrow0, h, krowA, ntA, krowB, NT, lam, a.in(I_ATTNG) + (size_t)(l * 4 + h) * 128, 1.0f - lam_init, true);
                    NEXT_UNIT();
                }
            }
#undef NEXT_UNIT
        }
        SEAM(pb + 2);

        if (SELP(4) && IN(pb + 3)) { if ((MK_DUP) == 4) phase_mixer_finalize(a, l, nrows, true); phase_mixer_finalize(a, l, nrows); }
        SEAM(pb + 3);

        if (SELP(5) && IN(pb + 4)) {
            GeoMergeA g{ZZP, (const bf16*)(WP + W_BR), 512, ZLD, 512};
            MergeOrder S; S.init(ntile, G, osg((int)blockIdx.x));
            if ((MK_DUP) == 5) { EpiMergeDiv E0{ZZP, true}; pg8::gemm_phase(lds, g, S, E0); }
            EpiMergeDiv E{ZZP, false};
            pg8::gemm_phase(lds, g, S, E);
        }
        SEAM(pb + 4);

        if (SELP(6) && IN(pb + 5)) REP(6) {
            GeoPlain g{ZZP + ZC_MRG, (const bf16*)(WP + W_OUT), 1024, ZLD, 1024};
            pg8::StaticOrder S; S.init(ntile, 4, G, osg((int)blockIdx.x));
            EpiBf16Plain E{ZZP + ZC_MIX, ZLD};
            pg8::gemm_phase(lds, g, S, E);
        }
        SEAM(pb + 5);

        if (SELP(7) && IN(pb + 6)) { if (l == 0) phase_ln1<false>(a, l, nrows); else phase_ln1<true>(a, l, nrows); }
        SEAM(pb + 6);

        if (SELP(8) && IN(pb + 7)) {
            REP(80) { GeoPlain g{ZZP + ZC_H2, (const bf16*)(WP + W_SU), 1024, ZLD, 1024};
              pg8::StaticOrder S; S.init(ntile, 2, G, osg((int)blockIdx.x));
              EpiSwiGLU<false> E{(bf16*)(WSP + WS_ACTS), nullptr};
              pg8::gemm_phase(lds, g, S, E); }
            REP(81) { GeoPlain g{ZZP + ZC_H2, (const bf16*)(WP + W_RT), 2048, ZLD, 2048};
              pg8::StaticOrder S; S.init(ntile, 1, G, osg((int)((blockIdx.x + gridDim.x - 16) % gridDim.x)));
              EpiRouter E{(float*)(WSP + WS_LOGIT)};
              pg8::gemm_phase(lds, g, S, E); }
        }
        SEAM(pb + 7);

        if (SELP(9) && IN(pb + 8)) REP(9) { phase_route_a(a, l, nrows, (LAS unsigned*)lds); __syncthreads(); }
        SEAM(pb + 8);
        if (SELP(10) && IN(pb + 9)) REP(10) { phase_route_b(a, nrows, (LAS int*)lds); __syncthreads(); }
        SEAM(pb + 9);

        if (SELP(11) && IN(pb + 10)) REP(11) {
            const int nt_ = __builtin_amdgcn_readfirstlane(*(const int*)(WSP + WS_NTILES));
            GeoMoeUp g{ZZP + ZC_H2, (const bf16*)(WP + W_UP), (const int*)(WSP + WS_ROWTOK), (const int*)(WSP + WS_TILEE), 1024, ZLD, 1024};
            pg8::StaticOrder S; S.init(nt_, 2, G, osg((int)blockIdx.x));
            EpiSwiGLU<true> E{(bf16*)(WSP + WS_ACT), (const float*)(WSP + WS_ROWW)};
            pg8::gemm_phase(lds, g, S, E);
        }
        SEAM(pb + 10);

        if (SELP(12) && IN(pb + 11)) {
            REP(12) { const int nt_ = __builtin_amdgcn_readfirstlane(*(const int*)(WSP + WS_NTILES));
              GeoMoeDown g{(const bf16*)(WSP + WS_ACT), (const bf16*)(WP + W_DN), (const int*)(WSP + WS_TILEE), 256, 256, 256};
              pg8::StaticOrder S; S.init(nt_, 4, G, osg((int)blockIdx.x));
              EpiBf16Plain E{(bf16*)(WSP + WS_YE), 1024};
              pg8::gemm_phase(lds, g, S, E); }
            { GeoPlain g{(const bf16*)(WSP + WS_ACTS), (const bf16*)(WP + W_SD), 256, 256, 256};
              pg8::StaticOrder S; S.init(ntile, 4, G, osg((int)blockIdx.x));
              if ((MK_DUP) == 120) { EpiSharedDown E0{XP, modl, true}; pg8::gemm_phase(lds, g, S, E0); }
              EpiSharedDown E{XP, modl, false};
              pg8::gemm_phase(lds, g, S, E); }
        }
        SEAM(pb + 11);

        if (SELP(13) && IN(pb + 12)) {
            if ((MK_DUP) == 13) phase_ln2(a, l, nrows, true);
            phase_ln2(a, l, nrows);
            if (!last) { __syncthreads(); convert_layer_weights(a, l + 1, (LAS float*)lds); }
        }
        SEAM(pb + 12);
    }
    if ((MK_TIME) >= 0 && blockIdx.x == 0) { const unsigned long long te_ = __builtin_amdgcn_s_memrealtime(); const unsigned long long w_ = 8ull * (tp1_ - tp0_); while (__builtin_amdgcn_s_memrealtime() - te_ < w_) __builtin_amdgcn_s_sleep(8); }
#undef l
#undef G
#undef lds
#undef IN
#undef SEAM
#undef WSP
#undef ZZP
#undef HP
#undef XP
#undef WP
}

extern "C" void kernel_launch(void* const* d_in, const int* in_sizes, int n_in, void* d_out, int out_size, void* d_ws, size_t ws_size, hipStream_t stream) {
    static int grid = 0;
    if (grid == 0) {
        if (n_in != 35 || in_sizes[0] != NLAT * DM || out_size != NLAT * DM || ws_size < WS_END) {
            fprintf(stderr, "kernel_launch: shape/workspace mismatch: n_in %d in0 %d out %d ws %zu (need %zu)\n", n_in, n_in > 0 ? in_sizes[0] : -1, out_size, ws_size, (size_t)WS_END); grid = -1; return; }
        int dev = 0, cus = 0, per_cu = 0;
        if (hipGetDevice(&dev) != hipSuccess || hipDeviceGetAttribute(&cus, hipDeviceAttributeMultiprocessorCount, dev) != hipSuccess) { fprintf(stderr, "kernel_launch: device query failed\n"); grid = -1; return; }
        if (hipFuncSetAttribute((const void*)mega_fwd, hipFuncAttributeMaxDynamicSharedMemorySize, LDS_BYTES) != hipSuccess) { fprintf(stderr, "kernel_launch: hipFuncSetAttribute failed\n"); grid = -1; return; }
        if (hipOccupancyMaxActiveBlocksPerMultiprocessor(&per_cu, (const void*)mega_fwd, 512, LDS_BYTES) != hipSuccess || per_cu < 1) fprintf(stderr, "kernel_launch: occupancy query reports %d\n", per_cu);
        (void)hipGetLastError();
        grid = cus;
    }
    if (grid < 0) return;
    if (hipMemsetAsync((char*)d_ws + WS_CTL, 0, CTL_ZERO_BYTES, stream) != hipSuccess) { fprintf(stderr, "kernel_launch: memset failed\n"); return; }
    Args a{};
    for (int i = 0; i < 35; ++i) a.in[i] = (const float*)d_in[i];
    a.out = (float*)d_out; a.ws = (unsigned char*)d_ws;
#if MK_PER_PHASE
    for (int p = 0; p < NPHASE; ++p) { a.ph_lo = p; a.ph_hi = p + 1; hipLaunchKernelGGL(mega_fwd, dim3(grid), dim3(512), LDS_BYTES, stream, a); }
#else
    a.ph_lo = 0; a.ph_hi = NPHASE;
    hipLaunchKernelGGL(mega_fwd, dim3(grid), dim3(512), LDS_BYTES, stream, a);
#endif
    const hipError_t le = hipPeekAtLastError();
    if (le != hipSuccess) fprintf(stderr, "kernel_launch: launch failed: %s\n", hipGetErrorName(le));
}
```

```cpp
#include <hip/hip_runtime.h>
#include <cstdio>
#include <cstdint>

#define GAS __attribute__((address_space(1)))
#define LAS __attribute__((address_space(3)))
typedef unsigned short bf16;
typedef short bf16x8 __attribute__((ext_vector_type(8)));
typedef short s16x4 __attribute__((ext_vector_type(4)));
typedef float f32x2 __attribute__((ext_vector_type(2)));
typedef float f32x4 __attribute__((ext_vector_type(4)));
typedef float f32x16 __attribute__((ext_vector_type(16)));
typedef unsigned u32x2 __attribute__((ext_vector_type(2)));
typedef unsigned u32x4 __attribute__((ext_vector_type(4)));

constexpr int DM = 1024, NBATCH = 8, SEQ = 4096, CTXL = 256, DEPTH = 2;
constexpr int NLAT = NBATCH * SEQ, NCTX = NBATCH * CTXL, MTOK = NLAT + NCTX;
constexpr int IN_TOTAL = 7184, ZLD = 7424;
constexpr int ZC_Q = 0, ZC_K = 512, ZC_V = 1024, ZC_LX = 1536, ZC_LG = 2048, ZC_Z = 2560, ZC_XBC = 3072, ZC_GATE = 4096, ZC_DT = 7168;
constexpr int ZC_MRG = 512;
constexpr int ZC_MIX = 1536;
constexpr int NEXP = 64, TOPK = 8, EXPF = 256;
constexpr int PMAX_TILES = 1152, PMAX = PMAX_TILES * 256;
constexpr float DN_ALPHA = 1.41421356237309515f;
constexpr float LN_EPS = 1e-5f, RMS_EPS = 1e-6f;

constexpr size_t MiB = 1u << 20;
constexpr size_t WS_CTL = 0, CTL_ZERO_BYTES = 1 * MiB;
constexpr size_t WS_MOD = 1 * MiB;
constexpr size_t WS_ROPE = 2 * MiB;
constexpr size_t WS_LOGIT = 4 * MiB;
constexpr size_t WS_ACTS = 13 * MiB;
constexpr size_t WS_SELE = 30 * MiB;
constexpr size_t WS_SELW = 32 * MiB;
constexpr size_t WS_SELR = 34 * MiB;
constexpr size_t WS_TSLOT = 36 * MiB;
constexpr size_t WS_ROWTOK = 38 * MiB;
constexpr size_t WS_ROWW = 40 * MiB;
constexpr size_t WS_WGHIST = 42 * MiB;
constexpr size_t WS_TILEE = 42 * MiB + 65536;
constexpr size_t WS_NTILES = 42 * MiB + 131072;
constexpr size_t WS_W = 44 * MiB;
constexpr size_t W_IN = 0;
constexpr size_t W_BR = W_IN + (size_t)ZLD * 1024 * 2;
constexpr size_t W_OUT = W_BR + (size_t)3072 * 512 * 2;
constexpr size_t W_RT = W_OUT + (size_t)1024 * 1024 * 2;
constexpr size_t W_SU = W_RT + (size_t)256 * 2048 * 2;
constexpr size_t W_SD = W_SU + (size_t)512 * 1024 * 2;
constexpr size_t W_UP = W_SD + (size_t)1024 * 256 * 2;
constexpr size_t W_DN = W_UP + (size_t)64 * 512 * 1024 * 2;
constexpr size_t W_END = W_DN + (size_t)64 * 1024 * 256 * 2;
static_assert(W_END <= 122 * MiB, "weights");
constexpr int ZC_H2 = 4096;
constexpr size_t WS_X = 166 * MiB;
constexpr size_t WS_ACT = 302 * MiB;
constexpr size_t WS_H = 446 * MiB;
constexpr size_t WS_ZZ = 514 * MiB;
constexpr size_t WS_YE = WS_H;
constexpr size_t WS_END = 1022 * MiB;
static_assert(WS_X + (size_t)MTOK * 1024 * 4 <= WS_ACT && WS_ACT + (size_t)PMAX * 256 * 2 <= WS_H && WS_H + (size_t)MTOK * 1024 * 2 <= WS_ZZ, "ws map 1");
static_assert(WS_ZZ + (size_t)MTOK * ZLD * 2 <= WS_END && WS_YE + (size_t)PMAX * 1024 * 2 <= WS_END, "ws map 2");
constexpr size_t SCR_STRIDE = (size_t)MTOK * 512 * 2;
static_assert(4 * SCR_STRIDE <= (size_t)PMAX * 256 * 2, "scan scratch fits the act region");
constexpr int CW_BAR = 4096;
constexpr int CW_QUEUE = 16384;

constexpr int LDS_BYTES = 147456;
constexpr int RW_OFF = 129 * 1024 + 4608 + 128;
constexpr int TE_OFF = 129 * 1024 + 4608;
constexpr int RT_OFF = 129 * 1024;
constexpr int MISC_OFF = 131072 + 320;

#define LDS_WAIT() asm volatile("s_waitcnt lgkmcnt(0)" ::: "memory")
#define VM_WAIT() asm volatile("s_waitcnt vmcnt(0)" ::: "memory")
__device__ __forceinline__ unsigned f2bf(float f) { unsigned u = __builtin_bit_cast(unsigned, f); return (u + 0x7fffu + ((u >> 16) & 1u)) >> 16; }
__device__ __forceinline__ float bf2f(unsigned h) { return __builtin_bit_cast(float, h << 16); }
__device__ __forceinline__ unsigned cvt_pk_bf16(float lo, float hi) { unsigned r; asm volatile("v_cvt_pk_bf16_f32 %0, %1, %2" : "=v"(r) : "v"(lo), "v"(hi)); return r; }
__device__ __forceinline__ float bflo(unsigned w) { return __builtin_bit_cast(float, w << 16); }
__device__ __forceinline__ float bfhi(unsigned w) { return __builtin_bit_cast(float, w & 0xffff0000u); }
__device__ __forceinline__ float fexp(float x) { return __builtin_amdgcn_exp2f(x * 1.4426950408889634f); }
__device__ __forceinline__ float sigmoidf_(float x) { return __builtin_amdgcn_rcpf(1.0f + fexp(-x)); }
__device__ __forceinline__ float siluf_(float x) { return x * sigmoidf_(x); }
__device__ __forceinline__ float softplusf_(float x) { const float e = fexp(-fabsf(x)); const float lp = e < 1e-3f ? e * (1.f - 0.5f * e + 0.33333333f * e * e) : __builtin_amdgcn_logf(1.f + e) * 0.6931471805599453f; return fmaxf(x, 0.f) + lp; }
__device__ __forceinline__ float gelu_tanh(float x) { const float u = 0.7978845608028654f * (x + 0.044715f * x * x * x); const float e = fexp(2.f * u); const float th = 1.f - 2.f * __builtin_amdgcn_rcpf(e + 1.f); return 0.5f * x * (1.f + th); }
__device__ __forceinline__ float wave_sum(float v) {
#pragma unroll
    for (int o = 1; o < 64; o <<= 1) v += __shfl_xor(v, o);
    return v;
}

template <class T> __device__ __forceinline__ T* uni(T* p) { const unsigned long long v = (unsigned long long)p; const unsigned lo = __builtin_amdgcn_readfirstlane((unsigned)v), hi = __builtin_amdgcn_readfirstlane((unsigned)(v >> 32)); return (T*)(GAS T*)(((unsigned long long)hi << 32) | lo); }
__device__ __forceinline__ int uni(int v) { return __builtin_amdgcn_readfirstlane(v); }
__device__ __forceinline__ float uni(float v) { return __builtin_bit_cast(float, __builtin_amdgcn_readfirstlane(__builtin_bit_cast(int, v))); }
extern __shared__ __attribute__((aligned(16))) unsigned char lds_raw[];
constexpr int WVTAB_OFF = 131072 + 320 + 128 + 320;
__device__ __forceinline__ int otid() {
    const unsigned key = (unsigned)__builtin_amdgcn_s_getreg(((6 - 1) << 11) | 4) & 63u;
    int off_ = WVTAB_OFF + (int)key * 4; asm volatile("" : "+v"(off_));
    const unsigned wv = (unsigned)__builtin_amdgcn_readfirstlane((int)*(const volatile LAS unsigned*)((LAS unsigned char*)lds_raw + off_));
    unsigned z = 0u; asm volatile("" : "+v"(z));
    const unsigned ln = __builtin_amdgcn_mbcnt_hi(~0u, __builtin_amdgcn_mbcnt_lo(~0u, z));
    int t = (int)(wv * 64u + ln); asm volatile("" : "+v"(t)); return t;
}
__device__ __forceinline__ LAS unsigned char* olds() { unsigned b = 0u; asm volatile("" : "+s"(b)); return (LAS unsigned char*)lds_raw + b; }
__device__ __forceinline__ int osg(int v) { asm volatile("" : "+s"(v)); return v; }

#define XB_TMO      128
#define XB_XCNT(j)  (256  + 64 * (j))
#define XB_XSUB(j)  (1280 + 64 * (j))
#define XB_XGEN(j)  (2304 + 64 * (j))
#define XB_TOP      3328
#define XB_TOPGEN   3392
#define XCD_BAR_WORDS 3456
#define XB_SPIN_CAP (1u << 20)
__device__ __forceinline__ unsigned xb_ld(unsigned* p)              { return __hip_atomic_load(p, __ATOMIC_RELAXED, __HIP_MEMORY_SCOPE_AGENT); }
__device__ __forceinline__ unsigned xb_add(unsigned* p, unsigned v) { return __hip_atomic_fetch_add(p, v, __ATOMIC_RELAXED, __HIP_MEMORY_SCOPE_AGENT); }
__device__ __forceinline__ unsigned xb_xcc_id() { return (unsigned)__builtin_amdgcn_s_getreg((3 << 11) | 20) & 0xFu; }
#define XB_SPIN(cond, bar) do { unsigned _sp = 0; while (cond) { __builtin_amdgcn_s_sleep(1); \
    if ((++_sp & 255u) == 0u) { if (xb_ld(&(bar)[XB_TMO])) break; if (_sp > XB_SPIN_CAP) { atomicAdd(&(bar)[XB_TMO], 1u); break; } } } } while (0)
struct XcdBarrier { unsigned* bar; unsigned x; volatile LAS unsigned* st; };
__device__ __forceinline__ XcdBarrier xcd_barrier_post(unsigned* bar, volatile LAS unsigned* st) {
    XcdBarrier b; b.bar = bar; b.x = xb_xcc_id(); b.st = st;
    if (otid() == 0) (void)xb_add(&bar[XB_XCNT(b.x)], 1u);
    return b;
}
__device__ __forceinline__ void xcd_barrier_complete(unsigned* bar, unsigned x, unsigned& nloc, unsigned& nx) {
    const unsigned G = gridDim.x * gridDim.y * gridDim.z;
    unsigned sum, cnt, mine, sp = 0u;
    for (;;) {
        sum = 0u; cnt = 0u; mine = 0u;
#pragma unroll
        for (unsigned j = 0; j < 16; ++j) { const unsigned c = xb_ld(&bar[XB_XCNT(j)]); sum += c; cnt += (c > 0u) ? 1u : 0u; mine = (j == x) ? c : mine; }
        if (sum == G) break;
        __builtin_amdgcn_s_sleep(1);
        if ((++sp & 255u) == 0u) { if (xb_ld(&bar[XB_TMO])) break; if (sp > XB_SPIN_CAP) { atomicAdd(&bar[XB_TMO], 1u); break; } }
    }
    nloc = mine > 0u ? mine : 1u; nx = cnt > 0u ? cnt : 1u;
}
__device__ __forceinline__ void xcd_barrier(const XcdBarrier& b) {
    asm volatile("s_waitcnt vmcnt(0)" ::: "memory");
    __syncthreads();
    if (otid() == 0) {
        unsigned* bar = b.bar;
        __builtin_amdgcn_s_waitcnt(0);
        unsigned nloc = b.st[0], nx = b.st[1];
        if (nloc == 0u) { xcd_barrier_complete(bar, b.x, nloc, nx); b.st[0] = nloc; b.st[1] = nx; }
        const unsigned old = xb_add(&bar[XB_XSUB(b.x)], 1u);
        const unsigned gen = old / nloc;
        if (old + 1u == (gen + 1u) * nloc) {
            __builtin_amdgcn_fence(__ATOMIC_RELEASE, "agent");
            asm volatile("s_waitcnt vmcnt(0)" ::: "memory");
            const unsigned og = xb_add(&bar[XB_TOP], 1u);
            const unsigned tg = og / nx;
            if (og + 1u == (tg + 1u) * nx) xb_add(&bar[XB_TOPGEN], 1u);
            else XB_SPIN(xb_ld(&bar[XB_TOPGEN]) == tg, bar);
            __builtin_amdgcn_fence(__ATOMIC_ACQUIRE, "agent");
            xb_add(&bar[XB_XGEN(b.x)], 1u);
            asm volatile("s_waitcnt vmcnt(0)" ::: "memory");
        } else {
            XB_SPIN(xb_ld(&bar[XB_XGEN(b.x)]) == gen, bar);
            __builtin_amdgcn_fence(__ATOMIC_ACQUIRE, "agent");
            asm volatile("s_waitcnt vmcnt(0)" ::: "memory");
        }
    }
    __syncthreads();
}

namespace pg8 {
constexpr int BM = 256, BK = 64, HALF = 128, HTB = HALF * BK * 2, STAGE_BYTES = 8 * HTB, NXCD = 8, WGM = 8;
__host__ __device__ __forceinline__ int lds_byte(int r, int c) { const int st = (r >> 4) * 2 + (c >> 5), rr = r & 15, cc = c & 31, ob = rr * 64 + cc * 2; return st * 1024 + (ob ^ (((ob >> 9) & 1) << 5)); }
__host__ __device__ __forceinline__ void stage_rc(int b, int& R, int& C) { const int st = b / 1024, sb = b % 1024, swz = sb ^ (((sb >> 9) & 1) << 5); R = (st >> 1) * 16 + swz / 64; C = (st & 1) * 32 + (swz % 64) / 2; }
__host__ __device__ __forceinline__ int perm32(int rho) { const int n = rho >> 4, i = rho & 15; return 8 * (i >> 2) + 4 * n + (i & 3); }
struct Unit { int pm, pn, idx; };
struct StaticOrder {
    int nM, nN, nwg, G, c;
    __device__ void init(int nM_, int nN_, int G_, int c_) { nM = nM_; nN = nN_; nwg = nM * nN; G = G_; c = c_; }
    __device__ __forceinline__ bool next(int i, Unit& u) const {
        const long L = (long)i * G + c; if (L >= nwg) return false;
        int wgid = (int)L; { const int q = nwg / NXCD, r = nwg % NXCD, xcd = wgid % NXCD, off = wgid / NXCD; wgid = (xcd < r ? xcd * (q + 1) : r * (q + 1) + (xcd - r) * q) + off; }
        const int nig = WGM * nN, gid = wgid / nig, fm = gid * WGM, gsz = (nM - fm) < WGM ? (nM - fm) : WGM;
        u.pm = __builtin_amdgcn_readfirstlane(fm + ((wgid % nig) % gsz)); u.pn = __builtin_amdgcn_readfirstlane((wgid % nig) / gsz); return true;
    }
};
struct RowOrder {
    int nM, nN, G, c;
    __device__ void init(int nM_, int nN_, int G_, int c_) { nM = nM_; nN = nN_; G = G_; c = c_; }
    __device__ bool next(int i, Unit& u) const { const int j = i / nN; const long L = (long)j * G + c; if (L >= nM) return false; u.pm = __builtin_amdgcn_readfirstlane((int)L); u.pn = __builtin_amdgcn_readfirstlane(i - j * nN); return true; }
};
template <class Geo, class Epi, class Sched>
__device__ __forceinline__ void gemm_phase(LAS unsigned char* lds, const Geo& g, const Sched& S, const Epi& E) {
    const int tid = otid(), wid = __builtin_amdgcn_readfirstlane(tid >> 6), lane = tid & 63, wr = wid >> 2, wc = wid & 3, fr = lane & 15, fq = lane >> 4;
    const int K = g.K, nt = K / BK;
    constexpr int NE = Epi::SEAM_VM;
    int Rs[2], Cs[2];
    unsigned voffB[2], vC[2][2];
#pragma unroll
    for (int i = 0; i < 2; ++i) { stage_rc(tid * 16 + i * 8192, Rs[i], Cs[i]); const int Rb = Epi::PERM ? ((Rs[i] & ~31) + perm32(Rs[i] & 31)) : Rs[i];
        voffB[i] = (unsigned)(Rb * g.ldb + Cs[i]) * 2u; }
    const size_t kstep = (size_t)(BK * 2);
    const size_t hstepB = (size_t)HALF * g.ldb * 2;
    const unsigned ldsw = (unsigned)wid * 1024u;
    const int aoff = lds_byte(wr * 64 + fr, fq * 8), boff = lds_byte(wc * 32 + fr, fq * 8);
#define PG8_SA(b, h) (((b) * 2 + (h)) * HTB)
#define PG8_SB(b, h) ((4 + (b) * 2 + (h)) * HTB)
#define PG8_STAGE(bufoff, gbase, voff) do { _Pragma("unroll") for (int _i = 0; _i < 2; ++_i) \
        __builtin_amdgcn_global_load_lds((const unsigned*)((const char*)(gbase) + (voff)[_i]), (LAS unsigned*)(lds + (bufoff) + ldsw + _i * 8192), 16, 0, 0); } while (0)
#define PG8_LDA(dst, b, h) do { _Pragma("unroll") for (int m = 0; m < 4; ++m) _Pragma("unroll") for (int k = 0; k < 2; ++k) dst[m][k] = *(const LAS bf16x8*)(lds + PG8_SA(b, h) + aoff + m * 2048 + k * 1024); } while (0)
#define PG8_LDB(dst, b, h) do { _Pragma("unroll") for (int n = 0; n < 2; ++n) _Pragma("unroll") for (int k = 0; k < 2; ++k) dst[n][k] = *(const LAS bf16x8*)(lds + PG8_SB(b, h) + boff + n * 2048 + k * 1024); } while (0)
#define PG8_MMA(ai, bj, At, Bt) do { __builtin_amdgcn_s_setprio(1); _Pragma("unroll") for (int m = 0; m < 4; ++m) _Pragma("unroll") for (int n = 0; n < 2; ++n) _Pragma("unroll") for (int k = 0; k < 2; ++k) \
        acc[ai][bj][m][n] = __builtin_amdgcn_mfma_f32_16x16x32_bf16(Bt[n][k], At[m][k], acc[ai][bj][m][n], 0, 0, 0); __builtin_amdgcn_s_setprio(0); } while (0)
#define PG8_WAIT_V(n) asm volatile("s_waitcnt vmcnt(" #n ")" ::: "memory")
#define PG8_WAIT_L(n) asm volatile("s_waitcnt lgkmcnt(" #n ")" ::: "memory")
#define PG8_WAIT_R() do { if (NE > 0) { int _scc; asm volatile("s_cselect_b32 %0, 1, 0\n\ts_waitcnt vmcnt(%1)\n\ts_cmp_eq_u32 %2, 0\n\ts_cbranch_scc0 2f\n\ts_cmp_lg_u32 %3, 0\n\ts_cbranch_scc1 1f\n2:\ts_waitcnt vmcnt(8)\n1:\ts_cmp_lg_u32 %0, 0" : "=&s"(_scc) : "n"(10 + NE), "s"(t), "s"(ui) : "memory"); } else PG8_WAIT_V(8); } while (0)
#define PG8_BAR __builtin_amdgcn_s_barrier()
#define PG8_SCHED __builtin_amdgcn_sched_barrier(0)
#define PG8_SETV(v, u, idx_) do { _Pragma("unroll") for (int _h = 0; _h < 2; ++_h) _Pragma("unroll") for (int _i = 0; _i < 2; ++_i) { \
        const unsigned _row = Geo::GATHER ? g.a_row((u), _h * HALF + Rs[_i], (idx_)) : (unsigned)(_h * HALF + Rs[_i]); v[_h][_i] = (_row * (unsigned)g.lda + (unsigned)Cs[_i]) * 2u; } } while (0)
    Unit cur, nxt; int ui = 0;
    if (!S.next(0, cur)) return;
    f32x4 acc[2][2][4][2];
#pragma unroll
    for (int a = 0; a < 2; ++a)
#pragma unroll
        for (int b = 0; b < 2; ++b)
#pragma unroll
            for (int m = 0; m < 4; ++m)
#pragma unroll
                for (int n = 0; n < 2; ++n) acc[a][b][m][n] = (f32x4){0.f, 0.f, 0.f, 0.f};
    bf16x8 At[4][2], B0[2][2], B1[2][2];
    const char* cA = g.a_tile(cur); const char* cB = g.b_tile(cur, 0);
    PG8_SETV(vC, cur, 0);
    if (Geo::GATHER) { PG8_WAIT_V(0); }
    PG8_STAGE(PG8_SB(0, 0), cB, voffB); PG8_STAGE(PG8_SB(0, 1), cB + hstepB, voffB); PG8_STAGE(PG8_SA(0, 0), cA, vC[0]); PG8_STAGE(PG8_SA(0, 1), cA, vC[1]);
    if (wr == 1) PG8_BAR;
    PG8_WAIT_V(2); PG8_BAR;
    PG8_STAGE(PG8_SB(1, 0), cB + kstep, voffB); PG8_STAGE(PG8_SA(1, 0), cA + kstep, vC[0]); PG8_STAGE(PG8_SB(1, 1), cB + hstepB + kstep, voffB);
    PG8_WAIT_V(6); PG8_BAR;
    for (;;) {
        const bool has_next = S.next(ui + 1, nxt);
        const char* nA = has_next ? g.a_tile(nxt) : cA; const char* nB = has_next ? g.b_tile(nxt, ui + 1) : cB;
        for (int t = 0; t < nt; t += 2) {
            const bool last = (t == nt - 2);
            const char* a1 = cA + (size_t)(t + 1) * kstep;
            const char* a2 = last ? nA : cA + (size_t)(t + 2) * kstep; const char* b2 = last ? nB : cB + (size_t)(t + 2) * kstep;
            const char* a3 = a2 + kstep; const char* b3 = b2 + kstep;
            unsigned t1[2] = {0u, 0u};
            if (Geo::GATHER && last && has_next) {
#pragma unroll
                for (int _i = 0; _i < 2; ++_i) { vC[0][_i] = (g.a_row(nxt, Rs[_i], ui + 1) * (unsigned)g.lda + (unsigned)Cs[_i]) * 2u; t1[_i] = (g.a_row(nxt, HALF + Rs[_i], ui + 1) * (unsigned)g.lda + (unsigned)Cs[_i]) * 2u; }
            }
            PG8_LDB(B0, 0, 0); PG8_LDB(B1, 0, 1); PG8_SCHED; PG8_LDA(At, 0, 0); PG8_STAGE(PG8_SA(1, 1), a1, vC[1]);
            if (Geo::GATHER && last && has_next) { vC[1][0] = t1[0]; vC[1][1] = t1[1]; }
            PG8_WAIT_R(); PG8_WAIT_L(0); PG8_BAR; PG8_MMA(0, 0, At, B0); PG8_MMA(0, 1, At, B1); PG8_BAR; PG8_SCHED;
            PG8_LDA(At, 0, 1); PG8_STAGE(PG8_SB(0, 0), b2, voffB); PG8_STAGE(PG8_SB(0, 1), b2 + hstepB, voffB); PG8_STAGE(PG8_SA(0, 0), a2, vC[0]);
            PG8_WAIT_R(); PG8_WAIT_L(0); PG8_BAR; PG8_MMA(1, 0, At, B0); PG8_MMA(1, 1, At, B1); PG8_BAR; PG8_SCHED;
            PG8_LDB(B0, 1, 0); PG8_LDB(B1, 1, 1); PG8_SCHED; PG8_LDA(At, 1, 0); PG8_STAGE(PG8_SA(0, 1), a2, vC[1]);
            PG8_WAIT_R(); PG8_WAIT_L(0); PG8_BAR; PG8_MMA(0, 0, At, B0); PG8_MMA(0, 1, At, B1); PG8_BAR; PG8_SCHED;
            PG8_LDA(At, 1, 1); PG8_STAGE(PG8_SB(1, 0), b3, voffB); PG8_STAGE(PG8_SB(1, 1), b3 + hstepB, voffB); PG8_STAGE(PG8_SA(1, 0), a3, vC[0]);
            PG8_WAIT_V(8); PG8_WAIT_L(0); PG8_BAR; PG8_MMA(1, 0, At, B0); PG8_MMA(1, 1, At, B1); PG8_BAR; PG8_SCHED;
        }
        if (NE > 0) PG8_STAGE(PG8_SA(1, 1), nA + kstep, vC[1]);
        if (wr == 0) PG8_BAR;
        cur.idx = ui; E(acc, cur, wr, wc, fr, fq);
        if (!has_next) break;
        if (!E.keep(cur)) {
#pragma unroll
        for (int a = 0; a < 2; ++a)
#pragma unroll
            for (int b = 0; b < 2; ++b)
#pragma unroll
                for (int m = 0; m < 4; ++m)
#pragma unroll
                    for (int n = 0; n < 2; ++n) acc[a][b][m][n] = (f32x4){0.f, 0.f, 0.f, 0.f};
        }
        cur = nxt; cA = nA; cB = nB; ++ui;
        if (wr == 1) PG8_BAR;
    }
    PG8_WAIT_V(0);
    PG8_BAR;
#undef PG8_SA
#undef PG8_SB
#undef PG8_STAGE
#undef PG8_LDA
#undef PG8_LDB
#undef PG8_MMA
#undef PG8_WAIT_V
#undef PG8_WAIT_L
#undef PG8_WAIT_R
#undef PG8_BAR
#undef PG8_SCHED
#undef PG8_SETV
}
}

struct GeoPlain {
    static constexpr bool GATHER = false;
    const bf16* A; const bf16* Bt; int K, lda, ldb;
    __device__ __forceinline__ const char* a_tile(const pg8::Unit& u) const { return (const char*)(A + (size_t)u.pm * 256 * lda); }
    __device__ __forceinline__ const char* b_tile(const pg8::Unit& u, int = 0) const { return (const char*)(Bt + (size_t)u.pn * 256 * ldb); }
    __device__ __forceinline__ unsigned a_row(const pg8::Unit&, int R, int = 0) const { return (unsigned)R; }
};
struct GeoMergeA {
    static constexpr bool GATHER = false;
    const bf16* ZZ; const bf16* Bt; int K, lda, ldb;
    __device__ __forceinline__ const char* a_tile(const pg8::Unit& u) const { const int br = u.pn >> 2; const int co = br == 0 ? ZC_Q : (br == 1 ? ZC_LG : ZC_Z); return (const char*)(ZZ + (size_t)u.pm * 256 * ZLD + co); }
    __device__ __forceinline__ const char* b_tile(const pg8::Unit& u, int = 0) const { return (const char*)(Bt + (size_t)u.pn * 256 * 512); }
    __device__ __forceinline__ unsigned a_row(const pg8::Unit&, int R, int = 0) const { return (unsigned)R; }
};
struct GeoMoeUp {
    static constexpr bool GATHER = true;
    const bf16* A; const bf16* Bt; const LAS unsigned short* rt; const LAS int* te; int K, lda, ldb;
    __device__ __forceinline__ const char* a_tile(const pg8::Unit&) const { return (const char*)A; }
    __device__ __forceinline__ const char* b_tile(const pg8::Unit& u, int idx) const { const int e = __builtin_amdgcn_readfirstlane(te[idx]); return (const char*)(Bt + ((size_t)e * 512 + (size_t)u.pn * 256) * 1024); }
    __device__ __forceinline__ unsigned a_row(const pg8::Unit&, int R, int idx) const { return (unsigned)rt[idx * 256 + R]; }
};
struct GeoMoeDown {
    static constexpr bool GATHER = false;
    const bf16* A; const bf16* Bt; const LAS int* te; int K, lda, ldb;
    __device__ __forceinline__ const char* a_tile(const pg8::Unit& u) const { return (const char*)(A + (size_t)u.pm * 256 * 256); }
    __device__ __forceinline__ const char* b_tile(const pg8::Unit& u, int idx) const { const int e = __builtin_amdgcn_readfirstlane(te[idx]); return (const char*)(Bt + ((size_t)e * 1024 + (size_t)u.pn * 256) * 256); }
    __device__ __forceinline__ unsigned a_row(const pg8::Unit&, int R, int = 0) const { return (unsigned)R; }
};

struct EpiInProj {
    static constexpr bool PERM = true; static constexpr int SEAM_VM = 0;
    __device__ __forceinline__ bool keep(const pg8::Unit&) const { return false; }
    bf16* ZZ; const float* cosT; const float* sinT;
    __device__ __forceinline__ void operator()(const f32x4 (&acc)[2][2][4][2], const pg8::Unit& u, int wr, int wc, int fr, int fq) const {
        const int row0 = u.pm * 256 + wr * 64 + fr, colt = u.pn * 256 + wc * 32 + 8 * fq;
        const int kind = u.pn < 4 ? 0 : ((u.pn >= 16 && u.pn < 28) ? 2 : 1);
        const bool rope = (kind == 0) && (u.pm < NLAT / 256);
        if (rope) {
            const int i0 = (colt & 63) >> 1;
#pragma unroll
            for (int ai = 0; ai < 2; ++ai) {
                f32x4 cq[4], sq[4];
#pragma unroll
                for (int m = 0; m < 4; ++m) { const int t = (row0 + ai * 128 + m * 16) & 4095; cq[m] = *(const f32x4*)(cosT + t * 32 + i0); sq[m] = *(const f32x4*)(sinT + t * 32 + i0); }
#pragma unroll
                for (int m = 0; m < 4; ++m) {
                    bf16* rowp = ZZ + (size_t)(row0 + ai * 128 + m * 16) * ZLD + colt; const f32x4 c = cq[m], s_ = sq[m];
#pragma unroll
                    for (int bj = 0; bj < 2; ++bj) {
                        const f32x4 v0 = acc[ai][bj][m][0], v1 = acc[ai][bj][m][1];
                        u32x4 w;
                        w.x = cvt_pk_bf16(v0[0] * c[0] - v0[1] * s_[0], v0[1] * c[0] + v0[0] * s_[0]); w.y = cvt_pk_bf16(v0[2] * c[1] - v0[3] * s_[1], v0[3] * c[1] + v0[2] * s_[1]);
                        w.z = cvt_pk_bf16(v1[0] * c[2] - v1[1] * s_[2], v1[1] * c[2] + v1[0] * s_[2]); w.w = cvt_pk_bf16(v1[2] * c[3] - v1[3] * s_[3], v1[3] * c[3] + v1[2] * s_[3]);
                        *(u32x4*)(rowp + bj * 128) = w;
                    }
                }
                asm volatile("" ::: "memory");
            }
            return;
        }
#pragma unroll
        for (int ai = 0; ai < 2; ++ai)
#pragma unroll
            for (int m = 0; m < 4; ++m) {
                const int row = row0 + ai * 128 + m * 16;
                bf16* rowp = ZZ + (size_t)row * ZLD + colt;
#pragma unroll
                for (int bj = 0; bj < 2; ++bj) {
                    f32x4 v0 = acc[ai][bj][m][0], v1 = acc[ai][bj][m][1];
                    if (kind == 2) {
#pragma unroll
                        for (int j = 0; j < 4; ++j) { v0[j] = sigmoidf_(v0[j]); v1[j] = sigmoidf_(v1[j]); }
                    }
                    u32x4 w; w.x = cvt_pk_bf16(v0[0], v0[1]); w.y = cvt_pk_bf16(v0[2], v0[3]); w.z = cvt_pk_bf16(v1[0], v1[1]); w.w = cvt_pk_bf16(v1[2], v1[3]);
                    *(u32x4*)(rowp + bj * 128) = w;
                }
                asm volatile("" ::: "memory");
            }
    }
};
struct EpiMergeDiv {
    static constexpr bool PERM = true; static constexpr int SEAM_VM = 0;
    __device__ __forceinline__ bool keep(const pg8::Unit& u) const { return (u.pn >> 2) < 2; }
    bf16* ZZ; bool dry;
    __device__ __forceinline__ void operator()(f32x4 (&acc)[2][2][4][2], const pg8::Unit& u, int wr, int wc, int fr, int fq) const {
        const int n = u.pn >> 2, pn4 = u.pn & 3;
        const int row0 = u.pm * 256 + wr * 64 + fr, colg = ZC_GATE + n * 1024 + pn4 * 256 + wc * 32 + 8 * fq, colo = ZC_MRG + pn4 * 256 + wc * 32 + 8 * fq;
        const int hofs = n < 2 ? 1024 : 0;
#pragma unroll
        for (int ai = 0; ai < 2; ++ai) {
            u32x4 gq[4][2], hq[4][2];
#pragma unroll
            for (int m = 0; m < 4; ++m) { const bf16* rowp = ZZ + (size_t)(row0 + ai * 128 + m * 16) * ZLD;
#pragma unroll
                for (int bj = 0; bj < 2; ++bj) { gq[m][bj] = *(const u32x4*)(rowp + colg + bj * 128); hq[m][bj] = *(const u32x4*)(rowp + colg + hofs + bj * 128); } }
#pragma unroll
            for (int m = 0; m < 4; ++m) {
                bf16* rowp = ZZ + (size_t)(row0 + ai * 128 + m * 16) * ZLD;
#pragma unroll
                for (int bj = 0; bj < 2; ++bj) {
                    const u32x4 g_ = gq[m][bj];
                    f32x4 s0, s1;
                    s0[0] = bflo(g_.x); s0[1] = bfhi(g_.x); s0[2] = bflo(g_.y); s0[3] = bfhi(g_.y); s1[0] = bflo(g_.z); s1[1] = bfhi(g_.z); s1[2] = bflo(g_.w); s1[3] = bfhi(g_.w);
                    { const u32x4 h_ = hq[m][bj];
                        f32x4 d0, d1;
                        d0[0] = bflo(h_.x); d0[1] = bfhi(h_.x); d0[2] = bflo(h_.y); d0[3] = bfhi(h_.y); d1[0] = bflo(h_.z); d1[1] = bfhi(h_.z); d1[2] = bflo(h_.w); d1[3] = bfhi(h_.w);
#pragma unroll
                        for (int j = 0; j < 4; ++j) { const float e0 = n < 2 ? fmaxf(d0[j], 1e-20f) : 1.0f, e1 = n < 2 ? fmaxf(d1[j], 1e-20f) : 1.0f;
                            acc[ai][bj][m][0][j] *= fmaxf(s0[j], 1e-20f) * __builtin_amdgcn_rcpf(e0); acc[ai][bj][m][1][j] *= fmaxf(s1[j], 1e-20f) * __builtin_amdgcn_rcpf(e1); } }
                    if (n == 2) {
                        const f32x4 v0 = acc[ai][bj][m][0], v1 = acc[ai][bj][m][1];
                        u32x4 w; w.x = cvt_pk_bf16(v0[0], v0[1]); w.y = cvt_pk_bf16(v0[2], v0[3]); w.z = cvt_pk_bf16(v1[0], v1[1]); w.w = cvt_pk_bf16(v1[2], v1[3]);
                        if (!dry) *(u32x4*)(rowp + colo + bj * 128) = w; else asm volatile("" :: "v"(w));
                    }
                }
            }
            asm volatile("" ::: "memory");
        }
    }
};
struct MergeOrder {
    pg8::StaticOrder base; int off;
    __device__ void init(int nM, int G, int c, int off_ = 0) { base.init(nM, 4, G, c); off = off_; }
    __device__ bool next(int i, pg8::Unit& u) const { const int j = i / 3, n = i - 3 * j; if (!base.next(j, u)) return false; u.pn += 4 * n; u.pm += off; return true; }
};
struct OffOrder {
    pg8::StaticOrder base; int off;
    __device__ void init(int nM, int nN, int G, int c, int off_) { base.init(nM, nN, G, c); off = off_; }
    __device__ bool next(int i, pg8::Unit& u) const { if (!base.next(i, u)) return false; u.pm += off; return true; }
};
struct EpiYe8 {
    static constexpr bool PERM = true; static constexpr int SEAM_VM = 8;
    __device__ __forceinline__ bool keep(const pg8::Unit&) const { return false; }
    unsigned char* O;
    __device__ __forceinline__ void operator()(const f32x4 (&acc)[2][2][4][2], const pg8::Unit& u, int wr, int wc, int fr, int fq) const {
        const int row0 = u.pm * 256 + wr * 64 + fr + (fq & 1) * 16, colt = u.pn * 256 + wc * 32 + 16 * (fq >> 1);
#pragma unroll
        for (int ai = 0; ai < 2; ++ai)
#pragma unroll
            for (int mp = 0; mp < 4; mp += 2) {
                unsigned char* rowp = O + (size_t)(row0 + ai * 128 + mp * 16) * 1024 + colt;
#pragma unroll
                for (int bj = 0; bj < 2; ++bj) {
                    const f32x4 a0 = acc[ai][bj][mp][0], a1 = acc[ai][bj][mp][1], b0 = acc[ai][bj][mp + 1][0], b1 = acc[ai][bj][mp + 1][1];
                    int wa0 = 0, wa1 = 0, wb0 = 0, wb1 = 0;
                    wa0 = __builtin_amdgcn_cvt_pk_bf8_f32(a0[0], a0[1], wa0, false); wa0 = __builtin_amdgcn_cvt_pk_bf8_f32(a0[2], a0[3], wa0, true);
                    wa1 = __builtin_amdgcn_cvt_pk_bf8_f32(a1[0], a1[1], wa1, false); wa1 = __builtin_amdgcn_cvt_pk_bf8_f32(a1[2], a1[3], wa1, true);
                    wb0 = __builtin_amdgcn_cvt_pk_bf8_f32(b0[0], b0[1], wb0, false); wb0 = __builtin_amdgcn_cvt_pk_bf8_f32(b0[2], b0[3], wb0, true);
                    wb1 = __builtin_amdgcn_cvt_pk_bf8_f32(b1[0], b1[1], wb1, false); wb1 = __builtin_amdgcn_cvt_pk_bf8_f32(b1[2], b1[3], wb1, true);
                    const auto r0 = __builtin_amdgcn_permlane16_swap((unsigned)wa0, (unsigned)wb0, false, false);
                    const auto r1 = __builtin_amdgcn_permlane16_swap((unsigned)wa1, (unsigned)wb1, false, false);
                    *(u32x4*)(rowp + bj * 128) = (u32x4){r0[0], r1[0], r0[1], r1[1]};
                }
            }
    }
};
struct EpiBf16Plain {
    static constexpr bool PERM = true; static constexpr int SEAM_VM = 16;
    __device__ __forceinline__ bool keep(const pg8::Unit&) const { return false; }
    bf16* O; int ldc;
    __device__ __forceinline__ void operator()(const f32x4 (&acc)[2][2][4][2], const pg8::Unit& u, int wr, int wc, int fr, int fq) const {
        const int row0 = u.pm * 256 + wr * 64 + fr, colt = u.pn * 256 + wc * 32 + 8 * fq;
#pragma unroll
        for (int ai = 0; ai < 2; ++ai)
#pragma unroll
            for (int m = 0; m < 4; ++m) {
                bf16* rowp = O + (size_t)(row0 + ai * 128 + m * 16) * ldc + colt;
#pragma unroll
                for (int bj = 0; bj < 2; ++bj) {
                    const f32x4 v0 = acc[ai][bj][m][0], v1 = acc[ai][bj][m][1];
                    u32x4 w; w.x = cvt_pk_bf16(v0[0], v0[1]); w.y = cvt_pk_bf16(v0[2], v0[3]); w.z = cvt_pk_bf16(v1[0], v1[1]); w.w = cvt_pk_bf16(v1[2], v1[3]);
                    *(u32x4*)(rowp + bj * 128) = w;
                }
            }
    }
};
template <bool ROUTED> struct EpiSwiGLU {
    static constexpr bool PERM = true; static constexpr int SEAM_VM = 0;
    __device__ __forceinline__ bool keep(const pg8::Unit&) const { return false; }
    bf16* O; const LAS float* rwl;
    __device__ __forceinline__ void operator()(const f32x4 (&acc)[2][2][4][2], const pg8::Unit& u, int wr, int wc, int fr, int fq) const {
        const int row0 = u.pm * 256 + wr * 64 + fr, colt = u.pn * 128 + wc * 32 + 8 * fq;
        float rwv[2][4];
#pragma unroll
        for (int ai = 0; ai < 2; ++ai)
#pragma unroll
            for (int m = 0; m < 4; ++m) rwv[ai][m] = ROUTED ? rwl[u.idx * 256 + wr * 64 + fr + ai * 128 + m * 16] : 1.0f;
#pragma unroll
        for (int ai = 0; ai < 2; ++ai)
#pragma unroll
            for (int m = 0; m < 4; ++m) {
                const int row = row0 + ai * 128 + m * 16;
                const float rw = rwv[ai][m];
                const f32x4 g0 = acc[ai][0][m][0], g1 = acc[ai][0][m][1], u0 = acc[ai][1][m][0], u1 = acc[ai][1][m][1];
                f32x4 a, b;
#pragma unroll
                for (int j = 0; j < 4; ++j) { a[j] = siluf_(g0[j]) * u0[j] * rw; b[j] = siluf_(g1[j]) * u1[j] * rw; }
                u32x4 w; w.x = cvt_pk_bf16(a[0], a[1]); w.y = cvt_pk_bf16(a[2], a[3]); w.z = cvt_pk_bf16(b[0], b[1]); w.w = cvt_pk_bf16(b[2], b[3]);
                *(u32x4*)(O + (size_t)row * 256 + colt) = w;
            }
    }
};
struct EpiRouter {
    static constexpr bool PERM = false; static constexpr int SEAM_VM = 0;
    __device__ __forceinline__ bool keep(const pg8::Unit&) const { return false; }
    float* L;
    __device__ __forceinline__ void operator()(const f32x4 (&acc)[2][2][4][2], const pg8::Unit& u, int wr, int wc, int fr, int fq) const {
        if (wc >= 2) return;
        const int row0 = u.pm * 256 + wr * 64 + fr, col0 = wc * 32 + 4 * fq;
#pragma unroll
        for (int ai = 0; ai < 2; ++ai)
#pragma unroll
            for (int m = 0; m < 4; ++m) {
                float* rowp = L + (size_t)(row0 + ai * 128 + m * 16) * 64 + col0;
#pragma unroll
                for (int n = 0; n < 2; ++n) *(f32x4*)(rowp + n * 16) = acc[ai][0][m][n] + acc[ai][1][m][n];
            }
    }
};
struct EpiSharedDown {
    static constexpr bool PERM = true; static constexpr int SEAM_VM = 16; static constexpr bool SEAM_PRE = true;
    __device__ __forceinline__ bool keep(const pg8::Unit&) const { return false; }
    bf16* X; const float* modl; bool dry;
    __device__ __forceinline__ void operator()(const f32x4 (&acc)[2][2][4][2], const pg8::Unit& u, int wr, int wc, int fr, int fq) const {
        const int row0 = u.pm * 256 + wr * 64 + fr, colt = u.pn * 256 + wc * 32 + 8 * fq;
        const int mr = u.pm * 256 < NLAT ? ((u.pm * 256) >> 12) : 8;
        const float* m5 = modl + (size_t)mr * 6144 + 5 * 1024 + colt;
        f32x4 g0[2], g1[2];
#pragma unroll
        for (int bj = 0; bj < 2; ++bj) { g0[bj] = *(const f32x4*)(m5 + bj * 128); g1[bj] = *(const f32x4*)(m5 + bj * 128 + 4); }
#pragma unroll
        for (int ai = 0; ai < 2; ++ai) {
            u32x4 xq[4][2];
#pragma unroll
            for (int m = 0; m < 4; ++m)
#pragma unroll
                for (int bj = 0; bj < 2; ++bj) xq[m][bj] = *(const u32x4*)(X + (size_t)(row0 + ai * 128 + m * 16) * 1024 + colt + bj * 128);
#pragma unroll
            for (int m = 0; m < 4; ++m) {
                bf16* rowp = X + (size_t)(row0 + ai * 128 + m * 16) * 1024 + colt;
#pragma unroll
                for (int bj = 0; bj < 2; ++bj) {
                    const u32x4 xr = xq[m][bj]; const f32x4 a0 = acc[ai][bj][m][0], a1 = acc[ai][bj][m][1];
                    u32x4 w;
                    w.x = cvt_pk_bf16(bflo(xr.x) * DN_ALPHA + g0[bj][0] * a0[0], bfhi(xr.x) * DN_ALPHA + g0[bj][1] * a0[1]); w.y = cvt_pk_bf16(bflo(xr.y) * DN_ALPHA + g0[bj][2] * a0[2], bfhi(xr.y) * DN_ALPHA + g0[bj][3] * a0[3]);
                    w.z = cvt_pk_bf16(bflo(xr.z) * DN_ALPHA + g1[bj][0] * a1[0], bfhi(xr.z) * DN_ALPHA + g1[bj][1] * a1[1]); w.w = cvt_pk_bf16(bflo(xr.w) * DN_ALPHA + g1[bj][2] * a1[2], bfhi(xr.w) * DN_ALPHA + g1[bj][3] * a1[3]);
                    if (!dry) *(u32x4*)(rowp + bj * 128) = w; else asm volatile("" :: "v"(w));
                }
            }
            asm volatile("" ::: "memory");
        }
    }
};

namespace att {
constexpr int KVBLK = 64;
constexpr float SCALE = 0.125f, THR = 8.f;
constexpr size_t SHM_V = KVBLK * 128 * 2, SHM_K = KVBLK * 128 * 2;
constexpr size_t SHM_ATTN = 2 * SHM_V + 2 * SHM_K + 8 * 64 * 4;
#define KSWZ(row, colB) ((row) * 256 + ((colB) ^ (((row) & 7) << 4)))
#define SBAR() __builtin_amdgcn_sched_barrier(0)
__device__ __forceinline__ int crow(int r, int hi) { return (r & 3) + 8 * (r >> 2) + 4 * hi; }
__device__ __forceinline__ void partialSM(f32x16& p0, f32x16& p1, float& m_reg, float& mn, float& alpha) {
  constexpr float C = SCALE * 1.4426950408889634f;
  float pmax = p0[0];
#pragma unroll
  for (int r = 1; r < 16; ++r) pmax = fmaxf(pmax, p0[r]);
#pragma unroll
  for (int r = 0; r < 16; ++r) pmax = fmaxf(pmax, p1[r]);
  { auto rr = __builtin_amdgcn_permlane32_swap(__float_as_uint(pmax), __float_as_uint(pmax), false, false);
    pmax = fmaxf(__uint_as_float(rr[0]), __uint_as_float(rr[1])); }
  if (__builtin_expect(__all(pmax - m_reg <= THR / SCALE), 1)) { mn = m_reg; alpha = 1.f; }
  else { mn = fmaxf(m_reg, pmax); alpha = __builtin_amdgcn_exp2f((m_reg - mn) * C); m_reg = mn; }
  float mnC = -mn * C;
#pragma unroll
  for (int r = 0; r < 16; ++r) p0[r] = fmaf(p0[r], C, mnC);
#pragma unroll
  for (int r = 0; r < 16; ++r) p1[r] = fmaf(p1[r], C, mnC);
#pragma unroll
  for (int r = 0; r < 16; ++r) p0[r] = __builtin_amdgcn_exp2f(p0[r]);
}
__device__ __forceinline__ void finishSM(f32x16& p0, f32x16& p1, float alpha, float& l_reg, bf16x8& pa0, bf16x8& pa1, bf16x8& pa2, bf16x8& pa3) {
#pragma unroll
  for (int r = 0; r < 16; ++r) p1[r] = __builtin_amdgcn_exp2f(p1[r]);
  float ps = 0;
#pragma unroll
  for (int r = 0; r < 16; ++r) ps += p0[r];
#pragma unroll
  for (int r = 0; r < 16; ++r) ps += p1[r];
  { auto rr = __builtin_amdgcn_permlane32_swap(__float_as_uint(ps), __float_as_uint(ps), false, false);
    ps = __uint_as_float(rr[0]) + __uint_as_float(rr[1]); }
  l_reg = l_reg * alpha + ps;
#define PK4(P, BASE, OUT) do { unsigned a0 = cvt_pk_bf16(P[BASE + 0], P[BASE + 1]), a1 = cvt_pk_bf16(P[BASE + 2], P[BASE + 3]);   \
    unsigned b0 = cvt_pk_bf16(P[BASE + 4], P[BASE + 5]), b1 = cvt_pk_bf16(P[BASE + 6], P[BASE + 7]);                              \
    auto r0 = __builtin_amdgcn_permlane32_swap(a0, b0, false, false); auto r1 = __builtin_amdgcn_permlane32_swap(a1, b1, false, false); \
    u32x4 w = {r0[0], r1[0], r0[1], r1[1]}; OUT = *reinterpret_cast<bf16x8*>(&w); } while (0)
  PK4(p0, 0, pa0); PK4(p0, 8, pa1); PK4(p1, 0, pa2); PK4(p1, 8, pa3);
#undef PK4
}
__device__ __forceinline__ void qkt(f32x16& p0, f32x16& p1, const char* Ks, const bf16x8 (&qr)[4], int r32, int hi, int mcol) {
  p0 = f32x16{}; p1 = f32x16{};
#pragma unroll
  for (int d0 = 0; d0 < 4; ++d0) { int cb = (mcol + d0 * 16 + hi * 8) * 2;
    bf16x8 b0 = *reinterpret_cast<const bf16x8*>(Ks + KSWZ(r32, cb));
    bf16x8 b1 = *reinterpret_cast<const bf16x8*>(Ks + KSWZ(32 + r32, cb));
    p0 = __builtin_amdgcn_mfma_f32_32x32x16_bf16(b0, qr[d0], p0, 0, 0, 0);
    p1 = __builtin_amdgcn_mfma_f32_32x32x16_bf16(b1, qr[d0], p1, 0, 0, 0); }
}
__device__ __forceinline__ int v_st(int k, int c) { const int kk = (k & ~0xC) | ((k & 4) << 1) | ((k & 8) >> 1); return ((kk >> 3) * 4 + (c >> 5)) * 512 + ((kk & 7) * 32 + (c & 31)) * 2; }
__device__ __forceinline__ int v_rd_base(int lane) { return ((lane & 3) << 3) | (((lane >> 2) & 3) << 6) | (((lane >> 4) & 1) << 5) | (((lane >> 5) & 1) << 8); }
constexpr int v_rd_off(int d0, int ks, int half) { return d0 * 512 + ks * 4096 + half * 2048; }
template <int OFF> __device__ __forceinline__ s16x4 tr_read(int vb) {
  s16x4 r; asm volatile("ds_read_b64_tr_b16 %0, %1 offset:%2" : "=&v"(r) : "v"(vb), "i"(OFF) : "memory"); return r;
}
template <int D0> __device__ __forceinline__ void pv_one(f32x16& od, int vb, bf16x8 pa0, bf16x8 pa1, bf16x8 pa2, bf16x8 pa3) {
  const s16x4 l0 = tr_read<v_rd_off(D0, 0, 0)>(vb), h0 = tr_read<v_rd_off(D0, 0, 1)>(vb), l1 = tr_read<v_rd_off(D0, 1, 0)>(vb), h1 = tr_read<v_rd_off(D0, 1, 1)>(vb);
  const s16x4 l2 = tr_read<v_rd_off(D0, 2, 0)>(vb), h2 = tr_read<v_rd_off(D0, 2, 1)>(vb), l3 = tr_read<v_rd_off(D0, 3, 0)>(vb), h3 = tr_read<v_rd_off(D0, 3, 1)>(vb);
  asm volatile("s_waitcnt lgkmcnt(0)" ::: "memory"); SBAR();
#define PK(L, H) (bf16x8){L[0], L[1], L[2], L[3], H[0], H[1], H[2], H[3]}
  od = __builtin_amdgcn_mfma_f32_32x32x16_bf16(pa0, PK(l0, h0), od, 0, 0, 0);
  od = __builtin_amdgcn_mfma_f32_32x32x16_bf16(pa1, PK(l1, h1), od, 0, 0, 0);
  od = __builtin_amdgcn_mfma_f32_32x32x16_bf16(pa2, PK(l2, h2), od, 0, 0, 0);
  od = __builtin_amdgcn_mfma_f32_32x32x16_bf16(pa3, PK(l3, h3), od, 0, 0, 0);
#undef PK
}
__device__ __forceinline__ void pv_d0(f32x16* o, int vb, bf16x8 pa0, bf16x8 pa1, bf16x8 pa2, bf16x8 pa3) {
  pv_one<0>(o[0], vb, pa0, pa1, pa2, pa3); pv_one<1>(o[1], vb, pa0, pa1, pa2, pa3); pv_one<2>(o[2], vb, pa0, pa1, pa2, pa3); pv_one<3>(o[3], vb, pa0, pa1, pa2, pa3);
}
static __device__ __forceinline__ void attn_unit(bf16* __restrict__ ZZ_, int qrow0_, int h_, int krowA_, int ntA_, int krowB_, int NT_, float lam_, const float* __restrict__ gn_, float oscale_, bool dostore) {
  bf16* __restrict__ ZZ = uni(ZZ_); const int qrow0 = uni(qrow0_), h = uni(h_), krowA = uni(krowA_), ntA = uni(ntA_), krowB = uni(krowB_), NT = uni(NT_); const float lam = uni(lam_), oscale = uni(oscale_); const float* __restrict__ gn = uni(gn_);
  char* lds = (char*)olds();
  const int tid = otid(), wid = tid >> 6, lane = tid & 63, r32 = lane & 31, hi = lane >> 5;
  const int map = wid >> 2, wq = wid & 3, mcol = map * 64;
  char* V_lds = lds; char* K_lds = lds + 2 * SHM_V;
  float* ws = (float*)(lds + 2 * SHM_V + 2 * SHM_K) + wid * 64; float* li_l = ws; float* al_l = ws + 32;
  float m_reg = -1e30f, l_reg = 0; f32x16 o[4] = {}; bf16x8 qr[4];
  const bf16* Qw = ZZ + (size_t)(qrow0 + wq * 32 + r32) * ZLD + ZC_Q + h * 128 + mcol + hi * 8;
#pragma unroll
  for (int d0 = 0; d0 < 4; ++d0) qr[d0] = *reinterpret_cast<const bf16x8*>(Qw + d0 * 16);
  const int sr = tid >> 4, sc = (tid & 15) * 8, vst0 = v_st(sr, sc), vst1 = v_st(32 + sr, sc);
  const int vb0 = (int)(uintptr_t)(LAS char*)V_lds + v_rd_base(lane);
  const bf16* Kcol = ZZ + ZC_K + h * 128 + sc; const bf16* Vcol = ZZ + ZC_V + h * 128 + sc;
  struct { bf16x8 vs0, vs1, ks0, ks1; } sr_[2];
#define KROW(j) ((j) < ntA ? krowA + (j) * KVBLK : krowB + ((j) - ntA) * KVBLK)
#define SLOAD(i, j) do { const size_t _r0 = (size_t)(KROW(j) + sr) * ZLD, _r1 = _r0 + (size_t)32 * ZLD; \
    sr_[i].vs0 = *reinterpret_cast<const bf16x8*>(Vcol + _r0); sr_[i].vs1 = *reinterpret_cast<const bf16x8*>(Vcol + _r1); \
    sr_[i].ks0 = *reinterpret_cast<const bf16x8*>(Kcol + _r0); sr_[i].ks1 = *reinterpret_cast<const bf16x8*>(Kcol + _r1); } while (0)
#define SWRITE(b, i) do { *(bf16x8*)(V_lds + (b) * SHM_V + vst0) = sr_[i].vs0;          \
    *(bf16x8*)(V_lds + (b) * SHM_V + vst1) = sr_[i].vs1; int kc = sc * 2;               \
    *(bf16x8*)(K_lds + (b) * SHM_K + KSWZ(sr, kc)) = sr_[i].ks0;                       \
    *(bf16x8*)(K_lds + (b) * SHM_K + KSWZ(32 + sr, kc)) = sr_[i].ks1; } while (0)
#define SWAIT() asm volatile("s_waitcnt vmcnt(4)" ::: "memory")
#define RESC(a) do { if (__any((a) < 1.f)) { if (hi == 0) al_l[r32] = (a); asm volatile("s_waitcnt lgkmcnt(0)" ::: "memory"); \
    _Pragma("unroll") for (int d = 0; d < 4; ++d) _Pragma("unroll") for (int r = 0; r < 16; ++r) o[d][r] *= al_l[crow(r, hi)]; } } while (0)
  f32x16 pA0, pA1, pB0, pB1; float mnA, mnB, alA, alB; bf16x8 pa0, pa1, pa2, pa3;
  constexpr int SE = 0, SO = 1;
  if (__builtin_amdgcn_readfirstlane(wid) >= 4) __builtin_amdgcn_s_setprio(1);
  SLOAD(SE, 0); asm volatile("s_waitcnt vmcnt(0)" ::: "memory"); SWRITE(0, SE); __syncthreads();
  qkt(pA0, pA1, K_lds, qr, r32, hi, mcol); partialSM(pA0, pA1, m_reg, mnA, alA);
  SLOAD(SO, 1); if (2 < NT) SLOAD(SE, 2);
  SWAIT(); SWRITE(1, SO); __syncthreads();
  for (int j = 1; j + 1 < NT; j += 2) {
    SBAR(); qkt(pB0, pB1, K_lds + SHM_K, qr, r32, hi, mcol);
    finishSM(pA0, pA1, alA, l_reg, pa0, pa1, pa2, pa3); SBAR();
    SLOAD(SO, j + 2); SBAR();
    pv_d0(o, vb0, pa0, pa1, pa2, pa3); partialSM(pB0, pB1, m_reg, mnB, alB);
    __syncthreads(); SWAIT(); SWRITE(0, SE);
    RESC(alB); __syncthreads();
    SBAR(); qkt(pA0, pA1, K_lds, qr, r32, hi, mcol);
    finishSM(pB0, pB1, alB, l_reg, pa0, pa1, pa2, pa3); SBAR();
    if (j + 3 < NT) SLOAD(SE, j + 3); SBAR();
    pv_d0(o, vb0 + (int)SHM_V, pa0, pa1, pa2, pa3); partialSM(pA0, pA1, m_reg, mnA, alA);
    __syncthreads(); SWAIT(); SWRITE(1, SO);
    RESC(alA); __syncthreads();
  }
  SBAR(); qkt(pB0, pB1, K_lds + SHM_K, qr, r32, hi, mcol);
  finishSM(pA0, pA1, alA, l_reg, pa0, pa1, pa2, pa3); SBAR();
  pv_d0(o, vb0, pa0, pa1, pa2, pa3); partialSM(pB0, pB1, m_reg, mnB, alB);
  __syncthreads(); RESC(alB);
  finishSM(pB0, pB1, alB, l_reg, pa0, pa1, pa2, pa3); SBAR();
  pv_d0(o, vb0 + (int)SHM_V, pa0, pa1, pa2, pa3);
  __builtin_amdgcn_s_setprio(0);
  if (hi == 0) li_l[r32] = l_reg; asm volatile("s_waitcnt lgkmcnt(0)" ::: "memory");
  float rli[16];
#pragma unroll
  for (int r = 0; r < 16; ++r) rli[r] = __builtin_amdgcn_rcpf(li_l[crow(r, hi)]);
  __syncthreads();
  float* xch = (float*)lds + (size_t)wq * 4096;
  if (map == 1) {
#pragma unroll
    for (int d0 = 0; d0 < 4; ++d0)
#pragma unroll
      for (int r = 0; r < 16; ++r) xch[(d0 * 16 + r) * 64 + lane] = o[d0][r] * rli[r];
  }
  __syncthreads();
  if (map == 0) {
    float ss[16];
#pragma unroll
    for (int r = 0; r < 16; ++r) ss[r] = 0.f;
#pragma unroll
    for (int d0 = 0; d0 < 4; ++d0)
#pragma unroll
      for (int r = 0; r < 16; ++r) { const float v = o[d0][r] * rli[r] - lam * xch[(d0 * 16 + r) * 64 + lane]; o[d0][r] = v; ss[r] += v * v; }
#pragma unroll
    for (int r = 0; r < 16; ++r) {
#pragma unroll
      for (int off = 1; off < 32; off <<= 1) ss[r] += __shfl_xor(ss[r], off);
      ss[r] = __builtin_amdgcn_rsqf(ss[r] * (1.0f / 128.0f) + RMS_EPS) * oscale;
    }
    float gv[4];
#pragma unroll
    for (int d0 = 0; d0 < 4; ++d0) gv[d0] = gn[d0 * 32 + r32];
    bf16* Ow = ZZ + (size_t)(qrow0 + wq * 32) * ZLD + ZC_Q + h * 128 + r32;
#pragma unroll
    for (int r = 0; r < 16; ++r) { const int orow = crow(r, hi);
#pragma unroll
      for (int d0 = 0; d0 < 4; ++d0) if (dostore) Ow[(size_t)orow * ZLD + d0 * 32] = (bf16)f2bf(o[d0][r] * ss[r] * gv[d0]); }
  }
#undef KROW
#undef SLOAD
#undef SWRITE
#undef SWAIT
#undef RESC
}
#undef KSWZ
#undef SBAR
}

__device__ __forceinline__ f32x4 mma_tile(const LAS char* A, int sa, const LAS char* B, int sb, int ksteps, int lane, f32x4 acc) {
    const int r = lane & 15, q = lane >> 4;
    for (int k = 0; k < ksteps; ++k) {
        const bf16x8 a = *(const LAS bf16x8*)(A + r * sa + (k * 32 + q * 8) * 2);
        const bf16x8 b = *(const LAS bf16x8*)(B + r * sb + (k * 32 + q * 8) * 2);
        acc = __builtin_amdgcn_mfma_f32_16x16x32_bf16(a, b, acc, 0, 0, 0);
    }
    return acc;
}

namespace ssd {
constexpr int PC = 272, PX = 144;
constexpr int BUFB = 64 * PC * 2 + 64 * PX;
constexpr int O_C = 0, O_B = 64 * PC, O_X = 2 * 64 * PC, O_XW = 2 * BUFB, O_MM = O_XW + 64 * PX, O_SB = O_MM + 64 * PX, O_ACS = O_SB + 64 * PC, O_END = O_ACS + 2 * 128 * 4;
static_assert(O_END <= 131072, "ssd lds");
struct Par { const bf16* XA; const float* DT; const float* ACS; bf16* Y; float Dskip; int b, h, d; };
__device__ __forceinline__ bf16x8 tr_frag(const LAS char* T, int pitch, int kbase, int idx0, int lane) {
    const int gq = lane >> 4, j = lane & 15;
    const LAS char* p0 = T + (kbase + 8 * gq + (j >> 2)) * pitch + (idx0 + 4 * (j & 3)) * 2;
    const s16x4 lo = __builtin_amdgcn_ds_read_tr16_b64_v4i16((LAS s16x4*)p0), hi = __builtin_amdgcn_ds_read_tr16_b64_v4i16((LAS s16x4*)(p0 + 4 * pitch));
    return (bf16x8){lo[0], lo[1], lo[2], lo[3], hi[0], hi[1], hi[2], hi[3]};
}
static __device__ __forceinline__ void unit(Par P_) {
    Par P; P.XA = uni(P_.XA); P.DT = uni(P_.DT); P.ACS = uni(P_.ACS); P.Y = uni(P_.Y); P.Dskip = uni(P_.Dskip); P.b = uni(P_.b); P.h = uni(P_.h); P.d = uni(P_.d);
    LAS char* lds = (LAS char*)olds();
    const int tid = otid(), wid = __builtin_amdgcn_readfirstlane(tid >> 6), lane = tid & 63, fr = lane & 15, fq = lane >> 4;
    const int g = P.h >> 2, dh = P.d * 8 + P.h;
    for (int i = tid; i < 64 * PC / 4; i += 512) ((LAS unsigned*)(lds + O_SB))[i] = 0u;
    f32x4 Sacc[4];
#pragma unroll
    for (int i = 0; i < 4; ++i) Sacc[i] = (f32x4){0.f, 0.f, 0.f, 0.f};
    u32x4 st[5]; float sa = 0.f;
#define CH_ROW(ch, pos) (((ch) < 4 ? NLAT + P.b * CTXL : P.b * SEQ) + (P.d ? ((ch) < 4 ? CTXL : SEQ) - 1 - ((((ch) < 4) ? (ch) : (ch) - 4) * 64 + (pos)) : (((ch) < 4) ? (ch) : (ch) - 4) * 64 + (pos)))
#define SSD_LOAD(ch) do { \
        _Pragma("unroll") for (int i_ = 0; i_ < 5; ++i_) { const int q_ = tid + 512 * i_; \
            const int row_ = i_ < 4 ? ((q_ & 1023) >> 4) : ((q_ - 2048) >> 3); const int pc_ = i_ < 4 ? (q_ & 15) : (q_ & 7); \
            const int col_ = i_ < 2 ? 768 + g * 128 + pc_ * 8 : (i_ < 4 ? 512 + g * 128 + pc_ * 8 : P.h * 64 + pc_ * 8); \
            st[i_] = *(const u32x4*)(P.XA + (size_t)CH_ROW(ch, row_) * 1024 + col_); } \
        if (tid < 128) { const int r_ = CH_ROW(ch, tid & 63); sa = tid < 64 ? P.ACS[(size_t)r_ * 16 + dh] : P.DT[(size_t)r_ * 16 + dh]; } } while (0)
#define SSD_WRITE(bf) do { \
        _Pragma("unroll") for (int i_ = 0; i_ < 5; ++i_) { const int q_ = tid + 512 * i_; \
            const int row_ = i_ < 4 ? ((q_ & 1023) >> 4) : ((q_ - 2048) >> 3); const int pc_ = i_ < 4 ? (q_ & 15) : (q_ & 7); \
            const int off_ = i_ < 2 ? O_C + row_ * PC + pc_ * 16 : (i_ < 4 ? O_B + row_ * PC + pc_ * 16 : O_X + row_ * PX + pc_ * 16); \
            *(LAS u32x4*)(lds + (bf) * BUFB + off_) = st[i_]; } \
        if (tid < 128) *(LAS float*)(lds + O_ACS + (bf) * 512 + tid * 4) = sa; } while (0)
    SSD_LOAD(0); SSD_WRITE(0); SSD_LOAD(1);
    __syncthreads();
    for (int ch = 0; ch < 68; ++ch) {
        const int bf = ch & 1;
        if (ch + 1 < 68) SSD_WRITE(bf ^ 1);
        if (ch + 2 < 68) SSD_LOAD(ch + 2);
        const LAS char* Cb = lds + bf * BUFB + O_C; const LAS char* Bb = lds + bf * BUFB + O_B; const LAS char* Xb = lds + bf * BUFB + O_X;
        const LAS float* ACSb = (const LAS float*)(lds + O_ACS + bf * 512); const LAS float* DTb = ACSb + 64;
        const float acs_end = ACSb[63];
        { const int s_ = tid >> 3, pc = tid & 7; const float sc = DTb[s_] * fexp(acs_end - ACSb[s_]);
          const u32x4 xv = *(const LAS u32x4*)(Xb + s_ * PX + pc * 16); u32x4 w;
          w.x = cvt_pk_bf16(bflo(xv.x) * sc, bfhi(xv.x) * sc); w.y = cvt_pk_bf16(bflo(xv.y) * sc, bfhi(xv.y) * sc); w.z = cvt_pk_bf16(bflo(xv.z) * sc, bfhi(xv.z) * sc); w.w = cvt_pk_bf16(bflo(xv.w) * sc, bfhi(xv.w) * sc);
          *(LAS u32x4*)(lds + O_XW + s_ * PX + pc * 16) = w; }
        const int lt = wid >> 1, h2 = wid & 1;
        f32x4 yo[2];
#pragma unroll
        for (int i = 0; i < 2; ++i) {
            const int st_ = h2 * 2 + i;
            f32x4 gacc = (f32x4){0.f, 0.f, 0.f, 0.f};
            if (st_ <= lt) gacc = mma_tile(Cb + lt * 16 * PC, PC, Bb + st_ * 16 * PC, PC, 4, lane, gacc);
            const int s = st_ * 16 + fr; const float as = ACSb[s], ds = DTb[s];
            float mv[4];
#pragma unroll
            for (int jj = 0; jj < 4; ++jj) { const int l = lt * 16 + fq * 4 + jj; mv[jj] = (s <= l) ? gacc[jj] * fexp(ACSb[l] - as) * ds : 0.f; }
            u32x2 mw; mw.x = cvt_pk_bf16(mv[0], mv[1]); mw.y = cvt_pk_bf16(mv[2], mv[3]);
            *(LAS u32x2*)(lds + O_MM + s * PX + (lt * 16 + fq * 4) * 2) = mw;
            f32x4 ya = (f32x4){0.f, 0.f, 0.f, 0.f};
#pragma unroll
            for (int ks = 0; ks < 4; ++ks) { const bf16x8 af = *(const LAS bf16x8*)(lds + O_SB + (st_ * 16 + fr) * PC + (ks * 32 + fq * 8) * 2); const bf16x8 bfr = *(const LAS bf16x8*)(Cb + (lt * 16 + fr) * PC + (ks * 32 + fq * 8) * 2);
                ya = __builtin_amdgcn_mfma_f32_16x16x32_bf16(af, bfr, ya, 0, 0, 0); }
            yo[i] = ya;
        }
        __syncthreads();
#pragma unroll
        for (int i = 0; i < 2; ++i) {
            const int pt = h2 * 2 + i;
            f32x4 yd = (f32x4){0.f, 0.f, 0.f, 0.f};
#pragma unroll
            for (int ks = 0; ks < 2; ++ks) { const bf16x8 af = tr_frag(Xb, PX, ks * 32, pt * 16, lane); const bf16x8 bfr = tr_frag(lds + O_MM, PX, ks * 32, lt * 16, lane);
                yd = __builtin_amdgcn_mfma_f32_16x16x32_bf16(af, bfr, yd, 0, 0, 0); }
            const int l = lt * 16 + fr, p0 = pt * 16 + fq * 4; const float el = fexp(ACSb[l]);
            float y[4];
#pragma unroll
            for (int jj = 0; jj < 4; ++jj) y[jj] = yd[jj] + el * yo[i][jj];
            if (P.d == 0) { const u32x2 xw = *(const LAS u32x2*)(Xb + l * PX + p0 * 2); y[0] += P.Dskip * bflo(xw.x); y[1] += P.Dskip * bfhi(xw.x); y[2] += P.Dskip * bflo(xw.y); y[3] += P.Dskip * bfhi(xw.y); }
            u32x2 ow; ow.x = cvt_pk_bf16(y[0], y[1]); ow.y = cvt_pk_bf16(y[2], y[3]);
            *(u32x2*)(P.Y + (size_t)CH_ROW(ch, l) * 512 + P.h * 64 + p0) = ow;
        }
        { const float dec = fexp(acs_end); const int pt = lt;
          bf16x8 af[2];
#pragma unroll
          for (int ks = 0; ks < 2; ++ks) af[ks] = tr_frag(lds + O_XW, PX, ks * 32, pt * 16, lane);
#pragma unroll
          for (int i = 0; i < 4; ++i) { const int nt = h2 * 4 + i;
              f32x4 acc = Sacc[i] * dec;
#pragma unroll
              for (int ks = 0; ks < 2; ++ks) { const bf16x8 bfr = tr_frag(Bb, PC, ks * 32, nt * 16, lane); acc = __builtin_amdgcn_mfma_f32_16x16x32_bf16(af[ks], bfr, acc, 0, 0, 0); }
              Sacc[i] = acc;
              const int n = nt * 16 + fr;
#pragma unroll
              for (int jj = 0; jj < 4; ++jj) { const int p = pt * 16 + fq * 4 + jj; *(LAS bf16*)(lds + O_SB + p * PC + n * 2) = (bf16)f2bf(acc[jj]); } } }
        __syncthreads();
    }
#undef CH_ROW
#undef SSD_LOAD
#undef SSD_WRITE
}
}

namespace lru {
constexpr int SS = 72 * 2;
constexpr int O_U = 0, O_WA = O_U + 2 * 128 * SS, O_WI = O_WA + 64 * SS, O_HL = O_WI + 64 * SS, O_CP = O_HL + 32768, O_AGG = O_CP + 32768, O_CW = O_AGG + 2 * 8 * 2 * 64 * 4, O_END = O_CW + 64 * 5 * 4;
static_assert(O_END <= 131072, "lru lds");
struct Par { const bf16* ZZ; bf16* Hout; const float* conv_w; const float* conv_b; const float* wa; const float* wi; const float* ba; const float* bi; const float* lam; int b, n, d; };
static __device__ __forceinline__ void unit(Par P_) {
    Par P; P.ZZ = uni(P_.ZZ); P.Hout = uni(P_.Hout); P.conv_w = uni(P_.conv_w); P.conv_b = uni(P_.conv_b); P.wa = uni(P_.wa); P.wi = uni(P_.wi); P.ba = uni(P_.ba); P.bi = uni(P_.bi); P.lam = uni(P_.lam); P.b = uni(P_.b); P.n = uni(P_.n); P.d = uni(P_.d);
    LAS char* lds = (LAS char*)olds();
    const int tid = otid(), wid = __builtin_amdgcn_readfirstlane(tid >> 6), lane = tid & 63, fr = lane & 15, fq = lane >> 4;
    LAS float* HL = (LAS float*)(lds + O_HL) + wid * 1024; LAS float* CP = (LAS float*)(lds + O_CP) + wid * 1024;
    LAS float* AGG = (LAS float*)(lds + O_AGG); LAS float* CW = (LAS float*)(lds + O_CW);
    for (int i = tid; i < 64 * 5; i += 512) { const int lc = i / 5, j = i % 5; const int c = P.n * 64 + lc; CW[i] = j < 4 ? P.conv_w[j * 512 + c] : P.conv_b[c]; }
    { float wav[8], wiv[8];
#pragma unroll
      for (int q = 0; q < 8; ++q) { wav[q] = P.wa[tid + 512 * q]; wiv[q] = P.wi[tid + 512 * q]; }
#pragma unroll
      for (int q = 0; q < 8; ++q) { const int i = tid + 512 * q, k = i >> 6, j = i & 63;
          *(LAS bf16*)(lds + O_WA + j * SS + k * 2) = (bf16)f2bf(wav[q]); *(LAS bf16*)(lds + O_WI + j * SS + k * 2) = (bf16)f2bf(wiv[q]); } }
    const int chn = P.n * 64 + lane;
    const float ba = P.ba[chn], bi = P.bi[chn], c8 = -8.0f * softplusf_(-P.lam[chn]);
    float hc = 0.f;
    u32x4 xr[2][4];
#define LRU_LOAD(chn_) do { const bool ic_ = (chn_) < 2; const int cc_ = ic_ ? (chn_) : (chn_) - 2; const int Ls_ = ic_ ? CTXL : SEQ; const int rs_ = ic_ ? NLAT + P.b * CTXL : P.b * SEQ; \
        _Pragma("unroll") for (int q_ = 0; q_ < 2; ++q_) { const int it_ = tid + 512 * q_; const int pos_ = it_ >> 3, lc_ = (it_ & 7) * 8; const int sp_ = cc_ * 128 + pos_; const int tk_ = P.d ? Ls_ - 1 - sp_ : sp_; \
            _Pragma("unroll") for (int j_ = 0; j_ < 4; ++j_) { const int t2_ = tk_ + j_ - 2; const int tc_ = t2_ < 0 ? 0 : (t2_ >= Ls_ ? Ls_ - 1 : t2_); \
                xr[q_][j_] = *(const u32x4*)(P.ZZ + (size_t)(rs_ + tc_) * ZLD + ZC_LX + P.n * 64 + lc_); } } } while (0)
    LRU_LOAD(0);
    __syncthreads();
    float cwr[8][5];
    { const int lcw = (tid & 7) * 8;
#pragma unroll
      for (int e = 0; e < 8; ++e)
#pragma unroll
          for (int j = 0; j < 5; ++j) cwr[e][j] = CW[(lcw + e) * 5 + j]; }
    for (int ch = 0; ch < 34; ++ch) {
        const bool isctx = ch < 2; const int cc = isctx ? ch : ch - 2; const int Ls = isctx ? CTXL : SEQ; const int rseg = isctx ? NLAT + P.b * CTXL : P.b * SEQ;
        const int ub = O_U + (ch & 1) * 128 * SS; LAS float* AGGc = AGG + (ch & 1) * 1024;
#pragma unroll
        for (int q = 0; q < 2; ++q) {
            const int it = tid + 512 * q; const int pos = it >> 3, lc0 = (it & 7) * 8;
            const int sp = cc * 128 + pos; const int tk = P.d ? Ls - 1 - sp : sp;
            float u[8];
#pragma unroll
            for (int e = 0; e < 8; ++e) u[e] = cwr[e][4];
#pragma unroll
            for (int j = 0; j < 4; ++j) { const int t2 = tk + j - 2;
                if (t2 >= 0 && t2 < Ls) { const u32x4 xv = xr[q][j];
                    u[0] += bflo(xv.x) * cwr[0][j]; u[1] += bfhi(xv.x) * cwr[1][j]; u[2] += bflo(xv.y) * cwr[2][j]; u[3] += bfhi(xv.y) * cwr[3][j];
                    u[4] += bflo(xv.z) * cwr[4][j]; u[5] += bfhi(xv.z) * cwr[5][j]; u[6] += bflo(xv.w) * cwr[6][j]; u[7] += bfhi(xv.w) * cwr[7][j]; } }
            u32x4 w; w.x = cvt_pk_bf16(u[0], u[1]); w.y = cvt_pk_bf16(u[2], u[3]); w.z = cvt_pk_bf16(u[4], u[5]); w.w = cvt_pk_bf16(u[6], u[7]);
            *(LAS u32x4*)(lds + ub + pos * SS + lc0 * 2) = w;
        }
        if (ch + 1 < 34) LRU_LOAD(ch + 1);
        __syncthreads();
#pragma unroll
        for (int jt = 0; jt < 4; ++jt) {
            const f32x4 ga = mma_tile(lds + ub + wid * 16 * SS, SS, lds + O_WA + jt * 16 * SS, SS, 2, lane, (f32x4){0.f, 0.f, 0.f, 0.f});
            const f32x4 gi = mma_tile(lds + ub + wid * 16 * SS, SS, lds + O_WI + jt * 16 * SS, SS, 2, lane, (f32x4){0.f, 0.f, 0.f, 0.f});
#pragma unroll
            for (int jj = 0; jj < 4; ++jj) { HL[(fq * 4 + jj) * 64 + jt * 16 + fr] = ga[jj]; CP[(fq * 4 + jj) * 64 + jt * 16 + fr] = gi[jj]; }
        }
        LDS_WAIT();
        float h = 0.f, Pp = 1.f;
        {
            float av[16], bv[16];
#pragma unroll
            for (int i = 0; i < 16; ++i) {
                const float uo = bf2f(*(const LAS bf16*)(lds + ub + (wid * 16 + i) * SS + lane * 2));
                const float r = sigmoidf_(HL[i * 64 + lane] + ba), ig = sigmoidf_(CP[i * 64 + lane] + bi), la = c8 * r;
                const float l2 = 2.0f * la;
                const float aa = fexp(la);
                const float om = l2 > -0.02f ? -l2 * (1.0f + l2 * (0.5f + l2 * (0.16666667f + l2 * 0.041666668f))) : fmaf(-aa, aa, 1.0f);
                av[i] = aa; bv[i] = __builtin_amdgcn_sqrtf(om) * (ig * uo);
            }
#pragma unroll
            for (int i = 0; i < 16; ++i) { h = av[i] * h + bv[i]; Pp *= av[i]; HL[i * 64 + lane] = h; CP[i * 64 + lane] = Pp; }
        }
        AGGc[(wid * 2 + 0) * 64 + lane] = Pp; AGGc[(wid * 2 + 1) * 64 + lane] = h;
        __syncthreads();
        float cin = hc, call = hc;
#pragma unroll
        for (int w = 0; w < 8; ++w) { const float pw = AGGc[(w * 2 + 0) * 64 + lane], hw = AGGc[(w * 2 + 1) * 64 + lane]; call = pw * call + hw; if (w < wid) cin = call; }
        hc = call;
        for (int i = 0; i < 16; ++i) {
            const float hf = HL[i * 64 + lane] + CP[i * 64 + lane] * cin;
            const int sp = cc * 128 + wid * 16 + i; const int tk = P.d ? Ls - 1 - sp : sp;
            P.Hout[(size_t)(rseg + tk) * 512 + chn] = (bf16)f2bf(hf);
        }
    }
    __syncthreads();
#undef LRU_LOAD
}
}

struct Args { const float* in[35]; float* out; unsigned char* ws; int ph_lo, ph_hi; };
constexpr int CTX_OFF = MISC_OFF + 128;
struct Ctx {
    static __device__ __forceinline__ unsigned long long ldp(int i) { int off_ = CTX_OFF + 8 * i; asm volatile("" : "+v"(off_)); const volatile LAS unsigned* p = (const volatile LAS unsigned*)((LAS unsigned char*)lds_raw + off_);
        const unsigned lo = __builtin_amdgcn_readfirstlane(p[0]), hi = __builtin_amdgcn_readfirstlane(p[1]); return ((unsigned long long)hi << 32) | lo; }
    __device__ __forceinline__ const float* in(int i) const { return (const float*)(const GAS float*)ldp(i); }
    __device__ __forceinline__ float* out() const { return (float*)(GAS float*)ldp(35); }
    __device__ __forceinline__ unsigned char* ws() const { return (unsigned char*)(GAS unsigned char*)ldp(36); }
};
enum { I_X = 0, I_C, I_CTX, I_CCTX, I_WMOD, I_BMOD, I_WIN, I_LAMQ, I_LAMK, I_ATTNG, I_LCW, I_LCB, I_LWA, I_LBA, I_LWI, I_LBI, I_LLAM, I_SCW, I_SCB, I_SDTB, I_SALOG, I_SD, I_SNG,
       I_WBR, I_WOUT, I_LN1G, I_LN1B, I_WRT, I_RBIAS, I_WUP, I_WDN, I_WSU, I_WSD, I_LN2G, I_LN2B };

__device__ __forceinline__ int map_win(int n) {
    if (n < 1024) { const int o = n & 63; return (n & ~63) + 2 * (o & 31) + (o >> 5); }
    if (n < 4096) return n;
    if (n < 4112) return ZC_DT + (n - 4096);
    return ZC_GATE + (n - 4112);
}
__device__ __forceinline__ int map_up(int n) { const int j = n & 255, isu = n >> 8; return (j >> 7) * 256 + isu * 128 + (j & 127); }
struct CvtMat { const float* src; bf16* dst; int ld, K, N, ldd, mode, ntile; };
__device__ __forceinline__ CvtMat cvt_mat(const Ctx a, int l, int m) {
    unsigned char* W = a.ws() + WS_W; CvtMat c;
    if (m == 0) { c.src = a.in(I_WIN) + (size_t)l * 1024 * IN_TOTAL; c.dst = (bf16*)(W + W_IN); c.ld = IN_TOTAL; c.K = 1024; c.N = IN_TOTAL; c.ldd = 1024; c.mode = 1; }
    else if (m < 4) { const int br = m - 1; c.src = a.in(I_WBR) + (size_t)(l * 3 + br) * 512 * 1024; c.dst = (bf16*)(W + W_BR) + (size_t)br * 1024 * 512; c.ld = 1024; c.K = 512; c.N = 1024; c.ldd = 512; c.mode = 0; }
    else if (m == 4) { c.src = a.in(I_WOUT) + (size_t)l * 1024 * 1024; c.dst = (bf16*)(W + W_OUT); c.ld = 1024; c.K = 1024; c.N = 1024; c.ldd = 1024; c.mode = 0; }
    else if (m == 5) { c.src = a.in(I_WSU) + (size_t)l * 1024 * 512; c.dst = (bf16*)(W + W_SU); c.ld = 512; c.K = 1024; c.N = 512; c.ldd = 1024; c.mode = 2; }
    else if (m == 6) { c.src = a.in(I_WSD) + (size_t)l * 256 * 1024; c.dst = (bf16*)(W + W_SD); c.ld = 1024; c.K = 256; c.N = 1024; c.ldd = 256; c.mode = 0; }
    else if (m < 71) { const int e = m - 7; c.src = a.in(I_WUP) + (size_t)(l * 64 + e) * 1024 * 512; c.dst = (bf16*)(W + W_UP) + (size_t)e * 512 * 1024; c.ld = 512; c.K = 1024; c.N = 512; c.ldd = 1024; c.mode = 2; }
    else { const int e = m - 71; c.src = a.in(I_WDN) + (size_t)(l * 64 + e) * 256 * 1024; c.dst = (bf16*)(W + W_DN) + (size_t)e * 1024 * 256; c.ld = 1024; c.K = 256; c.N = 1024; c.ldd = 256; c.mode = 0; }
    c.ntile = (c.K / 64) * ((c.N + 255) / 256); return c;
}
constexpr int CVT_T0 = 16 * 29, CVT_T1 = CVT_T0 + 96, CVT_T2 = CVT_T1 + 64, CVT_T3 = CVT_T2 + 32, CVT_T4 = CVT_T3 + 16, CVT_T5 = CVT_T4 + 2048, CVT_NT = CVT_T5 + 1024;
__device__ __forceinline__ void cvt_locate(int it, int& m, int& r) {
    if (it < CVT_T0) { m = 0; r = it; } else if (it < CVT_T1) { const int q = it - CVT_T0; m = 1 + q / 32; r = q % 32; } else if (it < CVT_T2) { m = 4; r = it - CVT_T1; }
    else if (it < CVT_T3) { m = 5; r = it - CVT_T2; } else if (it < CVT_T4) { m = 6; r = it - CVT_T3; } else if (it < CVT_T5) { const int q = it - CVT_T4; m = 7 + q / 32; r = q % 32; }
    else { const int q = it - CVT_T5; m = 71 + q / 16; r = q % 16; }
}
__device__ __forceinline__ void convert_layer_weights(const Ctx a, int l, LAS float* scr) {
    const int tid = otid();
    for (int r = blockIdx.x; r < 16; r += gridDim.x) { const float* wr = a.in(I_WRT) + (size_t)l * 1024 * 64; bf16* o = (bf16*)(a.ws() + WS_W + W_RT);
        for (int i = r * 4096 + tid; i < (r + 1) * 4096; i += 512) { const int k = i >> 6, n = i & 63; const float v = wr[i]; const unsigned hi = f2bf(v); const unsigned lo = f2bf(v - bf2f(hi));
            o[(size_t)n * 1024 + k] = (bf16)hi; o[(size_t)(128 + n) * 1024 + k] = (bf16)lo; } }
    f32x4 st[8];
    int it = osg((int)blockIdx.x); int m = 0, r = 0; CvtMat c; bool have = it < CVT_NT;
#define CVT_LOAD() do { cvt_locate(it, m, r); c = cvt_mat(a, l, m); const int nblk_ = (c.N + 255) >> 8; const int kb_ = r / nblk_, nb_ = r - kb_ * nblk_; const int n_ = nb_ * 256 + 4 * (tid & 63); \
        _Pragma("unroll") for (int i_ = 0; i_ < 8; ++i_) { const int kk_ = kb_ * 64 + (tid >> 6) + 8 * i_; st[i_] = (n_ < c.N) ? *(const f32x4*)(c.src + (size_t)kk_ * c.ld + n_) : (f32x4){0.f, 0.f, 0.f, 0.f}; } } while (0)
    if (have) CVT_LOAD();
    while (have) {
        const int nblk = (c.N + 255) >> 8; const int kb = r / nblk, nb = r - kb * nblk; const int k0 = kb * 64, n0 = nb * 256;
        const int mode = c.mode, N = c.N, ldd = c.ldd; bf16* dst = c.dst;
#pragma unroll
        for (int i = 0; i < 8; ++i) { const int kk_ = (tid >> 6) + 8 * i; *(LAS f32x4*)(scr + kk_ * 260 + (((tid & 63) ^ ((kk_ >> 3) & 7)) << 2)) = st[i]; }
        it += gridDim.x; have = it < CVT_NT;
        if (have) CVT_LOAD();
        __syncthreads();
#pragma unroll
        for (int j = 0; j < 4; ++j) { const int q = tid + 512 * j; const int nn = q >> 3, kc = (q & 7) * 8, n = n0 + nn;
            if (n < N) { const LAS float* sp = scr + kc * 260 + ((((nn >> 2) ^ ((kc >> 3) & 7)) << 2) | (nn & 3));
                u32x4 o; o.x = cvt_pk_bf16(sp[0], sp[260]); o.y = cvt_pk_bf16(sp[2 * 260], sp[3 * 260]); o.z = cvt_pk_bf16(sp[4 * 260], sp[5 * 260]); o.w = cvt_pk_bf16(sp[6 * 260], sp[7 * 260]);
                const int rr = mode == 1 ? map_win(n) : (mode == 2 ? map_up(n) : n);
                *(u32x4*)(dst + (size_t)rr * ldd + k0 + kc) = o; } }
        __syncthreads();
    }
#undef CVT_LOAD
}

__device__ __forceinline__ void phase_mod_rope(const Ctx a, LAS float* lds) {
    const int tid = otid();
    float* mod = (float*)(a.ws() + WS_MOD); float* cosT = (float*)(a.ws() + WS_ROPE); float* sinT = cosT + 4096 * 32;
    LAS float* S = lds; LAS float* RED = lds + 9 * 1024;
    for (int i = tid; i < 9 * 1024; i += 512) { const float v = i < 8192 ? a.in(I_C)[i] : a.in(I_CCTX)[i - 8192]; S[i] = siluf_(v); }
    __syncthreads();
    for (int un = blockIdx.x; un < 2 * 96; un += gridDim.x) {
        const int l = un / 96, cb = un % 96, kg = tid >> 6, j = tid & 63, col = cb * 64 + j;
        const float* w = a.in(I_WMOD) + (size_t)l * 1024 * 6144 + col;
        float acc[9];
#pragma unroll
        for (int r = 0; r < 9; ++r) acc[r] = 0.f;
        for (int k = kg * 128; k < kg * 128 + 128; ++k) { const float wv = w[(size_t)k * 6144];
#pragma unroll
            for (int r = 0; r < 9; ++r) acc[r] += S[r * 1024 + k] * wv; }
#pragma unroll
        for (int r = 0; r < 9; ++r) RED[(kg * 9 + r) * 64 + j] = acc[r];
        __syncthreads();
        for (int o = tid; o < 9 * 64; o += 512) { const int r = o >> 6, jj = o & 63; float s = a.in(I_BMOD)[l * 6144 + cb * 64 + jj];
#pragma unroll
            for (int g = 0; g < 8; ++g) s += RED[(g * 9 + r) * 64 + jj];
            mod[((size_t)l * 9 + r) * 6144 + cb * 64 + jj] = s; }
        __syncthreads();
    }
    for (int i = blockIdx.x * 512 + tid; i < 4096 * 32; i += gridDim.x * 512) {
        const int t = i >> 5, f = i & 31; const float pos = (float)(f < 16 ? (t >> 6) : (t & 63));
        const float inv = powf(10000.0f, -(float)(f & 15) / 16.0f); const float ang = pos * inv;
        cosT[i] = cosf(ang); sinT[i] = sinf(ang);
    }
}

__device__ __forceinline__ const float* xrow_in(const Ctx a, int l, int row) {
    if (l == 0) return row < NLAT ? a.in(I_X) + (size_t)row * 1024 : a.in(I_CTX) + (size_t)(row - NLAT) * 1024;
    return (const float*)(a.ws() + WS_X) + (size_t)row * 1024;
}
template <int MAP = 0> __device__ __forceinline__ int lncol(int lane, int j) { return MAP == 2 ? (16 * lane + 4 * j) : (MAP == 1 ? ((j >> 1) * 512 + 8 * lane + (j & 1) * 4) : (4 * lane + 256 * j)); }
template <int M8 = 0>
__device__ __forceinline__ void store_h_row(bf16* hrow, const f32x4 (&v)[4], const float* m0, const float* m1, int lane) {
    u32x2 w[4];
#pragma unroll
    for (int j = 0; j < 4; ++j) { const int c = lncol<M8>(lane, j); const f32x4 s = *(const f32x4*)(m1 + c), t = *(const f32x4*)(m0 + c);
        w[j].x = cvt_pk_bf16(v[j][0] * (1.f + s[0]) + t[0], v[j][1] * (1.f + s[1]) + t[1]); w[j].y = cvt_pk_bf16(v[j][2] * (1.f + s[2]) + t[2], v[j][3] * (1.f + s[3]) + t[3]); }
    if (M8) {
#pragma unroll
        for (int jj = 0; jj < 2; ++jj) *(u32x4*)(hrow + lncol<M8>(lane, 2 * jj)) = (u32x4){w[2 * jj].x, w[2 * jj].y, w[2 * jj + 1].x, w[2 * jj + 1].y};
    } else {
#pragma unroll
        for (int j = 0; j < 4; ++j) *(u32x2*)(hrow + lncol<0>(lane, j)) = w[j];
    }
}
template <int M8 = 0>
__device__ __forceinline__ void layer_norm_row(f32x4 (&v)[4], const float* g, const float* b, int lane) {
    float s = 0.f;
#pragma unroll
    for (int j = 0; j < 4; ++j) s += (v[j][0] + v[j][1]) + (v[j][2] + v[j][3]);
    const float mean = wave_sum(s) * (1.f / 1024.f); float q = 0.f;
#pragma unroll
    for (int j = 0; j < 4; ++j) { v[j] = v[j] - mean; q += (v[j][0] * v[j][0] + v[j][1] * v[j][1]) + (v[j][2] * v[j][2] + v[j][3] * v[j][3]); }
    const float rstd = __builtin_amdgcn_rsqf(wave_sum(q) * (1.f / 1024.f) + LN_EPS);
#pragma unroll
    for (int j = 0; j < 4; ++j) { const int c = lncol<M8>(lane, j); const f32x4 gg = *(const f32x4*)(g + c), bb = *(const f32x4*)(b + c); v[j] = v[j] * rstd * gg + bb; }
}
__device__ __forceinline__ void lds_fill(LAS float* dst, const float* src, int n, int tid) { for (int i = tid * 4; i < n; i += 2048) *(LAS f32x4*)(dst + i) = *(const f32x4*)(src + i); }
template <int M8>
__device__ __forceinline__ void store_h_row_l(bf16* hrow, const f32x4 (&v)[4], const LAS float* m0, const LAS float* m1, int lane) {
    u32x2 w[4];
#pragma unroll
    for (int j = 0; j < 4; ++j) { const int c = lncol<M8>(lane, j); const f32x4 s = *(const LAS f32x4*)(m1 + c), t = *(const LAS f32x4*)(m0 + c);
        w[j].x = cvt_pk_bf16(v[j][0] * (1.f + s[0]) + t[0], v[j][1] * (1.f + s[1]) + t[1]); w[j].y = cvt_pk_bf16(v[j][2] * (1.f + s[2]) + t[2], v[j][3] * (1.f + s[3]) + t[3]); }
#pragma unroll
    for (int jj = 0; jj < 2; ++jj) *(u32x4*)(hrow + lncol<M8>(lane, 2 * jj)) = (u32x4){w[2 * jj].x, w[2 * jj].y, w[2 * jj + 1].x, w[2 * jj + 1].y};
}
template <int M8>
__device__ __forceinline__ void layer_norm_row_l(f32x4 (&v)[4], const LAS float* g, const LAS float* b, int lane) {
    float s = 0.f;
#pragma unroll
    for (int j = 0; j < 4; ++j) s += (v[j][0] + v[j][1]) + (v[j][2] + v[j][3]);
    const float mean = wave_sum(s) * (1.f / 1024.f); float q = 0.f;
#pragma unroll
    for (int j = 0; j < 4; ++j) { v[j] = v[j] - mean; q += (v[j][0] * v[j][0] + v[j][1] * v[j][1]) + (v[j][2] * v[j][2] + v[j][3] * v[j][3]); }
    const float rstd = __builtin_amdgcn_rsqf(wave_sum(q) * (1.f / 1024.f) + LN_EPS);
#pragma unroll
    for (int j = 0; j < 4; ++j) { const int c = lncol<M8>(lane, j); const f32x4 gg = *(const LAS f32x4*)(g + c), bb = *(const LAS f32x4*)(b + c); v[j] = v[j] * rstd * gg + bb; }
}
__device__ __forceinline__ void phase_modulate0(const Ctx a, LAS float* P) {
    const int tid_ = otid(); const int lane = tid_ & 63, gw = blockIdx.x * 8 + (tid_ >> 6), NGW = gridDim.x * 8;
    const float* mod = (const float*)(a.ws() + WS_MOD); bf16* H = (bf16*)(a.ws() + WS_ACT);
    for (int r = 0; r < 9; ++r) lds_fill(P + r * 2048, mod + (size_t)r * 6144, 2048, tid_);
    __syncthreads();
    f32x4 v[4], vn[4], vn2[4];
#define MD0_LOAD(row_, dst_) do { const float* xr_ = xrow_in(a, 0, (row_)); _Pragma("unroll") for (int j = 0; j < 4; ++j) dst_[j] = *(const f32x4*)(xr_ + lncol<1>(lane, j)); } while (0)
    { const int r0_ = gw < MTOK ? gw : 0, r1_ = gw + NGW < MTOK ? gw + NGW : r0_; MD0_LOAD(r0_, v); MD0_LOAD(r1_, vn); }
    for (int row = gw; row < MTOK; row += NGW) {
        { const int rp_ = row + 2 * NGW < MTOK ? row + 2 * NGW : row; MD0_LOAD(rp_, vn2); }
        const int mr = row < NLAT ? (row >> 12) : 8; const LAS float* mm = P + mr * 2048;
        store_h_row_l<1>(H + (size_t)row * 1024, v, mm, mm + 1024, lane);
#pragma unroll
        for (int j = 0; j < 4; ++j) { v[j] = vn[j]; vn[j] = vn2[j]; }
    }
#undef MD0_LOAD
}
__device__ __forceinline__ void phase_scan_prep(const Ctx a, int l) {
    const int tid = otid(), lane = tid & 63;
    const bf16* ZZ = (const bf16*)(a.ws() + WS_ZZ); bf16* XA = (bf16*)(a.ws() + WS_H); float* DT = (float*)(a.ws() + WS_LOGIT); float* ACS = DT + (size_t)MTOK * 16;
    const float* cw = a.in(I_SCW) + (size_t)l * 4 * 1024; const float* cb = a.in(I_SCB) + l * 1024;
    u32x4 xr[7], xn[7];
    const int NIT = (MTOK / 4) * 128, ITS = gridDim.x * 512;
#define PREP_GEO(it_) const int oc = (it_) & 127, row0 = ((it_) >> 7) * 4, c0 = oc * 8; int segbase, Ls; if (row0 < NLAT) { segbase = row0 & ~(SEQ - 1); Ls = SEQ; } else { segbase = NLAT + ((row0 - NLAT) & ~(CTXL - 1)); Ls = CTXL; } const int t0 = row0 - segbase;
#define PREP_LOAD(it_, dst_) do { PREP_GEO(it_) _Pragma("unroll") for (int jr = 0; jr < 7; ++jr) { const int t = t0 - 2 + jr; const int tc = t < 0 ? 0 : (t >= Ls ? Ls - 1 : t); dst_[jr] = *(const u32x4*)(ZZ + (size_t)(segbase + tc) * ZLD + ZC_XBC + c0); } } while (0)
    { const int it0 = blockIdx.x * 512 + tid; PREP_LOAD(it0 < NIT ? it0 : 0, xr); }
    float w[4][8], bia[8];
    { const int c0w = (tid & 127) * 8;
#pragma unroll
      for (int j = 0; j < 4; ++j) { const f32x4 w0 = *(const f32x4*)(cw + j * 1024 + c0w), w1 = *(const f32x4*)(cw + j * 1024 + c0w + 4);
          w[j][0] = w0[0]; w[j][1] = w0[1]; w[j][2] = w0[2]; w[j][3] = w0[3]; w[j][4] = w1[0]; w[j][5] = w1[1]; w[j][6] = w1[2]; w[j][7] = w1[3]; }
      const f32x4 b0 = *(const f32x4*)(cb + c0w), b1 = *(const f32x4*)(cb + c0w + 4);
      bia[0] = b0[0]; bia[1] = b0[1]; bia[2] = b0[2]; bia[3] = b0[3]; bia[4] = b1[0]; bia[5] = b1[1]; bia[6] = b1[2]; bia[7] = b1[3]; }
    for (int it = blockIdx.x * 512 + tid; it < NIT; it += ITS) {
        { const int itn_ = it + ITS < NIT ? it + ITS : it; PREP_LOAD(itn_, xn); }
        PREP_GEO(it)
        float acc[4][8];
#pragma unroll
        for (int o = 0; o < 4; ++o)
#pragma unroll
            for (int e = 0; e < 8; ++e) acc[o][e] = bia[e];
#pragma unroll
        for (int jr = 0; jr < 7; ++jr) { const int t = t0 - 2 + jr;
            if (t >= 0 && t < Ls) { const u32x4 xv = xr[jr];
                float x[8]; x[0] = bflo(xv.x); x[1] = bfhi(xv.x); x[2] = bflo(xv.y); x[3] = bfhi(xv.y); x[4] = bflo(xv.z); x[5] = bfhi(xv.z); x[6] = bflo(xv.w); x[7] = bfhi(xv.w);
#pragma unroll
                for (int o = 0; o < 4; ++o) { const int j = jr - o; if (j >= 0 && j < 4) {
#pragma unroll
                    for (int e = 0; e < 8; ++e) acc[o][e] += x[e] * w[j][e]; } } } }
#pragma unroll
        for (int o = 0; o < 4; ++o) { u32x4 ov; ov.x = cvt_pk_bf16(siluf_(acc[o][0]), siluf_(acc[o][1])); ov.y = cvt_pk_bf16(siluf_(acc[o][2]), siluf_(acc[o][3])); ov.z = cvt_pk_bf16(siluf_(acc[o][4]), siluf_(acc[o][5])); ov.w = cvt_pk_bf16(siluf_(acc[o][6]), siluf_(acc[o][7]));
            *(u32x4*)(XA + (size_t)(row0 + o) * 1024 + c0) = ov; }
#pragma unroll
        for (int jr = 0; jr < 7; ++jr) xr[jr] = xn[jr];
    }
#undef PREP_GEO
#undef PREP_LOAD
    {
        const bf16* Hm = (const bf16*)(a.ws() + WS_ACT); const bf16* Wd = (const bf16*)(a.ws() + WS_W + W_IN) + (size_t)ZC_DT * 1024;
        const int r = lane & 15, q = lane >> 4;
        const float dtb = a.in(I_SDTB)[l * 16 + r], nega = -__expf(a.in(I_SALOG)[l * 16 + r]);
        for (int blk = blockIdx.x * 8 + (tid >> 6); blk < MTOK / 64; blk += gridDim.x * 8) {
            const int row0 = blk * 64;
            f32x4 c4[4];
#pragma unroll
            for (int mb = 0; mb < 4; ++mb) c4[mb] = (f32x4){0.f, 0.f, 0.f, 0.f};
            const bf16* hb = Hm + (size_t)(row0 + r) * 1024 + q * 8; const bf16* wb = Wd + (size_t)r * 1024 + q * 8;
            for (int ks0 = 0; ks0 < 32; ks0 += 4) {
                bf16x8 bv[4], av[4][4];
#pragma unroll
                for (int u = 0; u < 4; ++u) { bv[u] = *(const bf16x8*)(wb + (ks0 + u) * 32);
#pragma unroll
                    for (int mb = 0; mb < 4; ++mb) av[u][mb] = *(const bf16x8*)(hb + (size_t)mb * 16 * 1024 + (ks0 + u) * 32); }
#pragma unroll
                for (int u = 0; u < 4; ++u)
#pragma unroll
                    for (int mb = 0; mb < 4; ++mb) c4[mb] = __builtin_amdgcn_mfma_f32_16x16x32_bf16(av[u][mb], bv[u], c4[mb], 0, 0, 0);
            }
            float dtv[4][4], pre[4][4], carry = 0.f;
#pragma unroll
            for (int mb = 0; mb < 4; ++mb) {
                float run = 0.f;
#pragma unroll
                for (int j = 0; j < 4; ++j) { const float dt = softplusf_(c4[mb][j] + dtb); dtv[mb][j] = dt; run += dt * nega; pre[mb][j] = run; }
                float s1 = run; { const float t = __shfl_up(s1, 16); if (q >= 1) s1 += t; } { const float t = __shfl_up(s1, 32); if (q >= 2) s1 += t; }
                const float excl = s1 - run, tot = __shfl(s1, 48 + r);
#pragma unroll
                for (int j = 0; j < 4; ++j) pre[mb][j] += carry + excl;
                carry += tot;
            }
#pragma unroll
            for (int mb = 0; mb < 4; ++mb)
#pragma unroll
                for (int j = 0; j < 4; ++j) { const float v = dtv[mb][j] * nega; const float ac = r < 8 ? pre[mb][j] : carry - pre[mb][j] + v;
                    const size_t o = (size_t)(row0 + 16 * mb + 4 * q + j) * 16 + r; DT[o] = dtv[mb][j]; ACS[o] = ac; }
        }
    }
}
__device__ __forceinline__ void phase_mixer_finalize(const Ctx a, int l, int nrows, bool dry = false) {
    const int tid_ = otid(); const int lane = tid_ & 63, gw = blockIdx.x * 8 + (tid_ >> 6), NGW = gridDim.x * 8;
    bf16* ZZ = (bf16*)(a.ws() + WS_ZZ); const bf16* SCR = (const bf16*)(a.ws() + WS_ACT); const size_t SS_ = (size_t)MTOK * 512;
    const float* ng = a.in(I_SNG) + l * 512 + 8 * lane;
    const f32x4 g0 = *(const f32x4*)ng, g1 = *(const f32x4*)(ng + 4);
    u32x4 c_[6], n_[6], n2_[6];
#define FIN_LOAD(row_, d_) do { const size_t so_ = (size_t)(row_) * 512 + 8 * lane; const bf16* zr_ = ZZ + (size_t)(row_) * ZLD; \
        d_[0] = *(const u32x4*)(SCR + so_); d_[1] = *(const u32x4*)(SCR + SS_ + so_); d_[2] = *(const u32x4*)(SCR + 2 * SS_ + so_); d_[3] = *(const u32x4*)(SCR + 3 * SS_ + so_); \
        d_[4] = *(const u32x4*)(zr_ + ZC_LG + 8 * lane); d_[5] = *(const u32x4*)(zr_ + ZC_Z + 8 * lane); } while (0)
    { const int r0_ = gw < nrows ? gw : 0, r1_ = gw + NGW < nrows ? gw + NGW : r0_; FIN_LOAD(r0_, c_); FIN_LOAD(r1_, n_); }
    for (int row = gw; row < nrows; row += NGW) {
        { const int rp_ = row + 2 * NGW < nrows ? row + 2 * NGW : row; FIN_LOAD(rp_, n2_); }
        const u32x4 h0 = c_[0], h1 = c_[1], y0 = c_[2], y1 = c_[3], lg = c_[4], zz = c_[5];
        bf16* zr = ZZ + (size_t)row * ZLD;
        float hb[8], t[8], lgv[8], zv[8];
        hb[0] = bflo(h0.x) + bflo(h1.x); hb[1] = bfhi(h0.x) + bfhi(h1.x); hb[2] = bflo(h0.y) + bflo(h1.y); hb[3] = bfhi(h0.y) + bfhi(h1.y);
        hb[4] = bflo(h0.z) + bflo(h1.z); hb[5] = bfhi(h0.z) + bfhi(h1.z); hb[6] = bflo(h0.w) + bflo(h1.w); hb[7] = bfhi(h0.w) + bfhi(h1.w);
        t[0] = bflo(y0.x) + bflo(y1.x); t[1] = bfhi(y0.x) + bfhi(y1.x); t[2] = bflo(y0.y) + bflo(y1.y); t[3] = bfhi(y0.y) + bfhi(y1.y);
        t[4] = bflo(y0.z) + bflo(y1.z); t[5] = bfhi(y0.z) + bfhi(y1.z); t[6] = bflo(y0.w) + bflo(y1.w); t[7] = bfhi(y0.w) + bfhi(y1.w);
        lgv[0] = bflo(lg.x); lgv[1] = bfhi(lg.x); lgv[2] = bflo(lg.y); lgv[3] = bfhi(lg.y); lgv[4] = bflo(lg.z); lgv[5] = bfhi(lg.z); lgv[6] = bflo(lg.w); lgv[7] = bfhi(lg.w);
        zv[0] = bflo(zz.x); zv[1] = bfhi(zz.x); zv[2] = bflo(zz.y); zv[3] = bfhi(zz.y); zv[4] = bflo(zz.z); zv[5] = bfhi(zz.z); zv[6] = bflo(zz.w); zv[7] = bfhi(zz.w);
        float ss = 0.f;
#pragma unroll
        for (int e = 0; e < 8; ++e) { hb[e] *= gelu_tanh(lgv[e]); t[e] *= siluf_(zv[e]); ss += t[e] * t[e]; }
#pragma unroll
        for (int off = 1; off < 32; off <<= 1) ss += __shfl_xor(ss, off);
        const float ri = __builtin_amdgcn_rsqf(ss * (1.f / 256.f) + RMS_EPS);
        u32x4 wb, wc;
        wb.x = cvt_pk_bf16(hb[0], hb[1]); wb.y = cvt_pk_bf16(hb[2], hb[3]); wb.z = cvt_pk_bf16(hb[4], hb[5]); wb.w = cvt_pk_bf16(hb[6], hb[7]);
        wc.x = cvt_pk_bf16(t[0] * ri * g0[0], t[1] * ri * g0[1]); wc.y = cvt_pk_bf16(t[2] * ri * g0[2], t[3] * ri * g0[3]);
        wc.z = cvt_pk_bf16(t[4] * ri * g1[0], t[5] * ri * g1[1]); wc.w = cvt_pk_bf16(t[6] * ri * g1[2], t[7] * ri * g1[3]);
        if (!dry) { *(u32x4*)(zr + ZC_LG + 8 * lane) = wb; *(u32x4*)(zr + ZC_Z + 8 * lane) = wc; } else asm volatile("" :: "v"(wb), "v"(wc));
#pragma unroll
        for (int i = 0; i < 6; ++i) { c_[i] = n_[i]; n_[i] = n2_[i]; }
    }
#undef FIN_LOAD
}
template <bool XBF>
__device__ __forceinline__ void phase_ln1(const Ctx a, int l, int nrows, LAS float* P, bool dry = false) {
    const int tid_ = otid(); const int lane = tid_ & 63, gw = blockIdx.x * 8 + (tid_ >> 6), NGW = gridDim.x * 8;
    const float* mod = (const float*)(a.ws() + WS_MOD) + (size_t)l * 9 * 6144; bf16* X = (bf16*)(a.ws() + WS_X); const bf16* ZZ = (const bf16*)(a.ws() + WS_ZZ);
    const float* g = a.in(I_LN1G) + l * 1024; const float* b = a.in(I_LN1B) + l * 1024;
    LAS float* PG = P; LAS float* PB = P + 1024; LAS float* PM = P + 2048;
    lds_fill(PG, g, 1024, tid_); lds_fill(PB, b, 1024, tid_);
    for (int r = 0; r < 9; ++r) lds_fill(PM + r * 3072, mod + (size_t)r * 6144 + 2 * 1024, 3072, tid_);
    __syncthreads();
    constexpr int NXR = XBF ? 2 : 4;
    u32x4 xv[NXR], xn[NXR], xn2[NXR]; u32x4 mw[2], mn[2], mn2[2];
#define LN1_LOAD(row_, xr_, mr_) do { const bf16* mx_ = ZZ + (size_t)(row_) * ZLD + ZC_MIX; \
        if (XBF) { const bf16* xp_ = X + (size_t)(row_) * 1024; _Pragma("unroll") for (int j = 0; j < 2; ++j) xr_[j] = *(const u32x4*)(xp_ + 8 * lane + 512 * j); } \
        else { const float* xp_ = xrow_in(a, 0, (row_)); _Pragma("unroll") for (int j = 0; j < 4; ++j) xr_[j] = *(const u32x4*)(xp_ + lncol<1>(lane, j)); } \
        _Pragma("unroll") for (int j = 0; j < 2; ++j) mr_[j] = *(const u32x4*)(mx_ + 8 * lane + 512 * j); } while (0)
    { const int r0_ = gw < nrows ? gw : 0, r1_ = gw + NGW < nrows ? gw + NGW : r0_; LN1_LOAD(r0_, xv, mw); LN1_LOAD(r1_, xn, mn); }
    for (int row = gw; row < nrows; row += NGW) {
        { const int rp_ = row + 2 * NGW < nrows ? row + 2 * NGW : row; LN1_LOAD(rp_, xn2, mn2); }
        const int mr = row < NLAT ? (row >> 12) : 8; const LAS float* mm = PM + mr * 3072;
        f32x4 v[4];
#pragma unroll
        for (int j = 0; j < 4; ++j) { const int c = lncol<1>(lane, j); const f32x4 gt = *(const LAS f32x4*)(mm + c);
            const unsigned m0_ = (j & 1) ? mw[j >> 1].z : mw[j >> 1].x, m1_ = (j & 1) ? mw[j >> 1].w : mw[j >> 1].y;
            f32x4 xf;
            if (XBF) { const unsigned x0_ = (j & 1) ? xv[j >> 1].z : xv[j >> 1].x, x1_ = (j & 1) ? xv[j >> 1].w : xv[j >> 1].y; xf[0] = bflo(x0_); xf[1] = bfhi(x0_); xf[2] = bflo(x1_); xf[3] = bfhi(x1_); }
            else { xf[0] = __uint_as_float(xv[j % NXR].x); xf[1] = __uint_as_float(xv[j % NXR].y); xf[2] = __uint_as_float(xv[j % NXR].z); xf[3] = __uint_as_float(xv[j % NXR].w); }
            v[j][0] = DN_ALPHA * xf[0] + gt[0] * bflo(m0_); v[j][1] = DN_ALPHA * xf[1] + gt[1] * bfhi(m0_); v[j][2] = DN_ALPHA * xf[2] + gt[2] * bflo(m1_); v[j][3] = DN_ALPHA * xf[3] + gt[3] * bfhi(m1_); }
        layer_norm_row_l<1>(v, PG, PB, lane);
        bf16* xo = X + (size_t)row * 1024;
#pragma unroll
        for (int jj = 0; jj < 2; ++jj) { u32x4 w; w.x = cvt_pk_bf16(v[2 * jj][0], v[2 * jj][1]); w.y = cvt_pk_bf16(v[2 * jj][2], v[2 * jj][3]); w.z = cvt_pk_bf16(v[2 * jj + 1][0], v[2 * jj + 1][1]); w.w = cvt_pk_bf16(v[2 * jj + 1][2], v[2 * jj + 1][3]);
            if (!dry) *(u32x4*)(xo + 8 * lane + 512 * jj) = w; else asm volatile("" :: "v"(w)); }
        if (!dry) { bf16* hrow = (bf16*)(a.ws() + WS_ZZ) + (size_t)row * ZLD + ZC_H2; const LAS float* m3 = mm + 1024; const LAS float* m4 = mm + 2048;
#pragma unroll
          for (int jj = 0; jj < 2; ++jj) { u32x4 w;
#pragma unroll
              for (int q = 0; q < 2; ++q) { const int j = 2 * jj + q; const int c = lncol<1>(lane, j); const f32x4 sc = *(const LAS f32x4*)(m4 + c), sh = *(const LAS f32x4*)(m3 + c);
                  float hv[4];
#pragma unroll
                  for (int e = 0; e < 4; ++e) hv[e] = v[j][e] * (1.f + sc[e]) + sh[e];
                  if (q == 0) { w.x = cvt_pk_bf16(hv[0], hv[1]); w.y = cvt_pk_bf16(hv[2], hv[3]); }
                  else        { w.z = cvt_pk_bf16(hv[0], hv[1]); w.w = cvt_pk_bf16(hv[2], hv[3]); } }
              *(u32x4*)(hrow + 8 * lane + 512 * jj) = w; } }
#pragma unroll
        for (int j = 0; j < NXR; ++j) { xv[j] = xn[j]; xn[j] = xn2[j]; }
#pragma unroll
        for (int j = 0; j < 2; ++j) { mw[j] = mn[j]; mn[j] = mn2[j]; }
    }
#undef LN1_LOAD
}
__device__ __forceinline__ void phase_ln2(const Ctx a, int l, int nrows, LAS float* P, bool dry = false) {
    const int tid_ = otid(); const int lane = tid_ & 63, gw = blockIdx.x * 8 + (tid_ >> 6), NGW = gridDim.x * 8;
    const float* mod = (const float*)(a.ws() + WS_MOD) + (size_t)l * 9 * 6144; const float* modn = (const float*)(a.ws() + WS_MOD) + (size_t)(l + 1) * 9 * 6144;
    bf16* H = (bf16*)(a.ws() + WS_ACT); bf16* X = (bf16*)(a.ws() + WS_X); const unsigned char* YE = (const unsigned char*)(a.ws() + WS_YE);     const int* tslot = (const int*)(a.ws() + WS_TSLOT);
    const float* g = a.in(I_LN2G) + l * 1024; const float* b = a.in(I_LN2B) + l * 1024;
    const bool last = (l == DEPTH - 1);
    LAS float* PG = P; LAS float* PB = P + 1024; LAS float* P5 = P + 2048; LAS float* PN = P + 2048 + 9 * 1024;
    lds_fill(PG, g, 1024, tid_); lds_fill(PB, b, 1024, tid_);
    for (int r = 0; r < 9; ++r) { lds_fill(P5 + r * 1024, mod + (size_t)r * 6144 + 5 * 1024, 1024, tid_); if (!last) lds_fill(PN + r * 2048, modn + (size_t)r * 6144, 2048, tid_); }
    __syncthreads();
    int sl_c = 0, sl_n = 0;
    u32x4 yv[8], yn[8]; u32x4 xv[2], xn[2];
#define LN2_SLOT(row_, dst_) do { dst_ = (lane < 8) ? tslot[(row_) * 8 + lane] : 0; } while (0)
#define LN2_LOAD(row_, sl_, yr_, xr_) do { \
        _Pragma("unroll") for (int k = 0; k < 8; ++k) { const int slot_ = __builtin_amdgcn_readlane((sl_), k); yr_[k] = *(const u32x4*)(YE + (size_t)slot_ * 1024 + 16 * lane); } \
        _Pragma("unroll") for (int j = 0; j < 2; ++j) xr_[j] = *(const u32x4*)(X + (size_t)(row_) * 1024 + 16 * lane + 8 * j); } while (0)
    { const int r0_ = gw < nrows ? gw : 0, r1_ = gw + NGW < nrows ? gw + NGW : r0_; LN2_SLOT(r0_, sl_c); LN2_LOAD(r0_, sl_c, yv, xv); LN2_SLOT(r1_, sl_n); }
    for (int row = gw; row < nrows; row += NGW) {
        { const int rn_ = row + NGW < nrows ? row + NGW : row; LN2_LOAD(rn_, sl_n, yn, xn); }
        int sl_nn; { const int rn2_ = row + 2 * NGW < nrows ? row + 2 * NGW : row; LN2_SLOT(rn2_, sl_nn); }
        const int mr = row < NLAT ? (row >> 12) : 8;
        bf16* xo = X + (size_t)row * 1024;
        f32x4 v[4];
#pragma unroll
        for (int j = 0; j < 4; ++j) { f32x4 f = (f32x4){0.f, 0.f, 0.f, 0.f};
#pragma unroll
            for (int k = 0; k < 8; ++k) { const int yw = (int)(j == 0 ? yv[k].x : (j == 1 ? yv[k].y : (j == 2 ? yv[k].z : yv[k].w)));
                const f32x2 lo = __builtin_amdgcn_cvt_pk_f32_bf8(yw, false), hi = __builtin_amdgcn_cvt_pk_f32_bf8(yw, true);
                f[0] += lo[0]; f[1] += lo[1]; f[2] += hi[0]; f[3] += hi[1]; }
            const unsigned x0_ = (j & 1) ? xv[j >> 1].z : xv[j >> 1].x, x1_ = (j & 1) ? xv[j >> 1].w : xv[j >> 1].y; const f32x4 xf = (f32x4){bflo(x0_), bfhi(x0_), bflo(x1_), bfhi(x1_)};
            const int c = lncol<2>(lane, j); v[j] = xf + *(const LAS f32x4*)(P5 + mr * 1024 + c) * f; }
        layer_norm_row_l<2>(v, PG, PB, lane);
        if (dry) { asm volatile("" :: "v"(v[0]), "v"(v[1]), "v"(v[2]), "v"(v[3])); }
        else if (last) { float* o = a.out() + (size_t)row * 1024;
#pragma unroll
            for (int j = 0; j < 4; ++j) *(f32x4*)(o + lncol<2>(lane, j)) = v[j];
        } else {
#pragma unroll
            for (int jj = 0; jj < 2; ++jj) { u32x4 w; w.x = cvt_pk_bf16(v[2 * jj][0], v[2 * jj][1]); w.y = cvt_pk_bf16(v[2 * jj][2], v[2 * jj][3]); w.z = cvt_pk_bf16(v[2 * jj + 1][0], v[2 * jj + 1][1]); w.w = cvt_pk_bf16(v[2 * jj + 1][2], v[2 * jj + 1][3]);
                *(u32x4*)(xo + 16 * lane + 8 * jj) = w; }
            const LAS float* mn = PN + mr * 2048;
            store_h_row_l<2>(H + (size_t)row * 1024, v, mn, mn + 1024, lane);
        }
#pragma unroll
        for (int k = 0; k < 8; ++k) yv[k] = yn[k];
#pragma unroll
        for (int j = 0; j < 2; ++j) xv[j] = xn[j];
        sl_n = sl_nn;
    }
#undef LN2_SLOT
#undef LN2_LOAD
}

__device__ __forceinline__ void phase_route_a(const Ctx a, int l, int ntok, LAS unsigned* hist) {
    const int tid = otid(), lane = tid & 63, wid = tid >> 6;
    const float* L = (const float*)(a.ws() + WS_LOGIT); int* selE = (int*)(a.ws() + WS_SELE); float* selW = (float*)(a.ws() + WS_SELW); int* selR = (int*)(a.ws() + WS_SELR); int* wgh = (int*)(a.ws() + WS_WGHIST);
    if (tid < 64) hist[tid] = 0u;
    __syncthreads();
    const float bias = a.in(I_RBIAS)[l * 64 + lane];
    const int tpw = (ntok + gridDim.x - 1) / gridDim.x; const int t0 = blockIdx.x * tpw, t1 = min(ntok, t0 + tpw);
    float lg_c = (t0 + wid < t1) ? L[(size_t)(t0 + wid) * 64 + lane] : 0.f;
    for (int row = t0 + wid; row < t1; row += 8) {
        const float lg_n = (row + 8 < t1) ? L[(size_t)(row + 8) * 64 + lane] : 0.f;
        const float s = sigmoidf_(lg_c); const float sel = s + bias; lg_c = lg_n;
        float m1 = sel;
        m1 = fmaxf(m1, __shfl_xor(m1, 1)); m1 = fmaxf(m1, __shfl_xor(m1, 2)); m1 = fmaxf(m1, __shfl_xor(m1, 4));
        const unsigned long long bm = __ballot(sel == m1); const unsigned gbits = (unsigned)((bm >> (lane & ~7)) & 0xffull);
        const int first = (lane & ~7) + (__ffs(gbits) - 1);
        float m2 = (lane == first) ? -INFINITY : sel;
        m2 = fmaxf(m2, __shfl_xor(m2, 1)); m2 = fmaxf(m2, __shfl_xor(m2, 2)); m2 = fmaxf(m2, __shfl_xor(m2, 4));
        const float gs = m1 + m2; const int myg = lane >> 3;
        int grank = 0;
#pragma unroll
        for (int gq = 0; gq < 8; ++gq) { const float o = __builtin_bit_cast(float, __builtin_amdgcn_readlane(__builtin_bit_cast(int, gs), gq * 8)); grank += (o > gs || (o == gs && gq < myg)) ? 1 : 0; }
        const float sel2 = grank < 4 ? sel : -INFINITY;
        int erank = 0;
#pragma unroll 4
        for (int e = 0; e < 64; ++e) { const float o = __builtin_bit_cast(float, __builtin_amdgcn_readlane(__builtin_bit_cast(int, sel2), e)); erank += (o > sel2 || (o == sel2 && e < lane)) ? 1 : 0; }
        const bool chosen = (erank < 8) && (grank < 4);
        const unsigned long long cm = __ballot(chosen);
        const float wsum = wave_sum(chosen ? s : 0.f);
        if (chosen) {
            const int kidx = __popcll(cm & ((1ull << lane) - 1ull));
            const unsigned rk = __hip_atomic_fetch_add(&hist[lane], 1u, __ATOMIC_RELAXED, __HIP_MEMORY_SCOPE_WORKGROUP);
            selE[row * 8 + kidx] = lane; selW[row * 8 + kidx] = s / wsum * 2.5f; selR[row * 8 + kidx] = (int)rk;
        }
    }
    __syncthreads();
    if (tid < 64) wgh[blockIdx.x * 64 + tid] = (int)hist[tid];
}
__device__ __forceinline__ void phase_route_b(const Ctx a, int ntok, LAS int* sm) {
    const int tid = otid(), lane = tid & 63, wid = tid >> 6;
    const int* selE = (const int*)(a.ws() + WS_SELE); const float* selW = (const float*)(a.ws() + WS_SELW); const int* selR = (const int*)(a.ws() + WS_SELR); const int* wgh = (const int*)(a.ws() + WS_WGHIST);
    int* tslot = (int*)(a.ws() + WS_TSLOT); int* rowtok = (int*)(a.ws() + WS_ROWTOK); float* roww = (float*)(a.ws() + WS_ROWW); int* tileE = (int*)(a.ws() + WS_TILEE); int* ntiles = (int*)(a.ws() + WS_NTILES);
    LAS int* OFF = sm; LAS int* CNT = sm + 64; LAS int* PST = sm + 128; LAS int* PEN = sm + 192;
    {
        int cnt = 0, base = 0; const int wbeg = wid * ((int)gridDim.x / 8), wend = wid == 7 ? (int)gridDim.x : wbeg + (int)gridDim.x / 8;
        for (int w = wbeg; w < wend; w += 8) { int v[8];
#pragma unroll
            for (int j = 0; j < 8; ++j) v[j] = (w + j < wend) ? wgh[(w + j) * 64 + lane] : 0;
#pragma unroll
            for (int j = 0; j < 8; ++j) { cnt += v[j]; if (w + j < (int)blockIdx.x) base += v[j]; } }
        sm[256 + wid * 64 + lane] = cnt; sm[256 + 512 + wid * 64 + lane] = base; }
    __syncthreads();
    if (wid == 0) {
        int cnt = 0, base = 0;
#pragma unroll
        for (int w = 0; w < 8; ++w) { cnt += sm[256 + w * 64 + lane]; base += sm[256 + 512 + w * 64 + lane]; }
        const int padded = (cnt + 255) & ~255; int inc = padded;
#pragma unroll
        for (int off = 1; off < 64; off <<= 1) { const int t = __shfl_up(inc, off); if (lane >= off) inc += t; }
        OFF[lane] = inc - padded + base; CNT[lane] = cnt; PST[lane] = inc - padded; PEN[lane] = inc;
    }
    __syncthreads();
    const int tpw = (ntok + gridDim.x - 1) / gridDim.x; const int t0 = blockIdx.x * tpw, t1 = min(ntok, t0 + tpw);
    for (int i = t0 * 8 + tid; i < t1 * 8; i += 512) { const int e = selE[i]; const int slot = OFF[e] + selR[i]; tslot[i] = slot; rowtok[slot] = i >> 3; roww[slot] = selW[i]; }
    for (int e = blockIdx.x; e < 64; e += gridDim.x) {
        const int ps = PST[e], pe = PEN[e], cn = CNT[e];
        for (int i = ps + cn + tid; i < pe; i += 512) { rowtok[i] = 0; roww[i] = 0.f; }
        for (int t = (ps >> 8) + tid; t < (pe >> 8); t += 512) tileE[t] = e;
    }
    if (blockIdx.x == 0 && tid == 0) *ntiles = PEN[63] >> 8;
}

#ifndef MK_PER_PHASE
#define MK_PER_PHASE 0
#endif
constexpr int NPHASE = 2 + 13 * DEPTH;

__global__ void __launch_bounds__(512, 2) mega_fwd(Args ka) {
    LAS unsigned char* lds0 = (LAS unsigned char*)lds_raw;
#define lds (olds())
    volatile LAS unsigned* MISC = (volatile LAS unsigned*)(lds0 + MISC_OFF);
    { const int t0_ = threadIdx.x; const unsigned key_ = (unsigned)__builtin_amdgcn_s_getreg(((6 - 1) << 11) | 4) & 63u;
      if ((t0_ & 63) == 0) *(volatile LAS unsigned*)(lds0 + WVTAB_OFF + key_ * 4) = (unsigned)(t0_ >> 6);
      if (t0_ < 74) ((LAS unsigned*)(lds0 + CTX_OFF))[t0_] = ((const unsigned*)&ka)[t0_];
      if (t0_ < 32) ((volatile LAS unsigned*)(lds0 + MISC_OFF))[t0_] = 0u; }
    __syncthreads();
#define G (osg((int)gridDim.x))
    unsigned* ctl = (unsigned*)(ka.ws + WS_CTL);
    const Ctx a;
    const int lo = ka.ph_lo, hi = ka.ph_hi;
    XcdBarrier bar; bar.bar = ctl + CW_BAR; bar.x = 0; bar.st = nullptr;
    if (hi - lo > 1) bar = xcd_barrier_post(ctl + CW_BAR, MISC + 8);
#ifndef MK_ONLY
#define MK_ONLY -1
#endif
#define SELP(k) ((MK_ONLY) < 0 || (MK_ONLY) == (k))
#ifndef MK_DUP
#define MK_DUP -1
#endif
#define REP(k) for (int rep_ = 0; rep_ < ((MK_DUP) == (k) ? 2 : 1); ++rep_)
#define IN(k) (lo <= (k) && (k) < hi)
#ifndef MK_TIME
#define MK_TIME -1
#endif
    unsigned long long tp0_ = 0ull, tp1_ = 0ull;
#define SEAM(k) do { if (IN(k) && IN((k) + 1)) { xcd_barrier(bar); if ((MK_DUP) == 200) xcd_barrier(bar); } \
    if ((MK_TIME) >= 0) { if ((k) == (MK_TIME) - 1) tp0_ = __builtin_amdgcn_s_memrealtime(); if ((k) == (MK_TIME)) tp1_ = __builtin_amdgcn_s_memrealtime(); } } while (0)
#define WSP (a.ws())
#define ZZP ((bf16*)(a.ws() + WS_ZZ))
#define HP ((bf16*)(a.ws() + WS_H))
#define XP ((bf16*)(a.ws() + WS_X))
#define WP (a.ws() + WS_W)

    if (SELP(0) && IN(0)) { phase_mod_rope(a, (LAS float*)lds); __syncthreads(); REP(1) convert_layer_weights(a, 0, (LAS float*)lds); }
    SEAM(0);
    if (SELP(1) && IN(1)) { REP(100) phase_modulate0(a, (LAS float*)lds); }
    SEAM(1);

    for (int l_ = 0; l_ < DEPTH; ++l_) {
#define l (osg(l_))
        const int pb = 2 + 13 * l_;
        const bool last = (l_ == DEPTH - 1);
        const int nrows = last ? NLAT : MTOK;
        const int ntile = nrows / 256;
        const float* modl = (const float*)(WSP + WS_MOD) + (size_t)l * 9 * 6144;

        if (SELP(2) && IN(pb + 0)) REP(2) {
            const bf16* Hin = (const bf16*)(WSP + WS_ACT);
            GeoPlain g{Hin, (const bf16*)(WP + W_IN), 1024, 1024, 1024};
            pg8::StaticOrder S; S.init(MTOK / 256, ZC_DT / 256, G, osg((int)blockIdx.x));
            EpiInProj E{ZZP, (const float*)(WSP + WS_ROPE), (const float*)(WSP + WS_ROPE) + 4096 * 32};
            pg8::gemm_phase(lds, g, S, E);
        }
        SEAM(pb + 0);

        if (SELP(14) && IN(pb + 1)) REP(14) { phase_scan_prep(a, l); }
        SEAM(pb + 1);

        if (SELP(3) && IN(pb + 2)) {
            unsigned* qhead = ctl + CW_QUEUE + 64 * l;
            const int nunits = 256 + 1024 + (last ? 0 : 64);
            const float lam_init = 0.8f - 0.6f * __expf(-0.3f * (float)l);
            bf16* SCR = (bf16*)(WSP + WS_ACT);
#ifndef MK_UNIT
#define MK_UNIT 7
#endif
#define NEXT_UNIT() do { __syncthreads(); if (otid() == 0) MISC[0] = atomicAdd(qhead, 1u); __syncthreads(); uid = (int)MISC[0]; } while (0)
            int uid; NEXT_UNIT();
            while ((MK_UNIT & 1) && uid < 128) {
                const int b = uid >> 4, h = (uid >> 1) & 7, d = uid & 1;
                ssd::Par P; P.XA = (const bf16*)(WSP + WS_H); P.DT = (const float*)(WSP + WS_LOGIT); P.ACS = (const float*)(WSP + WS_LOGIT) + (size_t)MTOK * 16; P.Y = SCR + (size_t)(2 + d) * MTOK * 512;
                P.Dskip = a.in(I_SD)[l * 8 + h]; P.b = b; P.h = h; P.d = d;
                REP(30) ssd::unit(P);
                NEXT_UNIT();
            }
            while ((MK_UNIT & 2) && uid < 256) {
                const int u = uid - 128; const int b = u >> 4, n = (u >> 1) & 7, d = u & 1;
                lru::Par P; P.ZZ = ZZP; P.Hout = SCR + (size_t)d * MTOK * 512; P.conv_w = a.in(I_LCW) + (size_t)l * 4 * 512; P.conv_b = a.in(I_LCB) + l * 512;
                P.wa = a.in(I_LWA) + (size_t)((l * 2 + d) * 8 + n) * 4096; P.wi = a.in(I_LWI) + (size_t)((l * 2 + d) * 8 + n) * 4096;
                P.ba = a.in(I_LBA) + (l * 2 + d) * 512; P.bi = a.in(I_LBI) + (l * 2 + d) * 512; P.lam = a.in(I_LLAM) + (l * 2 + d) * 512; P.b = b; P.n = n; P.d = d;
                REP(31) lru::unit(P);
                NEXT_UNIT();
            }
            if (MK_UNIT & 4) {
                float d0 = 0.f, d1 = 0.f;
                for (int i = 0; i < 64; ++i) { d0 += a.in(I_LAMQ)[(l * 2 + 0) * 64 + i] * a.in(I_LAMK)[(l * 2 + 0) * 64 + i]; d1 += a.in(I_LAMQ)[(l * 2 + 1) * 64 + i] * a.in(I_LAMK)[(l * 2 + 1) * 64 + i]; }
                const float lam = __expf(d0) - __expf(d1) + lam_init;
                while (uid < nunits) {
                    int qrow0, h, krowA, ntA, krowB, NT;
                    if (uid < 1280) { const int u = uid - 256; const int b = u >> 7; h = (u >> 5) & 3; const int qb = u & 31; qrow0 = b * SEQ + qb * 128; krowA = b * SEQ; ntA = 64; krowB = NLAT + b * CTXL; NT = 68; }
                    else { const int u = uid - 1280; const int b = u >> 3; h = (u >> 1) & 3; const int cq = u & 1; qrow0 = NLAT + b * CTXL + cq * 128; krowA = NLAT + b * CTXL; ntA = 4; krowB = krowA; NT = 4; }
                    if ((MK_DUP) == 32) { att::attn_unit(ZZP, qrow0, h, krowA, ntA, krowB, NT, lam, a.in(I_ATTNG) + (size_t)(l * 4 + h) * 128, 1.0f - lam_init, false); __syncthreads(); }
                    att::attn_unit(ZZP, qrow0, h, krowA, ntA, krowB, NT, lam, a.in(I_ATTNG) + (size_t)(l * 4 + h) * 128, 1.0f - lam_init, true);
                    NEXT_UNIT();
                }
            }
#undef NEXT_UNIT
        }
        SEAM(pb + 2);

        if (SELP(4) && IN(pb + 3)) { if ((MK_DUP) == 4) phase_mixer_finalize(a, l, nrows, true); phase_mixer_finalize(a, l, nrows); }
        SEAM(pb + 3);

        const int nmain = ntile < NLAT / 256 ? ntile : NLAT / 256, nctx = ntile - nmain, nwc = nctx * 4;
        if (SELP(5) && IN(pb + 4)) {
            GeoMergeA g{ZZP, (const bf16*)(WP + W_BR), 512, ZLD, 512};
            EpiMergeDiv E{ZZP, false};
            { MergeOrder S; S.init(nmain, G, osg((int)blockIdx.x)); pg8::gemm_phase(lds, g, S, E); }
            if (nctx > 0) {
                xcd_barrier(bar);
                if (osg((int)blockIdx.x) < nwc) { MergeOrder S; S.init(nctx, nwc, osg((int)blockIdx.x), nmain); pg8::gemm_phase(lds, g, S, E); }
                else { GeoPlain g2{ZZP + ZC_MRG, (const bf16*)(WP + W_OUT), 1024, ZLD, 1024}; OffOrder S; S.init(nmain, 4, G - nwc, osg((int)blockIdx.x) - nwc, 0);
                       EpiBf16Plain E2{ZZP + ZC_MIX, ZLD}; pg8::gemm_phase(lds, g2, S, E2); }
            }
        }
        SEAM(pb + 4);

        if (SELP(6) && IN(pb + 5)) {
            GeoPlain g{ZZP + ZC_MRG, (const bf16*)(WP + W_OUT), 1024, ZLD, 1024};
            OffOrder S; if (nctx > 0) S.init(nctx, 4, G, osg((int)blockIdx.x), nmain); else S.init(ntile, 4, G, osg((int)blockIdx.x), 0);
            EpiBf16Plain E{ZZP + ZC_MIX, ZLD};
            pg8::gemm_phase(lds, g, S, E);
        }
        SEAM(pb + 5);

        if (SELP(7) && IN(pb + 6)) { if (l == 0) phase_ln1<false>(a, l, nrows, (LAS float*)lds); else phase_ln1<true>(a, l, nrows, (LAS float*)lds); }
        SEAM(pb + 6);

        if (SELP(8) && IN(pb + 7)) {
            REP(80) { GeoPlain g{ZZP + ZC_H2, (const bf16*)(WP + W_SU), 1024, ZLD, 1024};
              pg8::StaticOrder S; S.init(ntile, 2, G, osg((int)blockIdx.x));
              EpiSwiGLU<false> E{(bf16*)(WSP + WS_ACTS), nullptr};
              pg8::gemm_phase(lds, g, S, E); }
            REP(81) { GeoPlain g{ZZP + ZC_H2, (const bf16*)(WP + W_RT), 1024, ZLD, 1024};
              pg8::StaticOrder S; S.init(ntile, 1, G, osg((int)((blockIdx.x + gridDim.x - 16) % gridDim.x)));
              EpiRouter E{(float*)(WSP + WS_LOGIT)};
              pg8::gemm_phase(lds, g, S, E); }
        }
        SEAM(pb + 7);

        if (SELP(9) && IN(pb + 8)) REP(9) { phase_route_a(a, l, nrows, (LAS unsigned*)lds); __syncthreads(); }
        SEAM(pb + 8);
        if (SELP(10) && IN(pb + 9)) REP(10) { phase_route_b(a, nrows, (LAS int*)lds); __syncthreads(); }
        SEAM(pb + 9);

        if (SELP(11) && IN(pb + 10)) REP(11) {
            const int nt_ = __builtin_amdgcn_readfirstlane(*(const int*)(WSP + WS_NTILES));
            GeoMoeUp g{ZZP + ZC_H2, (const bf16*)(WP + W_UP), (const LAS unsigned short*)(lds + RT_OFF), (const LAS int*)(lds + TE_OFF), 1024, ZLD, 1024};
            pg8::StaticOrder S; S.init(nt_, 2, G, osg((int)blockIdx.x));
            EpiSwiGLU<true> E{(bf16*)(WSP + WS_ACT), (const LAS float*)(lds + RW_OFF)};
            { pg8::Unit uu; const int t_ = otid(); const int* rtg_ = (const int*)(WSP + WS_ROWTOK);
              for (int i = 0; i < 9 && S.next(i, uu); ++i) { if (t_ < 256) ((LAS unsigned short*)(lds + RT_OFF))[i * 256 + t_] = (unsigned short)rtg_[uu.pm * 256 + t_]; else ((LAS float*)(lds + RW_OFF))[i * 256 + t_ - 256] = ((const float*)(WSP + WS_ROWW))[uu.pm * 256 + t_ - 256];
                  if (t_ == 0) ((LAS int*)(lds + TE_OFF))[i] = ((const int*)(WSP + WS_TILEE))[uu.pm]; }
              __syncthreads(); }
            pg8::gemm_phase(lds, g, S, E);
        }
        SEAM(pb + 10);

        if (SELP(12) && IN(pb + 11)) {
            REP(12) { const int nt_ = __builtin_amdgcn_readfirstlane(*(const int*)(WSP + WS_NTILES));
              GeoMoeDown g{(const bf16*)(WSP + WS_ACT), (const bf16*)(WP + W_DN), (const LAS int*)(lds + TE_OFF), 256, 256, 256};
              pg8::StaticOrder S; S.init(nt_, 4, G, osg((int)blockIdx.x));
              EpiYe8 E{(unsigned char*)(WSP + WS_YE)};
              { pg8::Unit uu; const int t_ = otid(); for (int i = 0; i < 18 && S.next(i, uu); ++i) { if (t_ == 0) ((LAS int*)(lds + TE_OFF))[i] = ((const int*)(WSP + WS_TILEE))[uu.pm]; } __syncthreads(); }
              pg8::gemm_phase(lds, g, S, E); }
            { GeoPlain g{(const bf16*)(WSP + WS_ACTS), (const bf16*)(WP + W_SD), 256, 256, 256};
              const int r0_ = (__builtin_amdgcn_readfirstlane(*(const int*)(WSP + WS_NTILES)) * 4) % G;
              pg8::StaticOrder S; S.init(ntile, 4, G, (osg((int)blockIdx.x) + G - r0_) % G);
              if ((MK_DUP) == 120) { EpiSharedDown E0{XP, modl, true}; pg8::gemm_phase(lds, g, S, E0); }
              EpiSharedDown E{XP, modl, false};
              pg8::gemm_phase(lds, g, S, E); }
        }
        SEAM(pb + 11);

        if (SELP(13) && IN(pb + 12)) {
            phase_ln2(a, l, nrows, (LAS float*)lds);
            if (!last) { __syncthreads(); convert_layer_weights(a, l + 1, (LAS float*)lds); }
        }
        SEAM(pb + 12);
    }
    if ((MK_TIME) >= 0 && blockIdx.x == 0) { const unsigned long long te_ = __builtin_amdgcn_s_memrealtime(); const unsigned long long w_ = 8ull * (tp1_ - tp0_); while (__builtin_amdgcn_s_memrealtime() - te_ < w_) __builtin_amdgcn_s_sleep(8); }
#undef l
#undef G
#undef lds
#undef IN
#undef SEAM
#undef WSP
#undef ZZP
#undef HP
#undef XP
#undef WP
}

extern "C" void kernel_launch(void* const* d_in, const int* in_sizes, int n_in, void* d_out, int out_size, void* d_ws, size_t ws_size, hipStream_t stream) {
    static int grid = 0;
    if (grid == 0) {
        if (n_in != 35 || in_sizes[0] != NLAT * DM || out_size != NLAT * DM || ws_size < WS_END) {
            fprintf(stderr, "kernel_launch: shape/workspace mismatch: n_in %d in0 %d out %d ws %zu (need %zu)\n", n_in, n_in > 0 ? in_sizes[0] : -1, out_size, ws_size, (size_t)WS_END); grid = -1; return; }
        int dev = 0, cus = 0, per_cu = 0;
        if (hipGetDevice(&dev) != hipSuccess || hipDeviceGetAttribute(&cus, hipDeviceAttributeMultiprocessorCount, dev) != hipSuccess) { fprintf(stderr, "kernel_launch: device query failed\n"); grid = -1; return; }
        if (hipFuncSetAttribute((const void*)mega_fwd, hipFuncAttributeMaxDynamicSharedMemorySize, LDS_BYTES) != hipSuccess) { fprintf(stderr, "kernel_launch: hipFuncSetAttribute failed\n"); grid = -1; return; }
        if (hipOccupancyMaxActiveBlocksPerMultiprocessor(&per_cu, (const void*)mega_fwd, 512, LDS_BYTES) != hipSuccess || per_cu < 1) fprintf(stderr, "kernel_launch: occupancy query reports %d\n", per_cu);
        (void)hipGetLastError();
        grid = cus;
    }
    if (grid < 0) return;
    if (hipMemsetAsync((char*)d_ws + WS_CTL, 0, CTL_ZERO_BYTES, stream) != hipSuccess) { fprintf(stderr, "kernel_launch: memset failed\n"); return; }
    Args a{};
    for (int i = 0; i < 35; ++i) a.in[i] = (const float*)d_in[i];
    a.out = (float*)d_out; a.ws = (unsigned char*)d_ws;
#if MK_PER_PHASE
    for (int p = 0; p < NPHASE; ++p) { a.ph_lo = p; a.ph_hi = p + 1; hipLaunchKernelGGL(mega_fwd, dim3(grid), dim3(512), LDS_BYTES, stream, a); }
#else
    a.ph_lo = 0; a.ph_hi = NPHASE;
    hipLaunchKernelGGL(mega_fwd, dim3(grid), dim3(512), LDS_BYTES, stream, a);
#endif
    const hipError_t le = hipPeekAtLastError();
    if (le != hipSuccess) fprintf(stderr, "kernel_launch: launch failed: %s\n", hipGetErrorName(le));
}
```
